# Optimizing an MI355X kernel written in HIP

```python
import math
import jax, jax.numpy as jnp
from jax import lax
import numpy as np

D_MODEL = 1024
BATCH = 8
SEQ = 4096
DEPTH = 1

CHUNK = 64
EPS = 1e-6

DA_HEADS = 8
DA_DQK = 64
DA_DV = 2 * DA_DQK
DA_WIDTH = DA_HEADS * DA_DV
Q_BLOCK = 128

SG_BLOCK = 128
SG_GROUPS = 8
SG_WIDTH = D_MODEL
SG_GROUP_DIM = SG_WIDTH // SG_GROUPS

SPLIT_SIZES = (2 * DA_HEADS * DA_DQK,
               2 * DA_HEADS * DA_DQK,
               DA_WIDTH,
               SG_WIDTH,
               SG_WIDTH,
               2 * D_MODEL)
D_IN = sum(SPLIT_SIZES)

PEER_HEADS = 8
N_KEYS = 128
N_EXPERTS = N_KEYS * N_KEYS
PEER_TOPK = 16
D_KEY = 256
D_KEY_HALF = D_KEY // 2
PEER_TOKEN_BLOCK = 128

kernel_name = "hybrid_diffattn_gmlp_peer_block"


def rmsnorm(x, g):
    xf = x.astype(jnp.float32)
    y = xf * lax.rsqrt(jnp.mean(xf * xf, axis=-1, keepdims=True) + EPS)
    return (y * g).astype(x.dtype)


def layernorm(x, g, b):
    xf = x.astype(jnp.float32)
    mu = jnp.mean(xf, axis=-1, keepdims=True)
    var = jnp.mean(jnp.square(xf - mu), axis=-1, keepdims=True)
    y = (xf - mu) * lax.rsqrt(var + EPS)
    return (y * g + b).astype(x.dtype)


def lambda_init_for(layer):
    return 0.8 - 0.6 * math.exp(-0.3 * layer)


def diff_attention(q, k, v, lam, subln_g, lambda_init):
    B, S = q.shape[0], q.shape[1]
    nb = S // Q_BLOCK
    scale = DA_DQK ** -0.5
    qb = q.reshape(B, nb, Q_BLOCK, 2, DA_HEADS, DA_DQK).transpose(1, 0, 2, 3, 4, 5)
    key_chunk = jnp.arange(S) // CHUNK

    def block(args):
        qblk, bi = args
        q_chunk = (bi * Q_BLOCK + jnp.arange(Q_BLOCK)) // CHUNK
        allowed = key_chunk[None, :] <= q_chunk[:, None]
        s = jnp.einsum('bqmhd,bkmhd->bmhqk', qblk, k).astype(jnp.float32) * scale
        s = jnp.where(allowed, s, -1e30)
        p = jax.nn.softmax(s, axis=-1)
        a = p[:, 0] - lam * p[:, 1]
        return jnp.einsum('bhqk,bkhd->bqhd', a.astype(v.dtype), v)

    o = lax.map(block, (qb, jnp.arange(nb)))
    o = o.transpose(1, 0, 2, 3, 4).reshape(B, S, DA_HEADS, DA_DV)
    o = rmsnorm(o, subln_g) * (1.0 - lambda_init)
    return o.reshape(B, S, DA_WIDTH)


def spatial_gating(u, v, ln_g, ln_b, w_s, b_s):
    v = layernorm(v, ln_g, ln_b)
    B, S = v.shape[0], v.shape[1]
    nb = S // SG_BLOCK
    vb = v.reshape(B, nb, SG_BLOCK, SG_GROUPS, SG_GROUP_DIM)
    pos_chunk = jnp.arange(SG_BLOCK) // CHUNK
    mask = pos_chunk[:, None] >= pos_chunk[None, :]
    w = jnp.where(mask[None], w_s, 0)
    mixed = jnp.einsum('gij,bnjgc->bnigc', w, vb) + b_s.T[None, None, :, :, None]
    return u * mixed.reshape(B, S, SG_WIDTH)


def peer(x, w_query, subkeys, u_tab, v_tab):
    B, S, D = x.shape
    T = B * S
    xt = x.reshape(T, D)
    q = (xt @ w_query).reshape(T, PEER_HEADS, 2, D_KEY_HALF)
    s = jnp.einsum('thpc,pnc->thpn', q, subkeys).astype(jnp.float32)
    sv, si = lax.top_k(s, PEER_TOPK)
    cand = sv[:, :, 0, :, None] + sv[:, :, 1, None, :]
    cand_idx = si[:, :, 0, :, None] * N_KEYS + si[:, :, 1, None, :]
    cand = cand.reshape(T, PEER_HEADS, PEER_TOPK * PEER_TOPK)
    cand_idx = cand_idx.reshape(T, PEER_HEADS, PEER_TOPK * PEER_TOPK)
    top_s, pos = lax.top_k(cand, PEER_TOPK)
    experts = jnp.take_along_axis(cand_idx, pos, axis=-1)
    g = jax.nn.softmax(top_s, axis=-1)
    nb = T // PEER_TOKEN_BLOCK

    def block(args):
        xb, eb, gb = args
        u = u_tab[eb]
        hdn = jax.nn.gelu(jnp.einsum('td,thkd->thk', xb, u), approximate=False)
        wgt = gb.astype(xb.dtype) * hdn
        return jnp.einsum('thk,thkd->td', wgt, v_tab[eb])

    y = lax.map(block, (xt.reshape(nb, PEER_TOKEN_BLOCK, D),
                        experts.reshape(nb, PEER_TOKEN_BLOCK, PEER_HEADS, PEER_TOPK),
                        g.reshape(nb, PEER_TOKEN_BLOCK, PEER_HEADS, PEER_TOPK)))
    return y.reshape(B, S, D)


def setup_inputs(seed: int = 0) -> dict:
    key = jax.random.key(seed)
    ks = jax.random.split(key, 24)
    f32 = jnp.float32
    L = DEPTH

    def nrm(k, shape, scale):
        return jax.random.normal(k, shape, f32) * scale

    return {
        "x": jax.random.normal(ks[0], (BATCH, SEQ, D_MODEL), f32),
        "norm1_g": 1.0 + nrm(ks[1], (L, D_MODEL), 0.02),
        "w_in": nrm(ks[2], (L, D_MODEL, D_IN), D_MODEL ** -0.5),
        "lambda_q1": nrm(ks[3], (L, DA_DQK), 0.1),
        "lambda_k1": nrm(ks[4], (L, DA_DQK), 0.1),
        "lambda_q2": nrm(ks[5], (L, DA_DQK), 0.1),
        "lambda_k2": nrm(ks[6], (L, DA_DQK), 0.1),
        "da_subln_g": 1.0 + nrm(ks[7], (L, DA_DV), 0.02),
        "sg_ln_g": 1.0 + nrm(ks[8], (L, SG_WIDTH), 0.02),
        "sg_ln_b": nrm(ks[9], (L, SG_WIDTH), 0.02),
        "sg_w": nrm(ks[10], (L, SG_GROUPS, SG_BLOCK, SG_BLOCK), 0.5 * SG_BLOCK ** -0.5),
        "sg_b": 1.0 + nrm(ks[11], (L, SG_GROUPS, SG_BLOCK), 0.02),
        "w_branch_attn": nrm(ks[12], (L, DA_WIDTH, D_MODEL), DA_WIDTH ** -0.5),
        "w_branch_sg": nrm(ks[13], (L, SG_WIDTH, D_MODEL), SG_WIDTH ** -0.5),
        "w_out": nrm(ks[14], (L, D_MODEL, D_MODEL), D_MODEL ** -0.5),
        "norm2_g": 1.0 + nrm(ks[15], (L, D_MODEL), 0.02),
        "peer_w_query": nrm(ks[16], (L, D_MODEL, PEER_HEADS * D_KEY), D_MODEL ** -0.5),
        "peer_subkeys": nrm(ks[17], (L, 2, N_KEYS, D_KEY_HALF), D_KEY_HALF ** -0.5),
        "peer_u": nrm(ks[18], (L, N_EXPERTS, D_MODEL), D_MODEL ** -0.5),
        "peer_v": nrm(ks[19], (L, N_EXPERTS, D_MODEL), 0.3),
        "final_g": 1.0 + nrm(ks[20], (D_MODEL,), 0.02),
    }


def reference(x, norm1_g, w_in, lambda_q1, lambda_k1, lambda_q2, lambda_k2, da_subln_g,
              sg_ln_g, sg_ln_b, sg_w, sg_b, w_branch_attn, w_branch_sg, w_out,
              norm2_g, peer_w_query, peer_subkeys, peer_u, peer_v, final_g):
    B, S, D = x.shape
    offsets = []
    acc = 0
    for sz in SPLIT_SIZES[:-1]:
        acc += sz
        offsets.append(acc)
    h = x
    for l in range(DEPTH):
        lam_init = lambda_init_for(l)
        xn = rmsnorm(h, norm1_g[l])
        proj = xn @ w_in[l]
        q, k, v, su, sv, gates = jnp.split(proj, offsets, axis=-1)
        q = q.reshape(B, S, 2, DA_HEADS, DA_DQK)
        k = k.reshape(B, S, 2, DA_HEADS, DA_DQK)
        v = v.reshape(B, S, DA_HEADS, DA_DV)
        lam = (jnp.exp(jnp.sum(lambda_q1[l].astype(jnp.float32) * lambda_k1[l].astype(jnp.float32)))
               - jnp.exp(jnp.sum(lambda_q2[l].astype(jnp.float32) * lambda_k2[l].astype(jnp.float32)))
               + lam_init)
        ya = diff_attention(q, k, v, lam, da_subln_g[l], lam_init)
        yb = spatial_gating(jax.nn.gelu(su, approximate=False), jax.nn.gelu(sv, approximate=False),
                            sg_ln_g[l], sg_ln_b[l], sg_w[l], sg_b[l])
        ga, gb = jnp.split(jax.nn.sigmoid(gates), 2, axis=-1)
        merged = ga * (ya @ w_branch_attn[l]) + gb * (yb @ w_branch_sg[l])
        h = h + merged @ w_out[l]
        h = h + peer(rmsnorm(h, norm2_g[l]), peer_w_query[l], peer_subkeys[l], peer_u[l], peer_v[l])
    return rmsnorm(h, final_g)
```

```cpp
#include <hip/hip_runtime.h>
#include <hip/hip_cooperative_groups.h>
#include <hip/hip_bf16.h>
#include <cstdio>
#include <cstdint>
#include <cmath>
namespace cg = cooperative_groups;

#ifndef USE_PG8
#define USE_PG8 0
#endif
#ifndef USE_ATTN
#define USE_ATTN 0
#endif
#ifndef USE_GMLP
#define USE_GMLP 0
#endif
#ifndef ONE_LAUNCH
#define ONE_LAUNCH 0
#endif
#define GAS __attribute__((address_space(1)))
#define LAS __attribute__((address_space(3)))
typedef unsigned short bf16;
typedef unsigned v4u __attribute__((ext_vector_type(4)));
typedef unsigned v2u __attribute__((ext_vector_type(2)));
typedef float f32x4 __attribute__((ext_vector_type(4)));
typedef float f32x2 __attribute__((ext_vector_type(2)));
typedef short bf16x8 __attribute__((ext_vector_type(8)));
typedef __bf16 bf16x2_t __attribute__((ext_vector_type(2)));

constexpr int NWAVES = 8, NTHR = NWAVES * 64;
constexpr int T_ = 32768, D_ = 1024, S_ = 4096, NB_ = 8, DIN_ = 7168, NEXP_ = 16384;
constexpr float EPS_ = 1e-6f;
constexpr float C2_ = 0.125f * 1.4426950408889634f;
constexpr float LAM_INIT_ = 0.2f;

constexpr size_t MiB = 1u << 20;
constexpr size_t WS_CTL = 0;
constexpr size_t WS_WIN = 2 * MiB;
constexpr size_t WS_WA = 16 * MiB;
constexpr size_t WS_WB = 18 * MiB;
constexpr size_t WS_WO = 20 * MiB;
constexpr size_t WS_WQS = 22 * MiB;
constexpr size_t WS_SGW = 26 * MiB;
constexpr size_t WS_UT = 28 * MiB;
constexpr size_t WS_VT = 60 * MiB;
constexpr size_t WS_XN = 96 * MiB;
constexpr size_t WS_Q = 160 * MiB;
constexpr size_t WS_K = 224 * MiB;
constexpr size_t WS_V = 288 * MiB;
constexpr size_t WS_SU = 352 * MiB;
constexpr size_t WS_SV = 416 * MiB;
constexpr size_t WS_SC = 160 * MiB;
constexpr size_t WS_END = 480 * MiB;

__device__ __forceinline__ unsigned f2bf(float f) { unsigned u = __builtin_bit_cast(unsigned, f); return (u + 0x7fffu + ((u >> 16) & 1u)) >> 16; }
__device__ __forceinline__ unsigned pk2(float lo, float hi) { return f2bf(lo) | (f2bf(hi) << 16); }
__device__ __forceinline__ float bflo(unsigned u) { return __builtin_bit_cast(float, u << 16); }
__device__ __forceinline__ float bfhi(unsigned u) { return __builtin_bit_cast(float, u & 0xffff0000u); }
__device__ __forceinline__ float bf2f(bf16 h) { return __builtin_bit_cast(float, (unsigned)h << 16); }
__device__ __forceinline__ float wave_sum(float v) {
#pragma unroll
    for (int o = 1; o < 64; o <<= 1) v += __shfl_xor(v, o);
    return v;
}
__device__ __forceinline__ float wave_max(float v) {
#pragma unroll
    for (int o = 1; o < 64; o <<= 1) v = fmaxf(v, __shfl_xor(v, o));
    return v;
}
__device__ __forceinline__ float gelu1(float v) {
    const float av = fabsf(v), d = av * 0.2316418882f + 1.0f;
    const float t = __builtin_amdgcn_rcpf(d);
    float q = t * 0.5307027145f + (-0.7265760135f); q = q * t + 0.7107068705f; q = q * t + (-0.142248368f); q = q * t + 0.127414796f; q = q * t;
    const float e = __builtin_amdgcn_exp2f((v * v) * (-0.72134752044f));
    const float m = v * (q * e), r = v - m;
    return v < 0.f ? m : r;
}
__device__ __forceinline__ float sigmoid1(float v) { return __builtin_amdgcn_rcpf(1.0f + __builtin_amdgcn_exp2f(-1.4426950408889634f * v)); }
__device__ __forceinline__ void store4bf(bf16* p, f32x4 v) { v2u w; w.x = pk2(v[0], v[1]); w.y = pk2(v[2], v[3]); *(v2u*)p = w; }

struct Frame {
    LAS unsigned char* lds;
    int tid, lane, wave, G, bid;
    const float* in[21]; float* out; unsigned char* ws;
    bf16 *WIN, *WA, *WB, *WO, *WQS, *SGW, *UT, *VT, *XN, *Q, *K, *V, *SU, *SV, *GT;
    float* SC;
};

__device__ __forceinline__ void p0_transpose_item(const float* W, int K, int N, bf16* WT, LAS float* scr, int item, int lane) {
    const int nblk = N / 32, kb = item / nblk, nb = item % nblk, k0 = 64 * kb, n0 = 32 * nb;
#pragma unroll 8
    for (int i = 0; i < 32; ++i) { const int kk = 2 * i + (lane >> 5); scr[kk * 33 + (lane & 31)] = W[(size_t)(k0 + kk) * N + n0 + (lane & 31)]; }
    asm volatile("s_waitcnt lgkmcnt(0)" ::: "memory");
    const int c = lane & 7;
#pragma unroll
    for (int j = 0; j < 4; ++j) { const int n = (lane >> 3) + 8 * j; const LAS float* s = scr + (8 * c) * 33 + n;
        v4u o; o.x = pk2(s[0 * 33], s[1 * 33]); o.y = pk2(s[2 * 33], s[3 * 33]); o.z = pk2(s[4 * 33], s[5 * 33]); o.w = pk2(s[6 * 33], s[7 * 33]);
        *(v4u*)(WT + (size_t)(n0 + n) * K + k0 + 8 * c) = o; }
    asm volatile("s_waitcnt lgkmcnt(0)" ::: "memory");
}

__device__ __forceinline__ void p0_prologue(Frame& F) {
    LAS float* scr = (LAS float*)(F.lds + F.wave * 16384);
    const int gw = F.bid * NWAVES + F.wave, NGW = F.G * NWAVES;
    const int gt = F.bid * NTHR + F.tid, NGT = F.G * NTHR;
    constexpr int I_IN = (D_ / 64) * (DIN_ / 32), I_SQ = (D_ / 64) * (D_ / 32);
    constexpr int NITEMS = I_IN + 3 * I_SQ;
    for (int it = gw; it < NITEMS; it += NGW) {
        int r = it;
        if (r < I_IN) { p0_transpose_item(F.in[2], D_, DIN_, F.WIN, scr, r, F.lane); continue; } r -= I_IN;
        if (r < I_SQ) { p0_transpose_item(F.in[12], D_, D_, F.WA, scr, r, F.lane); continue; } r -= I_SQ;
        if (r < I_SQ) { p0_transpose_item(F.in[13], D_, D_, F.WB, scr, r, F.lane); continue; } r -= I_SQ;
        p0_transpose_item(F.in[14], D_, D_, F.WO, scr, r, F.lane);
    }
    {
        const float* Wq = F.in[16]; const float* sk = F.in[17]; const float* g2 = F.in[15];
        for (int it = gt; it < 16 * 8 * 1024; it += NGT) {
            const int d = it & 1023, nb = (it >> 10) & 7, sl = it >> 13, p = sl & 1;
            float acc[16];
#pragma unroll
            for (int i = 0; i < 16; ++i) acc[i] = 0.f;
            const float* wrow = Wq + (size_t)d * 2048 + sl * 128;
            const float* skb = sk + (size_t)(p * 128 + nb * 16) * 128;
            for (int c = 0; c < 128; c += 4) {
                const f32x4 w = *(const f32x4*)(wrow + c);
#pragma unroll
                for (int i = 0; i < 16; ++i) { const f32x4 s = *(const f32x4*)(skb + i * 128 + c); acc[i] += w[0] * s[0] + w[1] * s[1] + w[2] * s[2] + w[3] * s[3]; }
            }
            const float g = g2[d];
#pragma unroll
            for (int i = 0; i < 16; ++i) F.WQS[(size_t)(sl * 128 + nb * 16 + i) * 1024 + d] = (bf16)f2bf(acc[i] * g);
        }
    }
    for (int it = gt; it < 8 * 128 * 128; it += NGT) { const int j = it & 127, i = (it >> 7) & 127; const float w = F.in[10][it]; F.SGW[it] = (bf16)f2bf(((i >> 6) >= (j >> 6)) ? w : 0.f); }
    for (int it = gt; it < NEXP_ * D_ / 8; it += NGT) {
        const f32x4 a = ((const f32x4*)F.in[18])[2 * it], b = ((const f32x4*)F.in[18])[2 * it + 1];
        v4u o; o.x = pk2(a[0], a[1]); o.y = pk2(a[2], a[3]); o.z = pk2(b[0], b[1]); o.w = pk2(b[2], b[3]); ((v4u*)F.UT)[it] = o;
        const f32x4 c = ((const f32x4*)F.in[19])[2 * it], d = ((const f32x4*)F.in[19])[2 * it + 1];
        v4u q; q.x = pk2(c[0], c[1]); q.y = pk2(c[2], c[3]); q.z = pk2(d[0], d[1]); q.w = pk2(d[2], d[3]); ((v4u*)F.VT)[it] = q;
    }
    {
        const float* g1 = F.in[1];
        f32x4 gv[4];
#pragma unroll
        for (int j = 0; j < 4; ++j) gv[j] = ((const f32x4*)g1)[F.lane + 64 * j];
        for (int m = gw; m < T_; m += NGW) {
            const f32x4* xr = (const f32x4*)(F.in[0] + (size_t)m * D_) + F.lane;
            f32x4 v[4]; float s = 0.f;
#pragma unroll
            for (int j = 0; j < 4; ++j) { v[j] = xr[64 * j]; s += (v[j][0] * v[j][0] + v[j][1] * v[j][1]) + (v[j][2] * v[j][2] + v[j][3] * v[j][3]); }
            const float rstd = 1.0f / sqrtf(wave_sum(s) * (1.f / D_) + EPS_);
            v2u* o8 = (v2u*)(F.XN + (size_t)m * D_) + F.lane;
#pragma unroll
            for (int j = 0; j < 4; ++j) { v2u w; w.x = pk2(v[j][0] * rstd * gv[j][0], v[j][1] * rstd * gv[j][1]); w.y = pk2(v[j][2] * rstd * gv[j][2], v[j][3] * rstd * gv[j][3]); o8[64 * j] = w; }
        }
    }
}

struct EpiIn {
    bf16 *Q, *K, *V, *SU, *SV, *GT;
    __device__ __forceinline__ void operator()(int row, int col, f32x4 v) const {
        if (col < 1024) { store4bf(Q + (size_t)row * 1024 + col, v * C2_); }
        else if (col < 2048) { store4bf(K + (size_t)row * 1024 + (col - 1024), v); }
        else if (col < 3072) { store4bf(V + (size_t)row * 1024 + (col - 2048), v); }
        else if (col < 4096) { f32x4 g = {gelu1(v[0]), gelu1(v[1]), gelu1(v[2]), gelu1(v[3])}; store4bf(SU + (size_t)row * 1024 + (col - 3072), g); }
        else if (col < 5120) { f32x4 g = {gelu1(v[0]), gelu1(v[1]), gelu1(v[2]), gelu1(v[3])}; store4bf(SV + (size_t)row * 1024 + (col - 4096), g); }
        else { f32x4 g = {sigmoid1(v[0]), sigmoid1(v[1]), sigmoid1(v[2]), sigmoid1(v[3])}; store4bf(GT + (size_t)row * 2048 + (col - 5120), g); }
    }
};
struct EpiBrA {
    const bf16* GT; bf16* TMP;
    __device__ __forceinline__ void operator()(int row, int col, f32x4 v) const {
        const v2u g = *(const v2u*)(GT + (size_t)row * 2048 + col);
        f32x4 o = {v[0] * bflo(g.x), v[1] * bfhi(g.x), v[2] * bflo(g.y), v[3] * bfhi(g.y)};
        store4bf(TMP + (size_t)row * 1024 + col, o);
    }
};
struct EpiBrB {
    const bf16* GT; const bf16* TMP; bf16* MG;
    __device__ __forceinline__ void operator()(int row, int col, f32x4 v) const {
        const v2u g = *(const v2u*)(GT + (size_t)row * 2048 + 1024 + col);
        const v2u t = *(const v2u*)(TMP + (size_t)row * 1024 + col);
        f32x4 o = {bflo(t.x) + v[0] * bflo(g.x), bfhi(t.x) + v[1] * bfhi(g.x), bflo(t.y) + v[2] * bflo(g.y), bfhi(t.y) + v[3] * bfhi(g.y)};
        store4bf(MG + (size_t)row * 1024 + col, o);
    }
};
struct EpiOut {
    const float* X; float* H; bf16* HB;
    __device__ __forceinline__ void operator()(int row, int col, f32x4 v) const {
        const f32x4 x = *(const f32x4*)(X + (size_t)row * 1024 + col);
        const f32x4 h = x + v;
        *(f32x4*)(H + (size_t)row * 1024 + col) = h;
        store4bf(HB + (size_t)row * 1024 + col, h);
    }
};
struct EpiSc {
    float* SC;
    __device__ __forceinline__ void operator()(int row, int col, f32x4 v) const { *(f32x4*)(SC + (size_t)row * 2048 + col) = v; }
};

template <class Fn>
__device__ __forceinline__ void gemm_naive(const bf16* A, const bf16* Bt, int M, int N, int K, const Fn& f, int G, int bid) {
    const int tid = threadIdx.x, wid = tid >> 6, lane = tid & 63;
    const int tilesN = N / 128, ntiles = (M / 128) * tilesN;
    for (int tl = bid; tl < ntiles; tl += G) {
        const int tm = tl / tilesN, tn = tl % tilesN;
        const int m0 = tm * 128 + (wid & 3) * 32, n0 = tn * 128 + (wid >> 2) * 64;
        f32x4 acc[2][4];
#pragma unroll
        for (int i = 0; i < 2; ++i)
#pragma unroll
            for (int j = 0; j < 4; ++j) acc[i][j] = (f32x4){0.f, 0.f, 0.f, 0.f};
        const bf16* ap = A + (size_t)(m0 + (lane & 15)) * K + 8 * (lane >> 4);
        const bf16* bp = Bt + (size_t)(n0 + (lane & 15)) * K + 8 * (lane >> 4);
        for (int k = 0; k < K; k += 32) {
            bf16x8 a[2], b[4];
#pragma unroll
            for (int i = 0; i < 2; ++i) a[i] = *(const bf16x8*)(ap + (size_t)i * 16 * K + k);
#pragma unroll
            for (int j = 0; j < 4; ++j) b[j] = *(const bf16x8*)(bp + (size_t)j * 16 * K + k);
#pragma unroll
            for (int i = 0; i < 2; ++i)
#pragma unroll
                for (int j = 0; j < 4; ++j) acc[i][j] = __builtin_amdgcn_mfma_f32_16x16x32_bf16(b[j], a[i], acc[i][j], 0, 0, 0);
        }
#pragma unroll
        for (int i = 0; i < 2; ++i)
#pragma unroll
            for (int j = 0; j < 4; ++j) f(m0 + i * 16 + (lane & 15), n0 + j * 16 + (lane >> 4) * 4, acc[i][j]);
    }
}

#if USE_PG8
template <class Fn> struct EpiWrap {
    static constexpr bool PERM = false, AFTER_DRAIN = false;
    Fn f;
    __device__ __forceinline__ void operator()(const pg8::f32x4 (&acc)[2][2][4][2], const pg8::Unit& u, int wr, int wc, int fr, int fq) const {
#pragma unroll
        for (int ai = 0; ai < 2; ++ai)
#pragma unroll
            for (int m = 0; m < 4; ++m)
#pragma unroll
                for (int bj = 0; bj < 2; ++bj)
#pragma unroll
                    for (int n = 0; n < 2; ++n)
                        f(u.pm * 256 + ai * 128 + wr * 64 + m * 16 + fr, u.pn * 256 + bj * 128 + wc * 32 + n * 16 + 4 * fq, acc[ai][bj][m][n]);
    }
};
#endif

template <class Fn>
__device__ __forceinline__ void gemm_any(Frame& F, const bf16* A, const bf16* Bt, int M, int N, int K, const Fn& f) {
#if USE_PG8
    pg8::Gemm g{A, Bt, M, N, K}; pg8::StaticOrder S; S.init(M, N, F.G, F.bid);
    EpiWrap<Fn> E{f};
    pg8::gemm_phase<EpiWrap<Fn>, pg8::StaticOrder, true, true>(F.lds, g, S, E);
#else
    gemm_naive(A, Bt, M, N, K, f, F.G, F.bid);
#endif
}

__device__ __forceinline__ void gmlp_naive(Frame& F) {
    LAS float* vn = (LAS float*)F.lds;
    LAS float* Wl = (LAS float*)(F.lds + 65536);
    LAS float* st = (LAS float*)(F.lds + 131072);
    const float* lng = F.in[8]; const float* lnb = F.in[9]; const float* sgw = F.in[10]; const float* sgb = F.in[11];
    for (int u = F.bid; u < T_ / 128; u += F.G) {
        const int r0 = u * 128;
        __syncthreads();
        for (int rr = 0; rr < 16; ++rr) {
            const int j = F.wave * 16 + rr;
            const bf16* row = F.SV + (size_t)(r0 + j) * 1024;
            const v4u a = *(const v4u*)(row + 8 * F.lane), b = *(const v4u*)(row + 512 + 8 * F.lane);
            float x[16] = {bflo(a.x), bfhi(a.x), bflo(a.y), bfhi(a.y), bflo(a.z), bfhi(a.z), bflo(a.w), bfhi(a.w),
                           bflo(b.x), bfhi(b.x), bflo(b.y), bfhi(b.y), bflo(b.z), bfhi(b.z), bflo(b.w), bfhi(b.w)};
            float s = 0.f;
#pragma unroll
            for (int i = 0; i < 16; ++i) s += x[i];
            const float mean = wave_sum(s) * (1.f / 1024.f);
            float q = 0.f;
#pragma unroll
            for (int i = 0; i < 16; ++i) { const float d = x[i] - mean; q += d * d; }
            const float rstd = 1.0f / sqrtf(wave_sum(q) * (1.f / 1024.f) + EPS_);
            if (F.lane == 0) { st[2 * j] = mean; st[2 * j + 1] = rstd; }
        }
        __syncthreads();
        for (int g = 0; g < 8; ++g) {
            for (int idx = F.tid; idx < 16384; idx += NTHR) {
                const int j = idx >> 7, c = idx & 127;
                const float x = bf2f(F.SV[(size_t)(r0 + j) * 1024 + g * 128 + c]);
                vn[idx] = (x - st[2 * j]) * st[2 * j + 1] * lng[g * 128 + c] + lnb[g * 128 + c];
                const int i = j;
                const float w = sgw[(size_t)g * 16384 + idx];
                Wl[idx] = ((i >> 6) >= (c >> 6)) ? w : 0.f;
            }
            __syncthreads();
            const int c = F.tid & 127, rg = F.tid >> 7;
            float acc[32];
#pragma unroll
            for (int ii = 0; ii < 32; ++ii) acc[ii] = 0.f;
            for (int j = 0; j < 128; j += 4) {
                const float v0 = vn[(j + 0) * 128 + c], v1 = vn[(j + 1) * 128 + c], v2 = vn[(j + 2) * 128 + c], v3 = vn[(j + 3) * 128 + c];
#pragma unroll
                for (int ii = 0; ii < 32; ++ii) { const f32x4 w = *(const LAS f32x4*)(Wl + (rg * 32 + ii) * 128 + j); acc[ii] += w[0] * v0 + w[1] * v1 + w[2] * v2 + w[3] * v3; }
            }
#pragma unroll
            for (int ii = 0; ii < 32; ++ii) {
                const int i = rg * 32 + ii; bf16* p = F.SU + (size_t)(r0 + i) * 1024 + g * 128 + c;
                *p = (bf16)f2bf(bf2f(*p) * (acc[ii] + sgb[g * 128 + i]));
            }
            __syncthreads();
        }
    }
}

__device__ __forceinline__ void attn_naive(Frame& F, bf16* O1, bf16* O2) {
    const int gw = F.bid * NWAVES + F.wave, NGW = F.G * NWAVES;
    for (int it = gw; it < NB_ * 16 * S_; it += NGW) {
        const int q = it & (S_ - 1), hm = (it >> 12) & 15, b = it >> 16, head = hm & 7, map = hm >> 3;
        const size_t rowb = (size_t)b * S_;
        float qf[64];
        { const bf16* qp = F.Q + (rowb + q) * 1024 + hm * 64;
#pragma unroll
          for (int i = 0; i < 8; ++i) { const v4u w = *(const v4u*)(qp + 8 * i); qf[8 * i + 0] = bflo(w.x); qf[8 * i + 1] = bfhi(w.x); qf[8 * i + 2] = bflo(w.y); qf[8 * i + 3] = bfhi(w.y); qf[8 * i + 4] = bflo(w.z); qf[8 * i + 5] = bfhi(w.z); qf[8 * i + 6] = bflo(w.w); qf[8 * i + 7] = bfhi(w.w); } }
        float m = -INFINITY, l = 0.f, o0 = 0.f, o1 = 0.f;
        const int nt = (q >> 6) + 1;
        for (int tt = 0; tt < nt; ++tt) {
            const bf16* kp = F.K + (rowb + tt * 64 + F.lane) * 1024 + hm * 64;
            float s = 0.f;
#pragma unroll
            for (int i = 0; i < 8; ++i) { const v4u w = *(const v4u*)(kp + 8 * i);
                s += qf[8 * i + 0] * bflo(w.x) + qf[8 * i + 1] * bfhi(w.x) + qf[8 * i + 2] * bflo(w.y) + qf[8 * i + 3] * bfhi(w.y) + qf[8 * i + 4] * bflo(w.z) + qf[8 * i + 5] * bfhi(w.z) + qf[8 * i + 6] * bflo(w.w) + qf[8 * i + 7] * bfhi(w.w); }
            const float mt = wave_max(s), mn = fmaxf(m, mt), al = __builtin_amdgcn_exp2f(m - mn), p = __builtin_amdgcn_exp2f(s - mn);
            l = l * al + wave_sum(p); o0 *= al; o1 *= al; m = mn;
            const bf16* vp = F.V + (rowb + tt * 64) * 1024 + head * 128 + 2 * F.lane;
            for (int j = 0; j < 64; ++j) { const float pj = __shfl(p, j); const unsigned w = *(const unsigned*)(vp + (size_t)j * 1024); o0 += pj * bflo(w); o1 += pj * bfhi(w); }
        }
        const float il = 1.0f / l;
        bf16* op = (map ? O2 : O1) + (rowb + q) * 1024 + head * 128 + 2 * F.lane;
        *(unsigned*)op = pk2(o0 * il, o1 * il);
    }
}

__device__ __forceinline__ void combine_phase(Frame& F, bf16* O1, const bf16* O2) {
    const int gw = F.bid * NWAVES + F.wave, NGW = F.G * NWAVES;
    const float s1 = wave_sum(F.in[3][F.lane] * F.in[4][F.lane]), s2 = wave_sum(F.in[5][F.lane] * F.in[6][F.lane]);
    const float lam = expf(s1) - expf(s2) + LAM_INIT_;
    float sg[16];
#pragma unroll
    for (int i = 0; i < 16; ++i) sg[i] = F.in[7][(16 * F.lane + i) & 127] * (1.0f - LAM_INIT_);
    for (int t = gw; t < T_; t += NGW) {
        bf16* p1 = O1 + (size_t)t * 1024 + 16 * F.lane; const bf16* p2 = O2 + (size_t)t * 1024 + 16 * F.lane;
        const v4u a0 = *(const v4u*)p1, a1 = *(const v4u*)(p1 + 8), b0 = *(const v4u*)p2, b1 = *(const v4u*)(p2 + 8);
        float d[16] = {bflo(a0.x) - lam * bflo(b0.x), bfhi(a0.x) - lam * bfhi(b0.x), bflo(a0.y) - lam * bflo(b0.y), bfhi(a0.y) - lam * bfhi(b0.y),
                       bflo(a0.z) - lam * bflo(b0.z), bfhi(a0.z) - lam * bfhi(b0.z), bflo(a0.w) - lam * bflo(b0.w), bfhi(a0.w) - lam * bfhi(b0.w),
                       bflo(a1.x) - lam * bflo(b1.x), bfhi(a1.x) - lam * bfhi(b1.x), bflo(a1.y) - lam * bflo(b1.y), bfhi(a1.y) - lam * bfhi(b1.y),
                       bflo(a1.z) - lam * bflo(b1.z), bfhi(a1.z) - lam * bfhi(b1.z), bflo(a1.w) - lam * bflo(b1.w), bfhi(a1.w) - lam * bfhi(b1.w)};
        float ss = 0.f;
#pragma unroll
        for (int i = 0; i < 16; ++i) ss += d[i] * d[i];
        ss += __shfl_xor(ss, 1); ss += __shfl_xor(ss, 2); ss += __shfl_xor(ss, 4);
        const float r = 1.0f / sqrtf(ss * (1.f / 128.f) + EPS_);
        v4u o0, o1;
        o0.x = pk2(d[0] * r * sg[0], d[1] * r * sg[1]); o0.y = pk2(d[2] * r * sg[2], d[3] * r * sg[3]); o0.z = pk2(d[4] * r * sg[4], d[5] * r * sg[5]); o0.w = pk2(d[6] * r * sg[6], d[7] * r * sg[7]);
        o1.x = pk2(d[8] * r * sg[8], d[9] * r * sg[9]); o1.y = pk2(d[10] * r * sg[10], d[11] * r * sg[11]); o1.z = pk2(d[12] * r * sg[12], d[13] * r * sg[13]); o1.w = pk2(d[14] * r * sg[14], d[15] * r * sg[15]);
        *(v4u*)p1 = o0; *(v4u*)(p1 + 8) = o1;
    }
}

__device__ const unsigned char CAND_IJ[56] = {
    0x00, 0x01, 0x02, 0x03, 0x04, 0x05, 0x06, 0x07, 0x08, 0x09, 0x0a, 0x0b, 0x0c, 0x0d, 0x0e, 0x0f,
    0x10, 0x11, 0x12, 0x13, 0x14, 0x15, 0x16, 0x17,
    0x20, 0x21, 0x22, 0x23, 0x24,
    0x30, 0x31, 0x32, 0x33,
    0x40, 0x41, 0x42,
    0x50, 0x51, 0x60, 0x61, 0x70, 0x71,
    0x80, 0x90, 0xa0, 0xb0, 0xc0, 0xd0, 0xe0, 0xf0,
    0xff, 0xff, 0xff, 0xff, 0xff, 0xff};
__device__ __forceinline__ unsigned fkey(float f) { const unsigned b = __builtin_bit_cast(unsigned, f); return b ^ ((unsigned)((int)b >> 31) | 0x80000000u); }
__device__ __forceinline__ float keyf(unsigned k) { const unsigned b = (k & 0x80000000u) ? (k ^ 0x80000000u) : ~k; return __builtin_bit_cast(float, b); }
#define DPP_U(x, ctrl) ((unsigned)__builtin_amdgcn_update_dpp(0, (int)(x), (ctrl), 0xf, 0xf, false))
#define DPP_F(x, ctrl) __builtin_bit_cast(float, __builtin_amdgcn_update_dpp(0, __builtin_bit_cast(int, (float)(x)), (ctrl), 0xf, 0xf, false))
__device__ __forceinline__ unsigned umax_(unsigned a, unsigned b) { return a > b ? a : b; }
__device__ __forceinline__ unsigned umin_(unsigned a, unsigned b) { return a < b ? a : b; }
__device__ __forceinline__ unsigned rowmax16_u(unsigned v) {
    v = umax_(v, DPP_U(v, 0xB1)); v = umax_(v, DPP_U(v, 0x4E)); v = umax_(v, DPP_U(v, 0x141)); v = umax_(v, DPP_U(v, 0x140)); return v; }
__device__ __forceinline__ unsigned grpmax8_u(unsigned v) {
    v = umax_(v, DPP_U(v, 0xB1)); v = umax_(v, DPP_U(v, 0x4E)); v = umax_(v, DPP_U(v, 0x141)); return v; }
__device__ __forceinline__ float grpmax8_f(float v) { v = fmaxf(v, DPP_F(v, 0xB1)); v = fmaxf(v, DPP_F(v, 0x4E)); v = fmaxf(v, DPP_F(v, 0x141)); return v; }
__device__ __forceinline__ float grpsum8_f(float v) { v += DPP_F(v, 0xB1); v += DPP_F(v, 0x4E); v += DPP_F(v, 0x141); return v; }
#define CEX(a, b) do { const unsigned _hi = umax_(a, b), _lo = umin_(a, b); a = _hi; b = _lo; } while (0)

__device__ __forceinline__ float dot2bf(unsigned a, unsigned b, float acc) { return __builtin_amdgcn_fdot2_f32_bf16(__builtin_bit_cast(bf16x2_t, a), __builtin_bit_cast(bf16x2_t, b), acc, false); }

__device__ __forceinline__ void peer_phase(Frame& F) {
    const int lane = F.lane, gw = F.bid * NWAVES + F.wave, NGW = F.G * NWAVES;
    LAS unsigned* kl = (LAS unsigned*)(F.lds + F.wave * 2048);
    LAS int* exl = (LAS int*)(F.lds + F.wave * 2048 + 1024);
    LAS float* gtl = (LAS float*)(F.lds + F.wave * 2048 + 1536);
    const float* g2 = F.in[15]; const float* gfin = F.in[20];
    const float* H = F.out;
    const int li = lane & 15, rho = lane >> 4;
    for (int t = gw; t < T_; t += NGW) {
        const float* hp = H + (size_t)t * 1024;
        f32x4 hv[4]; hv[0] = *(const f32x4*)(hp + 8 * lane); hv[1] = *(const f32x4*)(hp + 8 * lane + 4); hv[2] = *(const f32x4*)(hp + 512 + 8 * lane); hv[3] = *(const f32x4*)(hp + 512 + 8 * lane + 4);
        float ss = 0.f;
#pragma unroll
        for (int i = 0; i < 4; ++i) ss += (hv[i][0] * hv[i][0] + hv[i][1] * hv[i][1]) + (hv[i][2] * hv[i][2] + hv[i][3] * hv[i][3]);
        const float rstd2 = 1.0f / sqrtf(wave_sum(ss) * (1.f / 1024.f) + EPS_);
        unsigned xb[8];
        {
            f32x4 gg[4]; gg[0] = *(const f32x4*)(g2 + 8 * lane); gg[1] = *(const f32x4*)(g2 + 8 * lane + 4); gg[2] = *(const f32x4*)(g2 + 512 + 8 * lane); gg[3] = *(const f32x4*)(g2 + 512 + 8 * lane + 4);
#pragma unroll
            for (int i = 0; i < 4; ++i) { xb[2 * i] = pk2(hv[i][0] * rstd2 * gg[i][0], hv[i][1] * rstd2 * gg[i][1]); xb[2 * i + 1] = pk2(hv[i][2] * rstd2 * gg[i][2], hv[i][3] * rstd2 * gg[i][3]); }
        }
        const float* sp = F.SC + (size_t)t * 2048;
#pragma unroll 1
        for (int r = 0; r < 4; ++r) {
            const int gi = 4 * r + rho;
            const f32x4 s0 = *(const f32x4*)(sp + gi * 128 + 8 * li), s1 = *(const f32x4*)(sp + gi * 128 + 8 * li + 4);
            unsigned k0 = (fkey(s0[0]) & ~127u) | (unsigned)(127 - (8 * li + 0)), k1 = (fkey(s0[1]) & ~127u) | (unsigned)(127 - (8 * li + 1)),
                     k2 = (fkey(s0[2]) & ~127u) | (unsigned)(127 - (8 * li + 2)), k3 = (fkey(s0[3]) & ~127u) | (unsigned)(127 - (8 * li + 3)),
                     k4 = (fkey(s1[0]) & ~127u) | (unsigned)(127 - (8 * li + 4)), k5 = (fkey(s1[1]) & ~127u) | (unsigned)(127 - (8 * li + 5)),
                     k6 = (fkey(s1[2]) & ~127u) | (unsigned)(127 - (8 * li + 6)), k7 = (fkey(s1[3]) & ~127u) | (unsigned)(127 - (8 * li + 7));
            CEX(k0, k1); CEX(k2, k3); CEX(k4, k5); CEX(k6, k7);
            CEX(k0, k2); CEX(k1, k3); CEX(k4, k6); CEX(k5, k7);
            CEX(k1, k2); CEX(k5, k6); CEX(k0, k4); CEX(k3, k7);
            CEX(k1, k5); CEX(k2, k6);
            CEX(k1, k4); CEX(k3, k6);
            CEX(k2, k4); CEX(k3, k5);
            CEX(k3, k4);
            unsigned rec = 0u;
#pragma unroll
            for (int itx = 0; itx < 16; ++itx) {
                const unsigned m = rowmax16_u(k0);
                rec = (li == itx) ? m : rec;
                const bool own = (k0 == m);
                k0 = own ? k1 : k0; k1 = own ? k2 : k1; k2 = own ? k3 : k2; k3 = own ? k4 : k3; k4 = own ? k5 : k4; k5 = own ? k6 : k5; k6 = own ? k7 : k6; k7 = own ? 0u : k7;
            }
            kl[gi * 16 + li] = rec;
        }
        asm volatile("s_waitcnt lgkmcnt(0)" ::: "memory");
        {
            const int hh = lane >> 3, q8 = lane & 7;
            unsigned c[7];
#pragma unroll
            for (int mth = 0; mth < 7; ++mth) {
                const int cid = q8 + 8 * mth; const unsigned ij = CAND_IJ[cid];
                if (ij == 0xffu) { c[mth] = 0u; }
                else { const unsigned ka = kl[(2 * hh) * 16 + (ij >> 4)], kb = kl[(2 * hh + 1) * 16 + (ij & 15)];
                       const float sum = keyf(ka & ~127u) + keyf(kb & ~127u);
                       c[mth] = (fkey(sum) & ~63u) | (unsigned)(63 - cid); }
            }
            CEX(c[0], c[6]); CEX(c[2], c[3]); CEX(c[4], c[5]);
            CEX(c[0], c[2]); CEX(c[1], c[4]); CEX(c[3], c[6]);
            CEX(c[0], c[1]); CEX(c[2], c[5]); CEX(c[3], c[4]);
            CEX(c[1], c[2]); CEX(c[4], c[6]);
            CEX(c[2], c[3]); CEX(c[4], c[5]);
            CEX(c[1], c[2]); CEX(c[3], c[4]); CEX(c[5], c[6]);
            unsigned rec0 = 0u, rec1 = 0u;
#pragma unroll
            for (int itx = 0; itx < 16; ++itx) {
                const unsigned m = grpmax8_u(c[0]);
                if (itx < 8) rec0 = (q8 == itx) ? m : rec0; else rec1 = (q8 == itx - 8) ? m : rec1;
                const bool own = (c[0] == m);
                c[0] = own ? c[1] : c[0]; c[1] = own ? c[2] : c[1]; c[2] = own ? c[3] : c[2]; c[3] = own ? c[4] : c[3]; c[4] = own ? c[5] : c[4]; c[5] = own ? c[6] : c[5]; c[6] = own ? 0u : c[6];
            }
            const int cid0 = 63 - (int)(rec0 & 63u), cid1 = 63 - (int)(rec1 & 63u);
            const unsigned ij0 = CAND_IJ[cid0], ij1 = CAND_IJ[cid1];
            const int e0 = (127 - (int)(kl[(2 * hh) * 16 + (ij0 >> 4)] & 127u)) * 128 + (127 - (int)(kl[(2 * hh + 1) * 16 + (ij0 & 15)] & 127u));
            const int e1 = (127 - (int)(kl[(2 * hh) * 16 + (ij1 >> 4)] & 127u)) * 128 + (127 - (int)(kl[(2 * hh + 1) * 16 + (ij1 & 15)] & 127u));
            const float v0 = keyf(rec0 & ~63u) * rstd2, v1 = keyf(rec1 & ~63u) * rstd2;
            const float mx = grpmax8_f(fmaxf(v0, v1));
            const float x0 = __expf(v0 - mx), x1 = __expf(v1 - mx);
            const float inv = 1.0f / grpsum8_f(x0 + x1);
            exl[hh * 16 + q8] = e0; exl[hh * 16 + 8 + q8] = e1;
            gtl[hh * 16 + q8] = x0 * inv; gtl[hh * 16 + 8 + q8] = x1 * inv;
        }
        asm volatile("s_waitcnt lgkmcnt(0)" ::: "memory");
        float y[16];
#pragma unroll
        for (int i = 0; i < 16; ++i) y[i] = 0.f;
#pragma unroll 1
        for (int ch = 0; ch < 32; ++ch) {
            int e[4]; float g[4];
#pragma unroll
            for (int i = 0; i < 4; ++i) { e[i] = __builtin_amdgcn_readfirstlane(exl[ch * 4 + i]); g[i] = __builtin_bit_cast(float, __builtin_amdgcn_readfirstlane(__builtin_bit_cast(int, gtl[ch * 4 + i]))); }
            v4u ua[4], ub[4], va[4], vb[4];
#pragma unroll
            for (int i = 0; i < 4; ++i) {
                const bf16* ur = F.UT + (size_t)e[i] * 1024; const bf16* vr = F.VT + (size_t)e[i] * 1024;
                ua[i] = *(const v4u*)(ur + 8 * lane); ub[i] = *(const v4u*)(ur + 512 + 8 * lane);
                va[i] = *(const v4u*)(vr + 8 * lane); vb[i] = *(const v4u*)(vr + 512 + 8 * lane);
            }
#pragma unroll
            for (int i = 0; i < 4; ++i) {
                float d = 0.f;
                d = dot2bf(ua[i].x, xb[0], d); d = dot2bf(ua[i].y, xb[1], d); d = dot2bf(ua[i].z, xb[2], d); d = dot2bf(ua[i].w, xb[3], d);
                d = dot2bf(ub[i].x, xb[4], d); d = dot2bf(ub[i].y, xb[5], d); d = dot2bf(ub[i].z, xb[6], d); d = dot2bf(ub[i].w, xb[7], d);
                d = wave_sum(d);
                const float w = g[i] * gelu1(d);
                y[0] += w * bflo(va[i].x); y[1] += w * bfhi(va[i].x); y[2] += w * bflo(va[i].y); y[3] += w * bfhi(va[i].y);
                y[4] += w * bflo(va[i].z); y[5] += w * bfhi(va[i].z); y[6] += w * bflo(va[i].w); y[7] += w * bfhi(va[i].w);
                y[8] += w * bflo(vb[i].x); y[9] += w * bfhi(vb[i].x); y[10] += w * bflo(vb[i].y); y[11] += w * bfhi(vb[i].y);
                y[12] += w * bflo(vb[i].z); y[13] += w * bfhi(vb[i].z); y[14] += w * bflo(vb[i].w); y[15] += w * bfhi(vb[i].w);
            }
        }
        f32x4 o[4]; float s2 = 0.f;
#pragma unroll
        for (int i = 0; i < 4; ++i) { o[i] = hv[i] + (f32x4){y[4 * i], y[4 * i + 1], y[4 * i + 2], y[4 * i + 3]}; s2 += (o[i][0] * o[i][0] + o[i][1] * o[i][1]) + (o[i][2] * o[i][2] + o[i][3] * o[i][3]); }
        const float rf = 1.0f / sqrtf(wave_sum(s2) * (1.f / 1024.f) + EPS_);
        float* op = F.out + (size_t)t * 1024;
        *(f32x4*)(op + 8 * lane) = o[0] * rf * *(const f32x4*)(gfin + 8 * lane);
        *(f32x4*)(op + 8 * lane + 4) = o[1] * rf * *(const f32x4*)(gfin + 8 * lane + 4);
        *(f32x4*)(op + 512 + 8 * lane) = o[2] * rf * *(const f32x4*)(gfin + 512 + 8 * lane);
        *(f32x4*)(op + 512 + 8 * lane + 4) = o[3] * rf * *(const f32x4*)(gfin + 512 + 8 * lane + 4);
    }
}

constexpr int LDS_BYTES = 147456;
constexpr int N_PHASES = 10;
struct Args { const float* in[21]; float* out; unsigned char* ws; int ph_lo, ph_hi; };

__global__ void __launch_bounds__(NTHR, 2) fwd_kernel(Args args) {
    extern __shared__ __attribute__((aligned(16))) unsigned char lds_raw[];
    Frame F;
    F.lds = (LAS unsigned char*)lds_raw;
    F.tid = threadIdx.x; F.lane = F.tid & 63; F.wave = __builtin_amdgcn_readfirstlane(F.tid >> 6);
    F.G = gridDim.x; F.bid = blockIdx.x;
#pragma unroll
    for (int i = 0; i < 21; ++i) F.in[i] = args.in[i];
    F.out = args.out; F.ws = args.ws;
    unsigned char* ws = args.ws;
    F.WIN = (bf16*)(ws + WS_WIN); F.WA = (bf16*)(ws + WS_WA); F.WB = (bf16*)(ws + WS_WB); F.WO = (bf16*)(ws + WS_WO); F.WQS = (bf16*)(ws + WS_WQS);
    F.SGW = (bf16*)(ws + WS_SGW); F.UT = (bf16*)(ws + WS_UT); F.VT = (bf16*)(ws + WS_VT); F.XN = (bf16*)(ws + WS_XN);
    F.Q = (bf16*)(ws + WS_Q); F.K = (bf16*)(ws + WS_K); F.V = (bf16*)(ws + WS_V); F.SU = (bf16*)(ws + WS_SU); F.SV = (bf16*)(ws + WS_SV);
    F.GT = (bf16*)args.out; F.SC = (float*)(ws + WS_SC);
    const int lo = args.ph_lo, hi = args.ph_hi;
#define IN(k) (lo <= (k) && (k) < hi)
#if ONE_LAUNCH
#define SEAM(k) do { if (IN(k) && IN((k) + 1)) { cg::this_grid().sync(); } } while (0)
#else
#define SEAM(k) do { } while (0)
#endif
    if (IN(0)) { p0_prologue(F); } SEAM(0);
    if (IN(1)) { EpiIn E{F.Q, F.K, F.V, F.SU, F.SV, F.GT}; gemm_any(F, F.XN, F.WIN, T_, DIN_, D_, E); } SEAM(1);
    if (IN(2)) { gmlp_naive(F); } SEAM(2);
    if (IN(3)) { attn_naive(F, F.XN, F.SV); } SEAM(3);
    if (IN(4)) { combine_phase(F, F.XN, F.SV); } SEAM(4);
    if (IN(5)) { EpiBrA E{F.GT, F.K}; gemm_any(F, F.XN, F.WA, T_, D_, D_, E); } SEAM(5);
    if (IN(6)) { EpiBrB E{F.GT, F.K, F.Q}; gemm_any(F, F.SU, F.WB, T_, D_, D_, E); } SEAM(6);
    if (IN(7)) { EpiOut E{F.in[0], F.out, F.XN}; gemm_any(F, F.Q, F.WO, T_, D_, D_, E); } SEAM(7);
    if (IN(8)) { EpiSc E{F.SC}; gemm_any(F, F.XN, F.WQS, T_, 2048, D_, E); } SEAM(8);
    if (IN(9)) { peer_phase(F); }
#undef IN
#undef SEAM
}

extern "C" void kernel_launch(void* const* d_in, const int* in_sizes, int n_in, void* d_out, int out_size, void* d_ws, size_t ws_size, hipStream_t stream) {
    static int grid = 0;
    if (grid == 0) {
        if (n_in != 21 || in_sizes[0] != T_ * D_ || out_size != T_ * D_ || ws_size < WS_END) { fprintf(stderr, "kernel_launch: unexpected problem: n_in %d in0 %d out %d ws %zu (need %zu)\n", n_in, n_in > 0 ? in_sizes[0] : -1, out_size, ws_size, (size_t)WS_END); grid = -1; return; }
        int dev = 0, cus = 0, per_cu = 0;
        if (hipGetDevice(&dev) != hipSuccess || hipDeviceGetAttribute(&cus, hipDeviceAttributeMultiprocessorCount, dev) != hipSuccess) { grid = -1; return; }
        if (hipFuncSetAttribute((const void*)fwd_kernel, hipFuncAttributeMaxDynamicSharedMemorySize, LDS_BYTES) != hipSuccess) { fprintf(stderr, "kernel_launch: hipFuncSetAttribute failed\n"); grid = -1; return; }
        if (hipOccupancyMaxActiveBlocksPerMultiprocessor(&per_cu, (const void*)fwd_kernel, NTHR, LDS_BYTES) != hipSuccess || per_cu < 1) { fprintf(stderr, "kernel_launch: occupancy query says %d\n", per_cu); per_cu = 1; }
        (void)hipGetLastError();
        grid = cus;
    }
    if (grid < 0) return;
    Args a{};
    for (int i = 0; i < 21; ++i) a.in[i] = (const float*)d_in[i];
    a.out = (float*)d_out; a.ws = (unsigned char*)d_ws;
#if ONE_LAUNCH
    a.ph_lo = 0; a.ph_hi = N_PHASES;
    void* kargs[] = {&a};
    hipError_t e = hipLaunchCooperativeKernel((const void*)fwd_kernel, dim3(grid), dim3(NTHR), kargs, LDS_BYTES, stream);
    if (e != hipSuccess) fprintf(stderr, "cooperative launch failed: %s (grid %d)\n", hipGetErrorString(e), grid);
#else
    for (int p = 0; p < N_PHASES; ++p) {
        a.ph_lo = p; a.ph_hi = p + 1;
        hipLaunchKernelGGL(fwd_kernel, dim3(grid), dim3(NTHR), LDS_BYTES, stream, a);
    }
#endif
}
```

```cpp
#include <hip/hip_runtime.h>
#include <hip/hip_cooperative_groups.h>
#include <hip/hip_bf16.h>
#include <cstdio>
#include <cstdint>
#include <cmath>
namespace cg = cooperative_groups;

#ifndef USE_PG8
#define USE_PG8 0
#endif
#ifndef USE_ATTN
#define USE_ATTN 0
#endif
#ifndef USE_GMLP
#define USE_GMLP 0
#endif
#ifndef ONE_LAUNCH
#define ONE_LAUNCH 1
#endif
#define GAS __attribute__((address_space(1)))
#define LAS __attribute__((address_space(3)))
typedef unsigned short bf16;
typedef unsigned v4u __attribute__((ext_vector_type(4)));
typedef unsigned v2u __attribute__((ext_vector_type(2)));
typedef float f32x4 __attribute__((ext_vector_type(4)));
typedef float f32x2 __attribute__((ext_vector_type(2)));
typedef short bf16x8 __attribute__((ext_vector_type(8)));
typedef __bf16 bf16x2_t __attribute__((ext_vector_type(2)));

constexpr int NWAVES = 8, NTHR = NWAVES * 64;
constexpr int T_ = 32768, D_ = 1024, S_ = 4096, NB_ = 8, DIN_ = 7168, NEXP_ = 16384;
constexpr float EPS_ = 1e-6f;
constexpr float C2_ = 0.125f * 1.4426950408889634f;
constexpr float LAM_INIT_ = 0.2f;

constexpr size_t MiB = 1u << 20;
constexpr size_t WS_CTL = 0;
constexpr size_t WS_WIN = 2 * MiB;
constexpr size_t WS_WA = 16 * MiB;
constexpr size_t WS_WB = 18 * MiB;
constexpr size_t WS_WO = 20 * MiB;
constexpr size_t WS_WQS = 22 * MiB;
constexpr size_t WS_SGW = 26 * MiB;
constexpr size_t WS_UT = 28 * MiB;
constexpr size_t WS_VT = 60 * MiB;
constexpr size_t WS_XN = 96 * MiB;
constexpr size_t WS_Q = 160 * MiB;
constexpr size_t WS_K = 224 * MiB;
constexpr size_t WS_V = 288 * MiB;
constexpr size_t WS_SU = 352 * MiB;
constexpr size_t WS_SV = 416 * MiB;
constexpr size_t WS_SC = 160 * MiB;
constexpr size_t WS_END = 480 * MiB;

__device__ __forceinline__ unsigned f2bf(float f) { unsigned u = __builtin_bit_cast(unsigned, f); return (u + 0x7fffu + ((u >> 16) & 1u)) >> 16; }
__device__ __forceinline__ unsigned pk2(float lo, float hi) { return f2bf(lo) | (f2bf(hi) << 16); }
__device__ __forceinline__ float bflo(unsigned u) { return __builtin_bit_cast(float, u << 16); }
__device__ __forceinline__ float bfhi(unsigned u) { return __builtin_bit_cast(float, u & 0xffff0000u); }
__device__ __forceinline__ float bf2f(bf16 h) { return __builtin_bit_cast(float, (unsigned)h << 16); }
__device__ __forceinline__ float wave_sum(float v) {
#pragma unroll
    for (int o = 1; o < 64; o <<= 1) v += __shfl_xor(v, o);
    return v;
}
__device__ __forceinline__ float wave_max(float v) {
#pragma unroll
    for (int o = 1; o < 64; o <<= 1) v = fmaxf(v, __shfl_xor(v, o));
    return v;
}
__device__ __forceinline__ float gelu1(float v) {
    const float av = fabsf(v), d = av * 0.2316418882f + 1.0f;
    const float t = __builtin_amdgcn_rcpf(d);
    float q = t * 0.5307027145f + (-0.7265760135f); q = q * t + 0.7107068705f; q = q * t + (-0.142248368f); q = q * t + 0.127414796f; q = q * t;
    const float e = __builtin_amdgcn_exp2f((v * v) * (-0.72134752044f));
    const float m = v * (q * e), r = v - m;
    return v < 0.f ? m : r;
}
__device__ __forceinline__ float sigmoid1(float v) { return __builtin_amdgcn_rcpf(1.0f + __builtin_amdgcn_exp2f(-1.4426950408889634f * v)); }
__device__ __forceinline__ void store4bf(bf16* p, f32x4 v) { v2u w; w.x = pk2(v[0], v[1]); w.y = pk2(v[2], v[3]); *(v2u*)p = w; }

struct Frame {
    LAS unsigned char* lds;
    int tid, lane, wave, G, bid;
    const float* in[21]; float* out; unsigned char* ws;
    bf16 *WIN, *WA, *WB, *WO, *WQS, *SGW, *UT, *VT, *XN, *Q, *K, *V, *SU, *SV, *GT;
    float* SC;
};

__device__ __forceinline__ void p0_transpose_item(const float* W, int K, int N, bf16* WT, LAS float* scr, int item, int lane) {
    const int nblk = N / 32, kb = item / nblk, nb = item % nblk, k0 = 64 * kb, n0 = 32 * nb;
#pragma unroll 8
    for (int i = 0; i < 32; ++i) { const int kk = 2 * i + (lane >> 5); scr[kk * 33 + (lane & 31)] = W[(size_t)(k0 + kk) * N + n0 + (lane & 31)]; }
    asm volatile("s_waitcnt lgkmcnt(0)" ::: "memory");
    const int c = lane & 7;
#pragma unroll
    for (int j = 0; j < 4; ++j) { const int n = (lane >> 3) + 8 * j; const LAS float* s = scr + (8 * c) * 33 + n;
        v4u o; o.x = pk2(s[0 * 33], s[1 * 33]); o.y = pk2(s[2 * 33], s[3 * 33]); o.z = pk2(s[4 * 33], s[5 * 33]); o.w = pk2(s[6 * 33], s[7 * 33]);
        *(v4u*)(WT + (size_t)(n0 + n) * K + k0 + 8 * c) = o; }
    asm volatile("s_waitcnt lgkmcnt(0)" ::: "memory");
}

__device__ __forceinline__ void p0_prologue(Frame& F) {
    LAS float* scr = (LAS float*)(F.lds + F.wave * 16384);
    const int gw = F.bid * NWAVES + F.wave, NGW = F.G * NWAVES;
    const int gt = F.bid * NTHR + F.tid, NGT = F.G * NTHR;
    constexpr int I_IN = (D_ / 64) * (DIN_ / 32), I_SQ = (D_ / 64) * (D_ / 32);
    constexpr int NITEMS = I_IN + 3 * I_SQ;
    for (int it = gw; it < NITEMS; it += NGW) {
        int r = it;
        if (r < I_IN) { p0_transpose_item(F.in[2], D_, DIN_, F.WIN, scr, r, F.lane); continue; } r -= I_IN;
        if (r < I_SQ) { p0_transpose_item(F.in[12], D_, D_, F.WA, scr, r, F.lane); continue; } r -= I_SQ;
        if (r < I_SQ) { p0_transpose_item(F.in[13], D_, D_, F.WB, scr, r, F.lane); continue; } r -= I_SQ;
        p0_transpose_item(F.in[14], D_, D_, F.WO, scr, r, F.lane);
    }
    {
        const float* Wq = F.in[16]; const float* sk = F.in[17]; const float* g2 = F.in[15];
        for (int it = gt; it < 16 * 8 * 1024; it += NGT) {
            const int d = it & 1023, nb = (it >> 10) & 7, sl = it >> 13, p = sl & 1;
            float acc[16];
#pragma unroll
            for (int i = 0; i < 16; ++i) acc[i] = 0.f;
            const float* wrow = Wq + (size_t)d * 2048 + sl * 128;
            const float* skb = sk + (size_t)(p * 128 + nb * 16) * 128;
            for (int c = 0; c < 128; c += 4) {
                const f32x4 w = *(const f32x4*)(wrow + c);
#pragma unroll
                for (int i = 0; i < 16; ++i) { const f32x4 s = *(const f32x4*)(skb + i * 128 + c); acc[i] += w[0] * s[0] + w[1] * s[1] + w[2] * s[2] + w[3] * s[3]; }
            }
            const float g = g2[d];
#pragma unroll
            for (int i = 0; i < 16; ++i) F.WQS[(size_t)(sl * 128 + nb * 16 + i) * 1024 + d] = (bf16)f2bf(acc[i] * g);
        }
    }
    for (int it = gt; it < 8 * 128 * 128; it += NGT) { const int j = it & 127, i = (it >> 7) & 127; const float w = F.in[10][it]; F.SGW[it] = (bf16)f2bf(((i >> 6) >= (j >> 6)) ? w : 0.f); }
    for (int it = gt; it < NEXP_ * D_ / 8; it += NGT) {
        const f32x4 a = ((const f32x4*)F.in[18])[2 * it], b = ((const f32x4*)F.in[18])[2 * it + 1];
        v4u o; o.x = pk2(a[0], a[1]); o.y = pk2(a[2], a[3]); o.z = pk2(b[0], b[1]); o.w = pk2(b[2], b[3]); ((v4u*)F.UT)[it] = o;
        const f32x4 c = ((const f32x4*)F.in[19])[2 * it], d = ((const f32x4*)F.in[19])[2 * it + 1];
        v4u q; q.x = pk2(c[0], c[1]); q.y = pk2(c[2], c[3]); q.z = pk2(d[0], d[1]); q.w = pk2(d[2], d[3]); ((v4u*)F.VT)[it] = q;
    }
    {
        const float* g1 = F.in[1];
        f32x4 gv[4];
#pragma unroll
        for (int j = 0; j < 4; ++j) gv[j] = ((const f32x4*)g1)[F.lane + 64 * j];
        for (int m = gw; m < T_; m += NGW) {
            const f32x4* xr = (const f32x4*)(F.in[0] + (size_t)m * D_) + F.lane;
            f32x4 v[4]; float s = 0.f;
#pragma unroll
            for (int j = 0; j < 4; ++j) { v[j] = xr[64 * j]; s += (v[j][0] * v[j][0] + v[j][1] * v[j][1]) + (v[j][2] * v[j][2] + v[j][3] * v[j][3]); }
            const float rstd = 1.0f / sqrtf(wave_sum(s) * (1.f / D_) + EPS_);
            v2u* o8 = (v2u*)(F.XN + (size_t)m * D_) + F.lane;
#pragma unroll
            for (int j = 0; j < 4; ++j) { v2u w; w.x = pk2(v[j][0] * rstd * gv[j][0], v[j][1] * rstd * gv[j][1]); w.y = pk2(v[j][2] * rstd * gv[j][2], v[j][3] * rstd * gv[j][3]); o8[64 * j] = w; }
        }
    }
}

struct EpiIn {
    bf16 *Q, *K, *V, *SU, *SV, *GT;
    __device__ __forceinline__ void operator()(int row, int col, f32x4 v) const {
        if (col < 1024) { store4bf(Q + (size_t)row * 1024 + col, v * C2_); }
        else if (col < 2048) { store4bf(K + (size_t)row * 1024 + (col - 1024), v); }
        else if (col < 3072) { store4bf(V + (size_t)row * 1024 + (col - 2048), v); }
        else if (col < 4096) { f32x4 g = {gelu1(v[0]), gelu1(v[1]), gelu1(v[2]), gelu1(v[3])}; store4bf(SU + (size_t)row * 1024 + (col - 3072), g); }
        else if (col < 5120) { f32x4 g = {gelu1(v[0]), gelu1(v[1]), gelu1(v[2]), gelu1(v[3])}; store4bf(SV + (size_t)row * 1024 + (col - 4096), g); }
        else { f32x4 g = {sigmoid1(v[0]), sigmoid1(v[1]), sigmoid1(v[2]), sigmoid1(v[3])}; store4bf(GT + (size_t)row * 2048 + (col - 5120), g); }
    }
};
struct EpiBrA {
    const bf16* GT; bf16* TMP;
    __device__ __forceinline__ void operator()(int row, int col, f32x4 v) const {
        const v2u g = *(const v2u*)(GT + (size_t)row * 2048 + col);
        f32x4 o = {v[0] * bflo(g.x), v[1] * bfhi(g.x), v[2] * bflo(g.y), v[3] * bfhi(g.y)};
        store4bf(TMP + (size_t)row * 1024 + col, o);
    }
};
struct EpiBrB {
    const bf16* GT; const bf16* TMP; bf16* MG;
    __device__ __forceinline__ void operator()(int row, int col, f32x4 v) const {
        const v2u g = *(const v2u*)(GT + (size_t)row * 2048 + 1024 + col);
        const v2u t = *(const v2u*)(TMP + (size_t)row * 1024 + col);
        f32x4 o = {bflo(t.x) + v[0] * bflo(g.x), bfhi(t.x) + v[1] * bfhi(g.x), bflo(t.y) + v[2] * bflo(g.y), bfhi(t.y) + v[3] * bfhi(g.y)};
        store4bf(MG + (size_t)row * 1024 + col, o);
    }
};
struct EpiOut {
    const float* X; float* H; bf16* HB;
    __device__ __forceinline__ void operator()(int row, int col, f32x4 v) const {
        const f32x4 x = *(const f32x4*)(X + (size_t)row * 1024 + col);
        const f32x4 h = x + v;
        *(f32x4*)(H + (size_t)row * 1024 + col) = h;
        store4bf(HB + (size_t)row * 1024 + col, h);
    }
};
struct EpiSc {
    float* SC;
    __device__ __forceinline__ void operator()(int row, int col, f32x4 v) const { *(f32x4*)(SC + (size_t)row * 2048 + col) = v; }
};

template <class Fn>
__device__ __forceinline__ void gemm_naive(const bf16* A, const bf16* Bt, int M, int N, int K, const Fn& f, int G, int bid) {
    const int tid = threadIdx.x, wid = tid >> 6, lane = tid & 63;
    const int tilesN = N / 128, ntiles = (M / 128) * tilesN;
    for (int tl = bid; tl < ntiles; tl += G) {
        const int tm = tl / tilesN, tn = tl % tilesN;
        const int m0 = tm * 128 + (wid & 3) * 32, n0 = tn * 128 + (wid >> 2) * 64;
        f32x4 acc[2][4];
#pragma unroll
        for (int i = 0; i < 2; ++i)
#pragma unroll
            for (int j = 0; j < 4; ++j) acc[i][j] = (f32x4){0.f, 0.f, 0.f, 0.f};
        const bf16* ap = A + (size_t)(m0 + (lane & 15)) * K + 8 * (lane >> 4);
        const bf16* bp = Bt + (size_t)(n0 + (lane & 15)) * K + 8 * (lane >> 4);
        for (int k = 0; k < K; k += 32) {
            bf16x8 a[2], b[4];
#pragma unroll
            for (int i = 0; i < 2; ++i) a[i] = *(const bf16x8*)(ap + (size_t)i * 16 * K + k);
#pragma unroll
            for (int j = 0; j < 4; ++j) b[j] = *(const bf16x8*)(bp + (size_t)j * 16 * K + k);
#pragma unroll
            for (int i = 0; i < 2; ++i)
#pragma unroll
                for (int j = 0; j < 4; ++j) acc[i][j] = __builtin_amdgcn_mfma_f32_16x16x32_bf16(b[j], a[i], acc[i][j], 0, 0, 0);
        }
#pragma unroll
        for (int i = 0; i < 2; ++i)
#pragma unroll
            for (int j = 0; j < 4; ++j) f(m0 + i * 16 + (lane & 15), n0 + j * 16 + (lane >> 4) * 4, acc[i][j]);
    }
}

#if USE_PG8
template <class Fn> struct EpiWrap {
    static constexpr bool PERM = false, AFTER_DRAIN = false;
    Fn f;
    __device__ __forceinline__ void operator()(const pg8::f32x4 (&acc)[2][2][4][2], const pg8::Unit& u, int wr, int wc, int fr, int fq) const {
#pragma unroll
        for (int ai = 0; ai < 2; ++ai)
#pragma unroll
            for (int m = 0; m < 4; ++m)
#pragma unroll
                for (int bj = 0; bj < 2; ++bj)
#pragma unroll
                    for (int n = 0; n < 2; ++n)
                        f(u.pm * 256 + ai * 128 + wr * 64 + m * 16 + fr, u.pn * 256 + bj * 128 + wc * 32 + n * 16 + 4 * fq, acc[ai][bj][m][n]);
    }
};
#endif

template <class Fn>
__device__ __forceinline__ void gemm_any(Frame& F, const bf16* A, const bf16* Bt, int M, int N, int K, const Fn& f) {
#if USE_PG8
    pg8::Gemm g{A, Bt, M, N, K}; pg8::StaticOrder S; S.init(M, N, F.G, F.bid);
    EpiWrap<Fn> E{f};
    pg8::gemm_phase<EpiWrap<Fn>, pg8::StaticOrder, true, true>(F.lds, g, S, E);
#else
    gemm_naive(A, Bt, M, N, K, f, F.G, F.bid);
#endif
}

__device__ __forceinline__ void gmlp_naive(Frame& F) {
    LAS float* vn = (LAS float*)F.lds;
    LAS float* Wl = (LAS float*)(F.lds + 65536);
    LAS float* st = (LAS float*)(F.lds + 131072);
    const float* lng = F.in[8]; const float* lnb = F.in[9]; const float* sgw = F.in[10]; const float* sgb = F.in[11];
    for (int u = F.bid; u < T_ / 128; u += F.G) {
        const int r0 = u * 128;
        __syncthreads();
        for (int rr = 0; rr < 16; ++rr) {
            const int j = F.wave * 16 + rr;
            const bf16* row = F.SV + (size_t)(r0 + j) * 1024;
            const v4u a = *(const v4u*)(row + 8 * F.lane), b = *(const v4u*)(row + 512 + 8 * F.lane);
            float x[16] = {bflo(a.x), bfhi(a.x), bflo(a.y), bfhi(a.y), bflo(a.z), bfhi(a.z), bflo(a.w), bfhi(a.w),
                           bflo(b.x), bfhi(b.x), bflo(b.y), bfhi(b.y), bflo(b.z), bfhi(b.z), bflo(b.w), bfhi(b.w)};
            float s = 0.f;
#pragma unroll
            for (int i = 0; i < 16; ++i) s += x[i];
            const float mean = wave_sum(s) * (1.f / 1024.f);
            float q = 0.f;
#pragma unroll
            for (int i = 0; i < 16; ++i) { const float d = x[i] - mean; q += d * d; }
            const float rstd = 1.0f / sqrtf(wave_sum(q) * (1.f / 1024.f) + EPS_);
            if (F.lane == 0) { st[2 * j] = mean; st[2 * j + 1] = rstd; }
        }
        __syncthreads();
        for (int g = 0; g < 8; ++g) {
            for (int idx = F.tid; idx < 16384; idx += NTHR) {
                const int j = idx >> 7, c = idx & 127;
                const float x = bf2f(F.SV[(size_t)(r0 + j) * 1024 + g * 128 + c]);
                vn[idx] = (x - st[2 * j]) * st[2 * j + 1] * lng[g * 128 + c] + lnb[g * 128 + c];
                const int i = j;
                const float w = sgw[(size_t)g * 16384 + idx];
                Wl[idx] = ((i >> 6) >= (c >> 6)) ? w : 0.f;
            }
            __syncthreads();
            const int c = F.tid & 127, rg = F.tid >> 7;
            float acc[32];
#pragma unroll
            for (int ii = 0; ii < 32; ++ii) acc[ii] = 0.f;
            for (int j = 0; j < 128; j += 4) {
                const float v0 = vn[(j + 0) * 128 + c], v1 = vn[(j + 1) * 128 + c], v2 = vn[(j + 2) * 128 + c], v3 = vn[(j + 3) * 128 + c];
#pragma unroll
                for (int ii = 0; ii < 32; ++ii) { const f32x4 w = *(const LAS f32x4*)(Wl + (rg * 32 + ii) * 128 + j); acc[ii] += w[0] * v0 + w[1] * v1 + w[2] * v2 + w[3] * v3; }
            }
#pragma unroll
            for (int ii = 0; ii < 32; ++ii) {
                const int i = rg * 32 + ii; bf16* p = F.SU + (size_t)(r0 + i) * 1024 + g * 128 + c;
                *p = (bf16)f2bf(bf2f(*p) * (acc[ii] + sgb[g * 128 + i]));
            }
            __syncthreads();
        }
    }
}

__device__ __forceinline__ void attn_naive(Frame& F, bf16* O1, bf16* O2) {
    const int gw = F.bid * NWAVES + F.wave, NGW = F.G * NWAVES;
    for (int it = gw; it < NB_ * 16 * S_; it += NGW) {
        const int q = it & (S_ - 1), hm = (it >> 12) & 15, b = it >> 16, head = hm & 7, map = hm >> 3;
        const size_t rowb = (size_t)b * S_;
        float qf[64];
        { const bf16* qp = F.Q + (rowb + q) * 1024 + hm * 64;
#pragma unroll
          for (int i = 0; i < 8; ++i) { const v4u w = *(const v4u*)(qp + 8 * i); qf[8 * i + 0] = bflo(w.x); qf[8 * i + 1] = bfhi(w.x); qf[8 * i + 2] = bflo(w.y); qf[8 * i + 3] = bfhi(w.y); qf[8 * i + 4] = bflo(w.z); qf[8 * i + 5] = bfhi(w.z); qf[8 * i + 6] = bflo(w.w); qf[8 * i + 7] = bfhi(w.w); } }
        float m = -INFINITY, l = 0.f, o0 = 0.f, o1 = 0.f;
        const int nt = (q >> 6) + 1;
        for (int tt = 0; tt < nt; ++tt) {
            const bf16* kp = F.K + (rowb + tt * 64 + F.lane) * 1024 + hm * 64;
            float s = 0.f;
#pragma unroll
            for (int i = 0; i < 8; ++i) { const v4u w = *(const v4u*)(kp + 8 * i);
                s += qf[8 * i + 0] * bflo(w.x) + qf[8 * i + 1] * bfhi(w.x) + qf[8 * i + 2] * bflo(w.y) + qf[8 * i + 3] * bfhi(w.y) + qf[8 * i + 4] * bflo(w.z) + qf[8 * i + 5] * bfhi(w.z) + qf[8 * i + 6] * bflo(w.w) + qf[8 * i + 7] * bfhi(w.w); }
            const float mt = wave_max(s), mn = fmaxf(m, mt), al = __builtin_amdgcn_exp2f(m - mn), p = __builtin_amdgcn_exp2f(s - mn);
            l = l * al + wave_sum(p); o0 *= al; o1 *= al; m = mn;
            const bf16* vp = F.V + (rowb + tt * 64) * 1024 + head * 128 + 2 * F.lane;
            for (int j = 0; j < 64; ++j) { const float pj = __shfl(p, j); const unsigned w = *(const unsigned*)(vp + (size_t)j * 1024); o0 += pj * bflo(w); o1 += pj * bfhi(w); }
        }
        const float il = 1.0f / l;
        bf16* op = (map ? O2 : O1) + (rowb + q) * 1024 + head * 128 + 2 * F.lane;
        *(unsigned*)op = pk2(o0 * il, o1 * il);
    }
}

__device__ __forceinline__ void combine_phase(Frame& F, bf16* O1, const bf16* O2) {
    const int gw = F.bid * NWAVES + F.wave, NGW = F.G * NWAVES;
    const float s1 = wave_sum(F.in[3][F.lane] * F.in[4][F.lane]), s2 = wave_sum(F.in[5][F.lane] * F.in[6][F.lane]);
    const float lam = expf(s1) - expf(s2) + LAM_INIT_;
    float sg[16];
#pragma unroll
    for (int i = 0; i < 16; ++i) sg[i] = F.in[7][(16 * F.lane + i) & 127] * (1.0f - LAM_INIT_);
    for (int t = gw; t < T_; t += NGW) {
        bf16* p1 = O1 + (size_t)t * 1024 + 16 * F.lane; const bf16* p2 = O2 + (size_t)t * 1024 + 16 * F.lane;
        const v4u a0 = *(const v4u*)p1, a1 = *(const v4u*)(p1 + 8), b0 = *(const v4u*)p2, b1 = *(const v4u*)(p2 + 8);
        float d[16] = {bflo(a0.x) - lam * bflo(b0.x), bfhi(a0.x) - lam * bfhi(b0.x), bflo(a0.y) - lam * bflo(b0.y), bfhi(a0.y) - lam * bfhi(b0.y),
                       bflo(a0.z) - lam * bflo(b0.z), bfhi(a0.z) - lam * bfhi(b0.z), bflo(a0.w) - lam * bflo(b0.w), bfhi(a0.w) - lam * bfhi(b0.w),
                       bflo(a1.x) - lam * bflo(b1.x), bfhi(a1.x) - lam * bfhi(b1.x), bflo(a1.y) - lam * bflo(b1.y), bfhi(a1.y) - lam * bfhi(b1.y),
                       bflo(a1.z) - lam * bflo(b1.z), bfhi(a1.z) - lam * bfhi(b1.z), bflo(a1.w) - lam * bflo(b1.w), bfhi(a1.w) - lam * bfhi(b1.w)};
        float ss = 0.f;
#pragma unroll
        for (int i = 0; i < 16; ++i) ss += d[i] * d[i];
        ss += __shfl_xor(ss, 1); ss += __shfl_xor(ss, 2); ss += __shfl_xor(ss, 4);
        const float r = 1.0f / sqrtf(ss * (1.f / 128.f) + EPS_);
        v4u o0, o1;
        o0.x = pk2(d[0] * r * sg[0], d[1] * r * sg[1]); o0.y = pk2(d[2] * r * sg[2], d[3] * r * sg[3]); o0.z = pk2(d[4] * r * sg[4], d[5] * r * sg[5]); o0.w = pk2(d[6] * r * sg[6], d[7] * r * sg[7]);
        o1.x = pk2(d[8] * r * sg[8], d[9] * r * sg[9]); o1.y = pk2(d[10] * r * sg[10], d[11] * r * sg[11]); o1.z = pk2(d[12] * r * sg[12], d[13] * r * sg[13]); o1.w = pk2(d[14] * r * sg[14], d[15] * r * sg[15]);
        *(v4u*)p1 = o0; *(v4u*)(p1 + 8) = o1;
    }
}

__device__ const unsigned char CAND_IJ[56] = {
    0x00, 0x01, 0x02, 0x03, 0x04, 0x05, 0x06, 0x07, 0x08, 0x09, 0x0a, 0x0b, 0x0c, 0x0d, 0x0e, 0x0f,
    0x10, 0x11, 0x12, 0x13, 0x14, 0x15, 0x16, 0x17,
    0x20, 0x21, 0x22, 0x23, 0x24,
    0x30, 0x31, 0x32, 0x33,
    0x40, 0x41, 0x42,
    0x50, 0x51, 0x60, 0x61, 0x70, 0x71,
    0x80, 0x90, 0xa0, 0xb0, 0xc0, 0xd0, 0xe0, 0xf0,
    0xff, 0xff, 0xff, 0xff, 0xff, 0xff};
__device__ __forceinline__ unsigned fkey(float f) { const unsigned b = __builtin_bit_cast(unsigned, f); return b ^ ((unsigned)((int)b >> 31) | 0x80000000u); }
__device__ __forceinline__ float keyf(unsigned k) { const unsigned b = (k & 0x80000000u) ? (k ^ 0x80000000u) : ~k; return __builtin_bit_cast(float, b); }
#define DPP_U(x, ctrl) ((unsigned)__builtin_amdgcn_update_dpp(0, (int)(x), (ctrl), 0xf, 0xf, false))
#define DPP_F(x, ctrl) __builtin_bit_cast(float, __builtin_amdgcn_update_dpp(0, __builtin_bit_cast(int, (float)(x)), (ctrl), 0xf, 0xf, false))
__device__ __forceinline__ unsigned umax_(unsigned a, unsigned b) { return a > b ? a : b; }
__device__ __forceinline__ unsigned umin_(unsigned a, unsigned b) { return a < b ? a : b; }
__device__ __forceinline__ unsigned rowmax16_u(unsigned v) {
    v = umax_(v, DPP_U(v, 0xB1)); v = umax_(v, DPP_U(v, 0x4E)); v = umax_(v, DPP_U(v, 0x141)); v = umax_(v, DPP_U(v, 0x140)); return v; }
__device__ __forceinline__ unsigned grpmax8_u(unsigned v) {
    v = umax_(v, DPP_U(v, 0xB1)); v = umax_(v, DPP_U(v, 0x4E)); v = umax_(v, DPP_U(v, 0x141)); return v; }
__device__ __forceinline__ float grpmax8_f(float v) { v = fmaxf(v, DPP_F(v, 0xB1)); v = fmaxf(v, DPP_F(v, 0x4E)); v = fmaxf(v, DPP_F(v, 0x141)); return v; }
__device__ __forceinline__ float grpsum8_f(float v) { v += DPP_F(v, 0xB1); v += DPP_F(v, 0x4E); v += DPP_F(v, 0x141); return v; }
#define CEX(a, b) do { const unsigned _hi = umax_(a, b), _lo = umin_(a, b); a = _hi; b = _lo; } while (0)

__device__ __forceinline__ float dot2bf(unsigned a, unsigned b, float acc) { return __builtin_amdgcn_fdot2_f32_bf16(__builtin_bit_cast(bf16x2_t, a), __builtin_bit_cast(bf16x2_t, b), acc, false); }

__device__ __forceinline__ void peer_phase(Frame& F) {
    const int lane = F.lane, gw = F.bid * NWAVES + F.wave, NGW = F.G * NWAVES;
    LAS unsigned* kl = (LAS unsigned*)(F.lds + F.wave * 2048);
    LAS int* exl = (LAS int*)(F.lds + F.wave * 2048 + 1024);
    LAS float* gtl = (LAS float*)(F.lds + F.wave * 2048 + 1536);
    const float* g2 = F.in[15]; const float* gfin = F.in[20];
    const float* H = F.out;
    const int li = lane & 15, rho = lane >> 4;
    for (int t = gw; t < T_; t += NGW) {
        const float* hp = H + (size_t)t * 1024;
        f32x4 hv[4]; hv[0] = *(const f32x4*)(hp + 8 * lane); hv[1] = *(const f32x4*)(hp + 8 * lane + 4); hv[2] = *(const f32x4*)(hp + 512 + 8 * lane); hv[3] = *(const f32x4*)(hp + 512 + 8 * lane + 4);
        float ss = 0.f;
#pragma unroll
        for (int i = 0; i < 4; ++i) ss += (hv[i][0] * hv[i][0] + hv[i][1] * hv[i][1]) + (hv[i][2] * hv[i][2] + hv[i][3] * hv[i][3]);
        const float rstd2 = 1.0f / sqrtf(wave_sum(ss) * (1.f / 1024.f) + EPS_);
        unsigned xb[8];
        {
            f32x4 gg[4]; gg[0] = *(const f32x4*)(g2 + 8 * lane); gg[1] = *(const f32x4*)(g2 + 8 * lane + 4); gg[2] = *(const f32x4*)(g2 + 512 + 8 * lane); gg[3] = *(const f32x4*)(g2 + 512 + 8 * lane + 4);
#pragma unroll
            for (int i = 0; i < 4; ++i) { xb[2 * i] = pk2(hv[i][0] * rstd2 * gg[i][0], hv[i][1] * rstd2 * gg[i][1]); xb[2 * i + 1] = pk2(hv[i][2] * rstd2 * gg[i][2], hv[i][3] * rstd2 * gg[i][3]); }
        }
        const float* sp = F.SC + (size_t)t * 2048;
#pragma unroll 1
        for (int r = 0; r < 4; ++r) {
            const int gi = 4 * r + rho;
            const f32x4 s0 = *(const f32x4*)(sp + gi * 128 + 8 * li), s1 = *(const f32x4*)(sp + gi * 128 + 8 * li + 4);
            unsigned k0 = (fkey(s0[0]) & ~127u) | (unsigned)(127 - (8 * li + 0)), k1 = (fkey(s0[1]) & ~127u) | (unsigned)(127 - (8 * li + 1)),
                     k2 = (fkey(s0[2]) & ~127u) | (unsigned)(127 - (8 * li + 2)), k3 = (fkey(s0[3]) & ~127u) | (unsigned)(127 - (8 * li + 3)),
                     k4 = (fkey(s1[0]) & ~127u) | (unsigned)(127 - (8 * li + 4)), k5 = (fkey(s1[1]) & ~127u) | (unsigned)(127 - (8 * li + 5)),
                     k6 = (fkey(s1[2]) & ~127u) | (unsigned)(127 - (8 * li + 6)), k7 = (fkey(s1[3]) & ~127u) | (unsigned)(127 - (8 * li + 7));
            CEX(k0, k1); CEX(k2, k3); CEX(k4, k5); CEX(k6, k7);
            CEX(k0, k2); CEX(k1, k3); CEX(k4, k6); CEX(k5, k7);
            CEX(k1, k2); CEX(k5, k6); CEX(k0, k4); CEX(k3, k7);
            CEX(k1, k5); CEX(k2, k6);
            CEX(k1, k4); CEX(k3, k6);
            CEX(k2, k4); CEX(k3, k5);
            CEX(k3, k4);
            unsigned rec = 0u;
#pragma unroll
            for (int itx = 0; itx < 16; ++itx) {
                const unsigned m = rowmax16_u(k0);
                rec = (li == itx) ? m : rec;
                const bool own = (k0 == m);
                k0 = own ? k1 : k0; k1 = own ? k2 : k1; k2 = own ? k3 : k2; k3 = own ? k4 : k3; k4 = own ? k5 : k4; k5 = own ? k6 : k5; k6 = own ? k7 : k6; k7 = own ? 0u : k7;
            }
            kl[gi * 16 + li] = rec;
        }
        asm volatile("s_waitcnt lgkmcnt(0)" ::: "memory");
        {
            const int hh = lane >> 3, q8 = lane & 7;
            unsigned c[7];
#pragma unroll
            for (int mth = 0; mth < 7; ++mth) {
                const int cid = q8 + 8 * mth; const unsigned ij = CAND_IJ[cid];
                if (ij == 0xffu) { c[mth] = 0u; }
                else { const unsigned ka = kl[(2 * hh) * 16 + (ij >> 4)], kb = kl[(2 * hh + 1) * 16 + (ij & 15)];
                       const float sum = keyf(ka & ~127u) + keyf(kb & ~127u);
                       c[mth] = (fkey(sum) & ~63u) | (unsigned)(63 - cid); }
            }
            CEX(c[0], c[6]); CEX(c[2], c[3]); CEX(c[4], c[5]);
            CEX(c[0], c[2]); CEX(c[1], c[4]); CEX(c[3], c[6]);
            CEX(c[0], c[1]); CEX(c[2], c[5]); CEX(c[3], c[4]);
            CEX(c[1], c[2]); CEX(c[4], c[6]);
            CEX(c[2], c[3]); CEX(c[4], c[5]);
            CEX(c[1], c[2]); CEX(c[3], c[4]); CEX(c[5], c[6]);
            unsigned rec0 = 0u, rec1 = 0u;
#pragma unroll
            for (int itx = 0; itx < 16; ++itx) {
                const unsigned m = grpmax8_u(c[0]);
                if (itx < 8) rec0 = (q8 == itx) ? m : rec0; else rec1 = (q8 == itx - 8) ? m : rec1;
                const bool own = (c[0] == m);
                c[0] = own ? c[1] : c[0]; c[1] = own ? c[2] : c[1]; c[2] = own ? c[3] : c[2]; c[3] = own ? c[4] : c[3]; c[4] = own ? c[5] : c[4]; c[5] = own ? c[6] : c[5]; c[6] = own ? 0u : c[6];
            }
            const int cid0 = 63 - (int)(rec0 & 63u), cid1 = 63 - (int)(rec1 & 63u);
            const unsigned ij0 = CAND_IJ[cid0], ij1 = CAND_IJ[cid1];
            const int e0 = (127 - (int)(kl[(2 * hh) * 16 + (ij0 >> 4)] & 127u)) * 128 + (127 - (int)(kl[(2 * hh + 1) * 16 + (ij0 & 15)] & 127u));
            const int e1 = (127 - (int)(kl[(2 * hh) * 16 + (ij1 >> 4)] & 127u)) * 128 + (127 - (int)(kl[(2 * hh + 1) * 16 + (ij1 & 15)] & 127u));
            const float v0 = keyf(rec0 & ~63u) * rstd2, v1 = keyf(rec1 & ~63u) * rstd2;
            const float mx = grpmax8_f(fmaxf(v0, v1));
            const float x0 = __expf(v0 - mx), x1 = __expf(v1 - mx);
            const float inv = 1.0f / grpsum8_f(x0 + x1);
            exl[hh * 16 + q8] = e0; exl[hh * 16 + 8 + q8] = e1;
            gtl[hh * 16 + q8] = x0 * inv; gtl[hh * 16 + 8 + q8] = x1 * inv;
        }
        asm volatile("s_waitcnt lgkmcnt(0)" ::: "memory");
        float y[16];
#pragma unroll
        for (int i = 0; i < 16; ++i) y[i] = 0.f;
#pragma unroll 1
        for (int ch = 0; ch < 32; ++ch) {
            int e[4]; float g[4];
#pragma unroll
            for (int i = 0; i < 4; ++i) { e[i] = __builtin_amdgcn_readfirstlane(exl[ch * 4 + i]); g[i] = __builtin_bit_cast(float, __builtin_amdgcn_readfirstlane(__builtin_bit_cast(int, gtl[ch * 4 + i]))); }
            v4u ua[4], ub[4], va[4], vb[4];
#pragma unroll
            for (int i = 0; i < 4; ++i) {
                const bf16* ur = F.UT + (size_t)e[i] * 1024; const bf16* vr = F.VT + (size_t)e[i] * 1024;
                ua[i] = *(const v4u*)(ur + 8 * lane); ub[i] = *(const v4u*)(ur + 512 + 8 * lane);
                va[i] = *(const v4u*)(vr + 8 * lane); vb[i] = *(const v4u*)(vr + 512 + 8 * lane);
            }
#pragma unroll
            for (int i = 0; i < 4; ++i) {
                float d = 0.f;
                d = dot2bf(ua[i].x, xb[0], d); d = dot2bf(ua[i].y, xb[1], d); d = dot2bf(ua[i].z, xb[2], d); d = dot2bf(ua[i].w, xb[3], d);
                d = dot2bf(ub[i].x, xb[4], d); d = dot2bf(ub[i].y, xb[5], d); d = dot2bf(ub[i].z, xb[6], d); d = dot2bf(ub[i].w, xb[7], d);
                d = wave_sum(d);
                const float w = g[i] * gelu1(d);
                y[0] += w * bflo(va[i].x); y[1] += w * bfhi(va[i].x); y[2] += w * bflo(va[i].y); y[3] += w * bfhi(va[i].y);
                y[4] += w * bflo(va[i].z); y[5] += w * bfhi(va[i].z); y[6] += w * bflo(va[i].w); y[7] += w * bfhi(va[i].w);
                y[8] += w * bflo(vb[i].x); y[9] += w * bfhi(vb[i].x); y[10] += w * bflo(vb[i].y); y[11] += w * bfhi(vb[i].y);
                y[12] += w * bflo(vb[i].z); y[13] += w * bfhi(vb[i].z); y[14] += w * bflo(vb[i].w); y[15] += w * bfhi(vb[i].w);
            }
        }
        f32x4 o[4]; float s2 = 0.f;
#pragma unroll
        for (int i = 0; i < 4; ++i) { o[i] = hv[i] + (f32x4){y[4 * i], y[4 * i + 1], y[4 * i + 2], y[4 * i + 3]}; s2 += (o[i][0] * o[i][0] + o[i][1] * o[i][1]) + (o[i][2] * o[i][2] + o[i][3] * o[i][3]); }
        const float rf = 1.0f / sqrtf(wave_sum(s2) * (1.f / 1024.f) + EPS_);
        float* op = F.out + (size_t)t * 1024;
        *(f32x4*)(op + 8 * lane) = o[0] * rf * *(const f32x4*)(gfin + 8 * lane);
        *(f32x4*)(op + 8 * lane + 4) = o[1] * rf * *(const f32x4*)(gfin + 8 * lane + 4);
        *(f32x4*)(op + 512 + 8 * lane) = o[2] * rf * *(const f32x4*)(gfin + 512 + 8 * lane);
        *(f32x4*)(op + 512 + 8 * lane + 4) = o[3] * rf * *(const f32x4*)(gfin + 512 + 8 * lane + 4);
    }
}

constexpr int LDS_BYTES = 147456;
constexpr int N_PHASES = 10;
struct Args { const float* in[21]; float* out; unsigned char* ws; int ph_lo, ph_hi; };

__global__ void __launch_bounds__(NTHR, 2) fwd_kernel(Args args) {
    extern __shared__ __attribute__((aligned(16))) unsigned char lds_raw[];
    Frame F;
    F.lds = (LAS unsigned char*)lds_raw;
    F.tid = threadIdx.x; F.lane = F.tid & 63; F.wave = __builtin_amdgcn_readfirstlane(F.tid >> 6);
    F.G = gridDim.x; F.bid = blockIdx.x;
#pragma unroll
    for (int i = 0; i < 21; ++i) F.in[i] = args.in[i];
    F.out = args.out; F.ws = args.ws;
    unsigned char* ws = args.ws;
    F.WIN = (bf16*)(ws + WS_WIN); F.WA = (bf16*)(ws + WS_WA); F.WB = (bf16*)(ws + WS_WB); F.WO = (bf16*)(ws + WS_WO); F.WQS = (bf16*)(ws + WS_WQS);
    F.SGW = (bf16*)(ws + WS_SGW); F.UT = (bf16*)(ws + WS_UT); F.VT = (bf16*)(ws + WS_VT); F.XN = (bf16*)(ws + WS_XN);
    F.Q = (bf16*)(ws + WS_Q); F.K = (bf16*)(ws + WS_K); F.V = (bf16*)(ws + WS_V); F.SU = (bf16*)(ws + WS_SU); F.SV = (bf16*)(ws + WS_SV);
    F.GT = (bf16*)args.out; F.SC = (float*)(ws + WS_SC);
    const int lo = args.ph_lo, hi = args.ph_hi;
#define IN(k) (lo <= (k) && (k) < hi)
#if ONE_LAUNCH
#define SEAM(k) do { if (IN(k) && IN((k) + 1)) { cg::this_grid().sync(); } } while (0)
#else
#define SEAM(k) do { } while (0)
#endif
    if (IN(0)) { p0_prologue(F); } SEAM(0);
    if (IN(1)) { EpiIn E{F.Q, F.K, F.V, F.SU, F.SV, F.GT}; gemm_any(F, F.XN, F.WIN, T_, DIN_, D_, E); } SEAM(1);
    if (IN(2)) { gmlp_naive(F); } SEAM(2);
    if (IN(3)) { attn_naive(F, F.XN, F.SV); } SEAM(3);
    if (IN(4)) { combine_phase(F, F.XN, F.SV); } SEAM(4);
    if (IN(5)) { EpiBrA E{F.GT, F.K}; gemm_any(F, F.XN, F.WA, T_, D_, D_, E); } SEAM(5);
    if (IN(6)) { EpiBrB E{F.GT, F.K, F.Q}; gemm_any(F, F.SU, F.WB, T_, D_, D_, E); } SEAM(6);
    if (IN(7)) { EpiOut E{F.in[0], F.out, F.XN}; gemm_any(F, F.Q, F.WO, T_, D_, D_, E); } SEAM(7);
    if (IN(8)) { EpiSc E{F.SC}; gemm_any(F, F.XN, F.WQS, T_, 2048, D_, E); } SEAM(8);
    if (IN(9)) { peer_phase(F); }
#undef IN
#undef SEAM
}

extern "C" void kernel_launch(void* const* d_in, const int* in_sizes, int n_in, void* d_out, int out_size, void* d_ws, size_t ws_size, hipStream_t stream) {
    static int grid = 0;
    if (grid == 0) {
        if (n_in != 21 || in_sizes[0] != T_ * D_ || out_size != T_ * D_ || ws_size < WS_END) { fprintf(stderr, "kernel_launch: unexpected problem: n_in %d in0 %d out %d ws %zu (need %zu)\n", n_in, n_in > 0 ? in_sizes[0] : -1, out_size, ws_size, (size_t)WS_END); grid = -1; return; }
        int dev = 0, cus = 0, per_cu = 0;
        if (hipGetDevice(&dev) != hipSuccess || hipDeviceGetAttribute(&cus, hipDeviceAttributeMultiprocessorCount, dev) != hipSuccess) { grid = -1; return; }
        if (hipFuncSetAttribute((const void*)fwd_kernel, hipFuncAttributeMaxDynamicSharedMemorySize, LDS_BYTES) != hipSuccess) { fprintf(stderr, "kernel_launch: hipFuncSetAttribute failed\n"); grid = -1; return; }
        if (hipOccupancyMaxActiveBlocksPerMultiprocessor(&per_cu, (const void*)fwd_kernel, NTHR, LDS_BYTES) != hipSuccess || per_cu < 1) { fprintf(stderr, "kernel_launch: occupancy query says %d\n", per_cu); per_cu = 1; }
        (void)hipGetLastError();
        grid = cus;
    }
    if (grid < 0) return;
    Args a{};
    for (int i = 0; i < 21; ++i) a.in[i] = (const float*)d_in[i];
    a.out = (float*)d_out; a.ws = (unsigned char*)d_ws;
#if ONE_LAUNCH
    a.ph_lo = 0; a.ph_hi = N_PHASES;
    void* kargs[] = {&a};
    hipError_t e = hipLaunchCooperativeKernel((const void*)fwd_kernel, dim3(grid), dim3(NTHR), kargs, LDS_BYTES, stream);
    if (e != hipSuccess) fprintf(stderr, "cooperative launch failed: %s (grid %d)\n", hipGetErrorString(e), grid);
#else
    for (int p = 0; p < N_PHASES; ++p) {
        a.ph_lo = p; a.ph_hi = p + 1;
        hipLaunchKernelGGL(fwd_kernel, dim3(grid), dim3(NTHR), LDS_BYTES, stream, a);
    }
#endif
}
```

```cpp
#include <hip/hip_runtime.h>
#include <hip/hip_cooperative_groups.h>
#include <hip/hip_bf16.h>
#include <cstdio>
#include <cstdint>
#include <cmath>
namespace cg = cooperative_groups;

#ifndef USE_PG8
#define USE_PG8 1
#endif
#ifndef USE_ATTN
#define USE_ATTN 1
#endif
#ifndef USE_GMLP
#define USE_GMLP 1
#endif
#ifndef ONE_LAUNCH
#define ONE_LAUNCH 1
#endif
#ifndef PROBE_K
#define PROBE_K -1
#endif
#ifndef PEER_VARIANT
#define PEER_VARIANT 0
#endif
#ifndef USE_PEER2
#define USE_PEER2 3
#endif
#ifndef PEER2_FIXED
#define PEER2_FIXED 0
#endif
#ifndef PEER_XSYNC
#define PEER_XSYNC 0
#endif
#ifndef PEER_NR
#define PEER_NR 16
#endif
#ifndef DBG_LIST
#define DBG_LIST 0
#endif
#ifndef DBG_VSIMPLE
#define DBG_VSIMPLE 0
#endif
#ifndef DBG_VSEL
#define DBG_VSEL 15
#endif
#ifndef PVT
#define PVT 4
#endif
#ifndef PG8_WGM
#define PG8_WGM 8
#endif
#ifndef PEER_UV_BARRIER
#define PEER_UV_BARRIER 0
#endif
#ifndef EPI_PLAIN
#define EPI_PLAIN 0
#endif
#ifndef PG8_ALIGN_EPI
#define PG8_ALIGN_EPI 1
#endif
#ifndef DBG_ATTN_QB
#define DBG_ATTN_QB -1
#endif
#ifndef PLAIN_LAUNCH
#define PLAIN_LAUNCH 0
#endif
#ifndef EPI_SKIP
#define EPI_SKIP 0
#endif
#ifndef STAGGER
#define STAGGER 1
#endif
#ifndef SKEW_TEST
#define SKEW_TEST 0
#endif
#ifndef ST_SC1
#define ST_SC1 0
#endif
#ifndef PG8_RELAX
#define PG8_RELAX 0
#endif
#ifndef XLOCAL
#define XLOCAL 1
#endif
#ifndef P2_SPLIT
#define P2_SPLIT 1
#endif
#ifndef P0_XROWS
#define P0_XROWS 8
#endif
#ifndef PG8_SP2X
#define PG8_SP2X 1
#endif
namespace pg8 {
#define PG8_LAS __attribute__((address_space(3)))
typedef unsigned short bf16_t;
typedef short bf16x8 __attribute__((ext_vector_type(8)));
typedef float f32x4 __attribute__((ext_vector_type(4)));
typedef unsigned u32x4 __attribute__((ext_vector_type(4)));
constexpr int BM = 256, BK = 64, HALF = 128, HTB = HALF * BK * 2  , STAGE_BYTES = 8 * HTB, NXCD = 8, WGM = PG8_WGM;

__host__ __device__ __forceinline__ int lds_byte(int r, int c) { const int st = (r >> 4) * 2 + (c >> 5), rr = r & 15, cc = c & 31, ob = rr * 64 + cc * 2; return st * 1024 + (ob ^ (((ob >> 9) & 1) << 5)); }
__host__ __device__ __forceinline__ void stage_rc(int b, int& R, int& C) { const int st = b / 1024, sb = b % 1024, swz = sb ^ (((sb >> 9) & 1) << 5); R = (st >> 1) * 16 + swz / 64; C = (st & 1) * 32 + (swz % 64) / 2; }
__host__ __device__ __forceinline__ int perm32(int rho) { const int n = rho >> 4, i = rho & 15; return 8 * (i >> 2) + 4 * n + (i & 3); }

struct Unit { int pm, pn; };
struct Gemm { const bf16_t* A; const bf16_t* Bt; int M, N, K; int nseg; long dA, dB; };

struct StaticOrder {
    int nM, nN, nwg, G, c;
    __host__ __device__ void init(int M, int N, int G_, int c_) { nM = M / BM; nN = N / BM; nwg = nM * nN; G = G_; c = c_; }
    __host__ __device__ bool next(int i, Unit& u) const {
        const long L = (long)i * G + c; if (L >= nwg) return false;
        int wgid = (int)L; { const int q = nwg / NXCD, r = nwg % NXCD, xcd = wgid % NXCD, off = wgid / NXCD; wgid = (xcd < r ? xcd * (q + 1) : r * (q + 1) + (xcd - r) * q) + off; }
        const int nig = WGM * nN, gid = wgid / nig, fm = gid * WGM, gsz = (nM - fm) < WGM ? (nM - fm) : WGM;
        u.pm = fm + ((wgid % nig) % gsz); u.pn = (wgid % nig) / gsz; return true;
    }
    __device__ __forceinline__ void a_ready(const Unit&) const {}
    __device__ __forceinline__ void done(const Unit&) const {}
};

__device__ __forceinline__ unsigned cvt_pk_bf16(float lo, float hi) { unsigned r; asm volatile("v_cvt_pk_bf16_f32 %0, %1, %2" : "=v"(r) : "v"(lo), "v"(hi)); return r; }
typedef float f32x2 __attribute__((ext_vector_type(2)));
__device__ __forceinline__ f32x2 gelu_pk(f32x2 v) {
    const f32x2 av = __builtin_elementwise_abs(v), d = av * 0.2316418882f + 1.0f;
    f32x2 t; t.x = __builtin_amdgcn_rcpf(d.x); t.y = __builtin_amdgcn_rcpf(d.y);
    f32x2 q = t * 0.5307027145f + (-0.7265760135f); q = q * t + 0.7107068705f; q = q * t + (-0.142248368f); q = q * t + 0.127414796f; q = q * t;
    const f32x2 s = (v * v) * (-0.72134752044f);
    f32x2 e; e.x = __builtin_amdgcn_exp2f(s.x); e.y = __builtin_amdgcn_exp2f(s.y);
    const f32x2 m = v * (q * e), r = v - m;
    f32x2 o; o.x = v.x < 0.f ? m.x : r.x; o.y = v.y < 0.f ? m.y : r.y; return o;
}

template <int ACT  > struct EpiBf16 {
    static constexpr bool PERM = true, AFTER_DRAIN = false; static_assert(ACT == 0 || ACT == 1, "EpiBf16: ACT is 0 (none) or 1 (gelu_pk)");
    bf16_t* O; int ldc; const float* bias; int split_cols; size_t split_stride; float scale0;
    __device__ __forceinline__ void operator()(const f32x4 (&acc)[2][2][4][2], const Unit& u, int wr, int wc, int fr, int fq) const {
        const int row0 = u.pm * BM + wr * 64 + fr; int colt = u.pn * BM; bf16_t* base = O;
        float sc = 1.f; if (split_cols) { const int t = colt / split_cols; base += (size_t)t * split_stride; colt -= t * split_cols; if (t == 0) sc = scale0; }
        const int col0 = colt + wc * 32 + 8 * fq, bcol0 = u.pn * BM + wc * 32 + 8 * fq;
        f32x4 bv[2][2];
#pragma unroll
        for (int bj = 0; bj < 2; ++bj)
#pragma unroll
            for (int n = 0; n < 2; ++n) bv[bj][n] = bias ? *(const f32x4*)(bias + bcol0 + bj * HALF + 4 * n) : (f32x4){0.f, 0.f, 0.f, 0.f};
#pragma unroll
        for (int ai = 0; ai < 2; ++ai)
#pragma unroll
            for (int m = 0; m < 4; ++m) { bf16_t* rowp = base + (size_t)(row0 + ai * HALF + m * 16) * ldc + col0;
#pragma unroll
                for (int bj = 0; bj < 2; ++bj) { f32x4 v0 = acc[ai][bj][m][0] + bv[bj][0], v1 = acc[ai][bj][m][1] + bv[bj][1];
                    if (ACT == 1) { f32x2 a = gelu_pk((f32x2){v0[0], v0[1]}), b = gelu_pk((f32x2){v0[2], v0[3]}), c = gelu_pk((f32x2){v1[0], v1[1]}), d = gelu_pk((f32x2){v1[2], v1[3]});
                        v0 = (f32x4){a.x, a.y, b.x, b.y}; v1 = (f32x4){c.x, c.y, d.x, d.y}; }
                    v0 = v0 * sc; v1 = v1 * sc; u32x4 w; w.x = cvt_pk_bf16(v0[0], v0[1]); w.y = cvt_pk_bf16(v0[2], v0[3]); w.z = cvt_pk_bf16(v1[0], v1[1]); w.w = cvt_pk_bf16(v1[2], v1[3]);
                    *(u32x4*)(rowp + bj * HALF) = w; } }
    }
};

struct PanelStats {
    unsigned* xbuf;
    unsigned* cnt;
    unsigned* tmo;
    int ntn; float eps;
    unsigned code;
    __device__ __forceinline__ bool run(const f32x4 (&v)[2][2][4][2], const Unit& u, int wr, int wc, int fr, int fq, PG8_LAS unsigned char* lds, int wid, int lane) const {
        typedef float f32x2v __attribute__((ext_vector_type(2)));
        PG8_LAS f32x2v* P = (PG8_LAS f32x2v*)lds;
        PG8_LAS f32x2v* S = (PG8_LAS f32x2v*)(lds + 8192);
        PG8_LAS unsigned* flag = (PG8_LAS unsigned*)(lds + 8192 + 2048);
#pragma unroll
        for (int ai = 0; ai < 2; ++ai)
#pragma unroll
            for (int m = 0; m < 4; ++m) {
                float s = 0.f;
#pragma unroll
                for (int bj = 0; bj < 2; ++bj)
#pragma unroll
                    for (int n = 0; n < 2; ++n) { const f32x4 x = v[ai][bj][m][n]; s += (x[0] + x[1]) + (x[2] + x[3]); }
                s += __shfl_xor(s, 16); s += __shfl_xor(s, 32);
                const float mw = s * (1.0f / 64.0f); float q = 0.f;
#pragma unroll
                for (int bj = 0; bj < 2; ++bj)
#pragma unroll
                    for (int n = 0; n < 2; ++n) { const f32x4 d = v[ai][bj][m][n] - mw; q += (d[0] * d[0] + d[1] * d[1]) + (d[2] * d[2] + d[3] * d[3]); }
                q += __shfl_xor(q, 16); q += __shfl_xor(q, 32);
                if (fq == 0) P[(ai * HALF + wr * 64 + m * 16 + fr) * 4 + wc] = (f32x2v){mw, q};
            }
        asm volatile("s_waitcnt lgkmcnt(0)" ::: "memory"); __builtin_amdgcn_s_barrier(); asm volatile("" ::: "memory");
#if defined(BROKEN_EXCHANGE_NO_WAIT)
#warning BROKEN CONTROL BUILD: the row-statistics exchange does not wait; results are wrong by design
        if (blockIdx.x >= 64) { const long long t0_ = clock64(); while (clock64() - t0_ < 60000) __builtin_amdgcn_s_sleep(8); }
#endif
        const int row = wid * 32 + (lane & 31);
        if (lane < 32) {
            const f32x2v a = P[row * 4 + 0], b = P[row * 4 + 1], c = P[row * 4 + 2], d = P[row * 4 + 3];
            const float mt = (a.x + b.x + c.x + d.x) * 0.25f;
            const float da = a.x - mt, db = b.x - mt, dc = c.x - mt, dd = d.x - mt;
            const float m2 = (a.y + b.y) + (c.y + d.y) + 64.0f * ((da * da + db * db) + (dc * dc + dd * dd));
            unsigned long long* slot = (unsigned long long*)xbuf + ((size_t)(u.pm * BM + row) * 4 + u.pn);
            __hip_atomic_store(slot, ((unsigned long long)__float_as_uint(m2) << 32) | __float_as_uint(mt), __ATOMIC_RELAXED, __HIP_MEMORY_SCOPE_AGENT);
        }
        asm volatile("s_waitcnt vmcnt(0)" ::: "memory");
        if (lane == 0) __hip_atomic_fetch_add(cnt + 64 * u.pm, 1u, __ATOMIC_RELAXED, __HIP_MEMORY_SCOPE_AGENT);
        if (wid == 0) {
            bool dead = false; const unsigned long long t0 = __builtin_amdgcn_s_memrealtime(); const unsigned want = 8u * (unsigned)ntn;
            for (;;) {
#if defined(BROKEN_EXCHANGE_NO_WAIT)
                break;
#endif
                if ((unsigned)__builtin_amdgcn_readfirstlane(__hip_atomic_load(cnt + 64 * u.pm, __ATOMIC_RELAXED, __HIP_MEMORY_SCOPE_AGENT)) >= want) break;
                if (__builtin_amdgcn_s_memrealtime() - t0 > 2000000ull) {
                    if (lane == 0) { unsigned expect = 0u; __hip_atomic_compare_exchange_strong(tmo + 1, &expect, code | (unsigned)(u.pm & 0xff), __ATOMIC_RELAXED, __ATOMIC_RELAXED, __HIP_MEMORY_SCOPE_AGENT);
                                     __hip_atomic_store(tmo, 1u, __ATOMIC_RELAXED, __HIP_MEMORY_SCOPE_AGENT); }
                    dead = true; break; }
                __builtin_amdgcn_s_sleep(2);
            }
            __builtin_amdgcn_fence(__ATOMIC_ACQUIRE, "agent");
            if (lane == 0) flag[0] = dead ? 1u : 0u;
        }
        asm volatile("s_waitcnt vmcnt(0) lgkmcnt(0)" ::: "memory"); __builtin_amdgcn_s_barrier(); asm volatile("" ::: "memory");
        const bool bad = flag[0] != 0u;
        if (lane < 32) {
            const unsigned long long* slot = (const unsigned long long*)xbuf + (size_t)(u.pm * BM + row) * 4; float mt[4], m2[4]; float ms = 0.f;
#pragma unroll
            for (int t = 0; t < 4; ++t) { if (t < ntn) { const unsigned long long w = __hip_atomic_load(slot + t, __ATOMIC_RELAXED, __HIP_MEMORY_SCOPE_AGENT); mt[t] = __uint_as_float((unsigned)w); m2[t] = __uint_as_float((unsigned)(w >> 32)); } else { mt[t] = 0.f; m2[t] = 0.f; } ms += mt[t]; }
            const float mean = ms / (float)ntn; float q = 0.f;
#pragma unroll
            for (int t = 0; t < 4; ++t) if (t < ntn) { const float dm = mt[t] - mean; q += m2[t] + 256.0f * dm * dm; }
            S[row] = (f32x2v){mean, 1.0f / sqrtf(q / (256.0f * (float)ntn) + eps)};
        }
        asm volatile("s_waitcnt lgkmcnt(0)" ::: "memory"); __builtin_amdgcn_s_barrier(); asm volatile("" ::: "memory");
        return bad;
    }
};
struct EpiLnRes {
    static constexpr bool PERM = false, AFTER_DRAIN = true;
    const float* base; float* out; int ldc; const float* bias; PanelStats st; unsigned poison;
    __device__ __forceinline__ void fused(f32x4 (&acc)[2][2][4][2], const Unit& u, int wr, int wc, int fr, int fq, PG8_LAS unsigned char* lds, int wid, int lane) const {
        typedef float f32x2v __attribute__((ext_vector_type(2)));
        const PG8_LAS f32x2v* S = (const PG8_LAS f32x2v*)(lds + 8192);
        const int col0 = u.pn * BM + wc * 32 + 4 * fq;
#pragma unroll
        for (int bj = 0; bj < 2; ++bj)
#pragma unroll
            for (int n = 0; n < 2; ++n) { const f32x4 bv = bias ? *(const f32x4*)(bias + col0 + bj * HALF + n * 16) : (f32x4){0.f, 0.f, 0.f, 0.f};
#pragma unroll
                for (int ai = 0; ai < 2; ++ai)
#pragma unroll
                    for (int m = 0; m < 4; ++m) acc[ai][bj][m][n] += bv; }
        f32x4 pre[4][2][2];
#pragma unroll
        for (int m = 0; m < 4; ++m) { const size_t off = (size_t)(u.pm * BM + wr * 64 + m * 16 + fr) * ldc + col0;
#pragma unroll
            for (int bj = 0; bj < 2; ++bj)
#pragma unroll
                for (int n = 0; n < 2; ++n) pre[m][bj][n] = *(const f32x4*)(base + off + bj * HALF + n * 16); }
        const bool bad = st.run(acc, u, wr, wc, fr, fq, lds, wid, lane) || poison != 0u;
        const float qnan = __builtin_nanf("");
#pragma unroll
        for (int ai = 0; ai < 2; ++ai)
#pragma unroll
            for (int m = 0; m < 4; ++m) { const int r = ai * HALF + wr * 64 + m * 16 + fr; const f32x2v sr = S[r]; const size_t off = (size_t)(u.pm * BM + r) * ldc + col0;
#pragma unroll
                for (int bj = 0; bj < 2; ++bj)
#pragma unroll
                    for (int n = 0; n < 2; ++n) { const f32x4 bs = ai == 0 ? pre[m][bj][n] : *(const f32x4*)(base + off + bj * HALF + n * 16); f32x4 o = bs + (acc[ai][bj][m][n] - sr.x) * sr.y;
                        if (bad) o = (f32x4){qnan, qnan, qnan, qnan}; *(f32x4*)(out + off + bj * HALF + n * 16) = o; }
                if (m & 1) asm volatile("" ::: "memory"); }
    }
};
struct EpiLnResLn {
    static constexpr bool PERM = false, AFTER_DRAIN = true;
    const float* base; float* out; bf16_t* xn; int ldc; const float* bias; PanelStats st1, st2; unsigned poison;
    __device__ __forceinline__ void fused(f32x4 (&acc)[2][2][4][2], const Unit& u, int wr, int wc, int fr, int fq, PG8_LAS unsigned char* lds, int wid, int lane) const {
        typedef float f32x2v __attribute__((ext_vector_type(2))); typedef unsigned u32x2v __attribute__((ext_vector_type(2)));
        const PG8_LAS f32x2v* S = (const PG8_LAS f32x2v*)(lds + 8192);
        const int col0 = u.pn * BM + wc * 32 + 4 * fq;
#pragma unroll
        for (int bj = 0; bj < 2; ++bj)
#pragma unroll
            for (int n = 0; n < 2; ++n) { const f32x4 bv = bias ? *(const f32x4*)(bias + col0 + bj * HALF + n * 16) : (f32x4){0.f, 0.f, 0.f, 0.f};
#pragma unroll
                for (int ai = 0; ai < 2; ++ai)
#pragma unroll
                    for (int m = 0; m < 4; ++m) acc[ai][bj][m][n] += bv; }
        bool bad = st1.run(acc, u, wr, wc, fr, fq, lds, wid, lane) || poison != 0u;
        const float qnan = __builtin_nanf("");
#pragma unroll
        for (int ai = 0; ai < 2; ++ai)
#pragma unroll
            for (int m = 0; m < 4; ++m) { const int r = ai * HALF + wr * 64 + m * 16 + fr; const f32x2v sr = S[r]; const size_t off = (size_t)(u.pm * BM + r) * ldc + col0;
#pragma unroll
                for (int bj = 0; bj < 2; ++bj)
#pragma unroll
                    for (int n = 0; n < 2; ++n) { const f32x4 bs = *(const f32x4*)(base + off + bj * HALF + n * 16); acc[ai][bj][m][n] = bs + (acc[ai][bj][m][n] - sr.x) * sr.y; }
                asm volatile("" : "+v"(acc[ai][0][m][0]), "+v"(acc[ai][0][m][1]), "+v"(acc[ai][1][m][0]), "+v"(acc[ai][1][m][1]));
                if (m & 1) asm volatile("" ::: "memory"); }
        const bool bad1 = bad;
        bad = st2.run(acc, u, wr, wc, fr, fq, lds, wid, lane) || bad;
#pragma unroll
        for (int ai = 0; ai < 2; ++ai)
#pragma unroll
            for (int m = 0; m < 4; ++m) { const int r = ai * HALF + wr * 64 + m * 16 + fr; const f32x2v sr = S[r]; const size_t off = (size_t)(u.pm * BM + r) * ldc + col0;
#pragma unroll
                for (int bj = 0; bj < 2; ++bj)
#pragma unroll
                    for (int n = 0; n < 2; ++n) { const f32x4 x1 = acc[ai][bj][m][n]; *(f32x4*)(out + off + bj * HALF + n * 16) = bad1 ? (f32x4){qnan, qnan, qnan, qnan} : x1;
                        const f32x4 o = (x1 - sr.x) * sr.y; u32x2v w; w.x = cvt_pk_bf16(o[0], o[1]); w.y = cvt_pk_bf16(o[2], o[3]);
                        if (bad) { w.x = 0x7fc07fc0u; w.y = 0x7fc07fc0u; } *(u32x2v*)(xn + off + bj * HALF + n * 16) = w; }
                asm volatile("" ::: "memory"); }
    }
};

template <class Epi, class Sched, bool ALIGN_EPI = false, bool SP2 = false>
__device__ __forceinline__ void gemm_phase(PG8_LAS unsigned char* lds, const Gemm g, const Sched& S, const Epi& E, const int tid) {
    const int wid = __builtin_amdgcn_readfirstlane(tid >> 6), lane = tid & 63, wr = wid >> 2, wc = wid & 3, fr = lane & 15, fq = lane >> 4;
    const int K = g.K, seg = K / BK, nt = (g.nseg > 1) ? seg * g.nseg : seg;
    constexpr bool RELAX = PG8_RELAX && SP2 && ALIGN_EPI && !Epi::AFTER_DRAIN && (Epi::NSTORE == 16);
    unsigned voffA[2], voffB[2];
#pragma unroll
    for (int i = 0; i < 2; ++i) { int R, C; stage_rc(tid * 16 + i * 8192, R, C); const int Rb = Epi::PERM ? ((R & ~31) + perm32(R & 31)) : R;
        voffA[i] = (unsigned)(R * K + C) * 2u; voffB[i] = (unsigned)(Rb * K + C) * 2u; }
    const size_t kstep = (size_t)(BK * 2);
    const long jA = g.dA - (long)seg * (long)kstep, jB = g.dB - (long)seg * (long)kstep;
    const size_t hstep = (size_t)HALF * K * 2;
    const size_t tstep = 2 * hstep;
    const unsigned ldsw = (unsigned)wid * 1024u;
    const int aoff = lds_byte(wr * 64 + fr, fq * 8), boff = lds_byte(wc * 32 + fr, fq * 8);
#define PG8_SA(b, h) (((b) * 2 + (h)) * HTB)
#define PG8_SB(b, h) ((4 + (b) * 2 + (h)) * HTB)
#define PG8_STAGE(bufoff, gbase, voff) do { _Pragma("unroll") for (int _i = 0; _i < 2; ++_i) \
        __builtin_amdgcn_global_load_lds((const unsigned*)((const char*)(gbase) + (voff)[_i]), (PG8_LAS unsigned*)(lds + (bufoff) + ldsw + _i * 8192), 16, 0, 0); } while (0)
#define PG8_LDA(dst, b, h) do { _Pragma("unroll") for (int m = 0; m < 4; ++m) _Pragma("unroll") for (int k = 0; k < 2; ++k) dst[m][k] = *(const PG8_LAS bf16x8*)(lds + PG8_SA(b, h) + aoff + m * 2048 + k * 1024); } while (0)
#define PG8_LDB(dst, b, h) do { _Pragma("unroll") for (int n = 0; n < 2; ++n) _Pragma("unroll") for (int k = 0; k < 2; ++k) dst[n][k] = *(const PG8_LAS bf16x8*)(lds + PG8_SB(b, h) + boff + n * 2048 + k * 1024); } while (0)
#define PG8_MMA(ai, bj, At, Bt) do { __builtin_amdgcn_s_setprio(1); _Pragma("unroll") for (int m = 0; m < 4; ++m) _Pragma("unroll") for (int n = 0; n < 2; ++n) _Pragma("unroll") for (int k = 0; k < 2; ++k) \
        acc[ai][bj][m][n] = __builtin_amdgcn_mfma_f32_16x16x32_bf16(Bt[n][k], At[m][k], acc[ai][bj][m][n], 0, 0, 0); __builtin_amdgcn_s_setprio(0); } while (0)
#define PG8_WAIT_V(n) asm volatile("s_waitcnt vmcnt(" #n ")" ::: "memory")
#define PG8_WAIT_L(n) asm volatile("s_waitcnt lgkmcnt(" #n ")" ::: "memory")
#define PG8_BAR __builtin_amdgcn_s_barrier()
#define PG8_SCHED __builtin_amdgcn_sched_barrier(0)
    Unit cur, nxt; int ui = 0;
    if (!S.next(0, cur)) return;
    f32x4 acc[2][2][4][2];
#pragma unroll
    for (int a = 0; a < 2; ++a)
#pragma unroll
        for (int b = 0; b < 2; ++b)
#pragma unroll
            for (int m = 0; m < 4; ++m)
#pragma unroll
                for (int n = 0; n < 2; ++n) acc[a][b][m][n] = (f32x4){0.f, 0.f, 0.f, 0.f};
    bf16x8 At[4][2], B0[2][2], B1[2][2];
    const char* cA = (const char*)g.A + (size_t)cur.pm * tstep; const char* cB = (const char*)g.Bt + (size_t)cur.pn * tstep;
    S.a_ready(cur);
    if constexpr (SP2) {
        PG8_STAGE(PG8_SB(0, 0), cB, voffB); PG8_STAGE(PG8_SB(0, 1), cB + hstep, voffB); PG8_STAGE(PG8_SA(0, 0), cA, voffA); PG8_STAGE(PG8_SA(0, 1), cA + hstep, voffA);
        if (wr == 1) PG8_BAR;
        PG8_WAIT_V(2); PG8_BAR;
        PG8_STAGE(PG8_SB(1, 0), cB + kstep, voffB); PG8_STAGE(PG8_SA(1, 0), cA + kstep, voffA); PG8_STAGE(PG8_SB(1, 1), cB + hstep + kstep, voffB);
        PG8_WAIT_V(6); PG8_BAR;
    } else {
        PG8_STAGE(PG8_SB(0, 0), cB, voffB); PG8_STAGE(PG8_SA(0, 0), cA, voffA); PG8_STAGE(PG8_SB(0, 1), cB + hstep, voffB); PG8_STAGE(PG8_SA(0, 1), cA + hstep, voffA);
        if (wr == 1) PG8_BAR;
        PG8_WAIT_V(4); PG8_BAR;
        PG8_STAGE(PG8_SB(1, 0), cB + kstep, voffB); PG8_STAGE(PG8_SA(1, 0), cA + kstep, voffA); PG8_STAGE(PG8_SB(1, 1), cB + hstep + kstep, voffB);
        PG8_WAIT_V(6); PG8_BAR;
    }
    for (;;) {
        const bool has_next = S.next(ui + 1, nxt);
        const char* nA = has_next ? (const char*)g.A + (size_t)nxt.pm * tstep : cA; const char* nB = has_next ? (const char*)g.Bt + (size_t)nxt.pn * tstep : cB;
#define PG8_KOFF(x, j) ((size_t)(x) * kstep + (((x) >= seg) ? (size_t)(j) : (size_t)0))
#define PG8_ITER(RLX_) { \
            const bool last = (t == nt - 2); \
            if constexpr (Epi::KSPLIT) { if (t == seg) E.mid(acc, cur, wr, wc, fr, fq); } \
            const char* a1 = cA + PG8_KOFF(t + 1, jA); \
            const char* a2 = last ? nA : cA + PG8_KOFF(t + 2, jA); const char* b2 = last ? nB : cB + PG8_KOFF(t + 2, jB); \
            const char* a3 = last ? nA + kstep : cA + PG8_KOFF(t + 3, jA); const char* b3 = last ? nB + kstep : cB + PG8_KOFF(t + 3, jB); \
            if (last && has_next) S.a_ready(nxt); \
            if constexpr (SP2) { \
            constexpr bool rlx = (RLX_); \
            PG8_LDB(B0, 0, 0); PG8_LDB(B1, 0, 1); PG8_SCHED; PG8_LDA(At, 0, 0); if constexpr (!rlx) { PG8_STAGE(PG8_SA(1, 1), a1 + hstep, voffA); } \
            if constexpr (rlx) { PG8_WAIT_V(24); } else { PG8_WAIT_V(8); } PG8_WAIT_L(0); PG8_BAR; PG8_MMA(0, 0, At, B0); PG8_MMA(0, 1, At, B1); PG8_BAR; PG8_SCHED; \
            PG8_LDA(At, 0, 1); PG8_STAGE(PG8_SB(0, 0), b2, voffB); PG8_STAGE(PG8_SB(0, 1), b2 + hstep, voffB); PG8_STAGE(PG8_SA(0, 0), a2, voffA); \
            if constexpr (rlx) { PG8_WAIT_V(24); } else { PG8_WAIT_V(8); } PG8_WAIT_L(0); PG8_BAR; PG8_MMA(1, 0, At, B0); PG8_MMA(1, 1, At, B1); PG8_BAR; PG8_SCHED; \
            PG8_LDB(B0, 1, 0); PG8_LDB(B1, 1, 1); PG8_SCHED; PG8_LDA(At, 1, 0); PG8_STAGE(PG8_SA(0, 1), a2 + hstep, voffA); \
            if constexpr (rlx) { PG8_WAIT_V(24); } else { PG8_WAIT_V(8); } PG8_WAIT_L(0); PG8_BAR; PG8_MMA(0, 0, At, B0); PG8_MMA(0, 1, At, B1); PG8_BAR; PG8_SCHED; \
            PG8_LDA(At, 1, 1); PG8_STAGE(PG8_SB(1, 0), b3, voffB); PG8_STAGE(PG8_SB(1, 1), b3 + hstep, voffB); PG8_STAGE(PG8_SA(1, 0), a3, voffA); \
            PG8_WAIT_V(8); PG8_WAIT_L(0); PG8_BAR; PG8_MMA(1, 0, At, B0); PG8_MMA(1, 1, At, B1); PG8_BAR; PG8_SCHED; \
            } else { \
            PG8_LDB(B0, 0, 0); PG8_SCHED; PG8_LDA(At, 0, 0); PG8_STAGE(PG8_SA(1, 1), a1 + hstep, voffA); \
            PG8_WAIT_L(8); PG8_BAR; PG8_WAIT_L(0); PG8_MMA(0, 0, At, B0); PG8_BAR; PG8_SCHED; \
            PG8_LDB(B1, 0, 1); PG8_STAGE(PG8_SB(0, 0), b2, voffB); \
            PG8_BAR; PG8_WAIT_L(0); PG8_MMA(0, 1, At, B1); PG8_BAR; \
            PG8_LDA(At, 0, 1); PG8_STAGE(PG8_SA(0, 0), a2, voffA); \
            PG8_BAR; PG8_WAIT_L(0); PG8_MMA(1, 0, At, B0); PG8_BAR; PG8_SCHED; \
            PG8_STAGE(PG8_SB(0, 1), b2 + hstep, voffB); \
            PG8_WAIT_V(6); PG8_BAR; PG8_MMA(1, 1, At, B1); PG8_BAR; \
            PG8_LDB(B0, 1, 0); PG8_SCHED; PG8_LDA(At, 1, 0); PG8_STAGE(PG8_SA(0, 1), a2 + hstep, voffA); \
            PG8_WAIT_L(8); PG8_BAR; PG8_WAIT_L(0); PG8_MMA(0, 0, At, B0); PG8_BAR; PG8_SCHED; \
            PG8_LDB(B1, 1, 1); PG8_STAGE(PG8_SB(1, 0), b3, voffB); \
            PG8_BAR; PG8_WAIT_L(0); PG8_MMA(0, 1, At, B1); PG8_BAR; \
            PG8_LDA(At, 1, 1); PG8_STAGE(PG8_SA(1, 0), a3, voffA); \
            PG8_BAR; PG8_WAIT_L(0); PG8_MMA(1, 0, At, B0); PG8_BAR; PG8_SCHED; \
            PG8_STAGE(PG8_SB(1, 1), b3 + hstep, voffB); \
            PG8_WAIT_V(6); PG8_BAR; PG8_MMA(1, 1, At, B1); PG8_BAR; \
            } \
        }
        int t = 0;
        if constexpr (RELAX) {
#pragma unroll
            for (int a = 0; a < 2; ++a)
#pragma unroll
                for (int b = 0; b < 2; ++b)
#pragma unroll
                    for (int m = 0; m < 4; ++m) asm volatile("" : "+v"(acc[a][b][m][0]), "+v"(acc[a][b][m][1]));
        }
        if (RELAX && ui > 0) { PG8_ITER(true) t = 2; }
        for (; t < nt; t += 2) PG8_ITER(false)
#undef PG8_ITER
        if constexpr (ALIGN_EPI) { if (wr == 0) PG8_BAR; }
        if constexpr (RELAX) { PG8_STAGE(PG8_SA(1, 1), nA + kstep + hstep, voffA); PG8_SCHED; }
        if constexpr (!Epi::AFTER_DRAIN) { E(acc, cur, wr, wc, fr, fq); S.done(cur); }
        if (!has_next) break;
#pragma unroll
        for (int a = 0; a < 2; ++a)
#pragma unroll
            for (int b = 0; b < 2; ++b)
#pragma unroll
                for (int m = 0; m < 4; ++m)
#pragma unroll
                    for (int n = 0; n < 2; ++n) acc[a][b][m][n] = (f32x4){0.f, 0.f, 0.f, 0.f};
        cur = nxt; cA = nA; cB = nB; ++ui;
        if constexpr (ALIGN_EPI) { if (wr == 1) PG8_BAR; }
    }
    PG8_WAIT_V(0);
    if constexpr (!ALIGN_EPI) { if (wr == 0) PG8_BAR; }
    PG8_BAR;
    if constexpr (Epi::AFTER_DRAIN) { E.fused(acc, cur, wr, wc, fr, fq, lds, wid, lane); S.done(cur); }
#undef PG8_KOFF
#undef PG8_SA
#undef PG8_SB
#undef PG8_STAGE
#undef PG8_LDA
#undef PG8_LDB
#undef PG8_MMA
#undef PG8_WAIT_V
#undef PG8_WAIT_L
#undef PG8_BAR
#undef PG8_SCHED
}
}
#include <hip/hip_bf16.h>
#include <cmath>
#ifndef ATTN_MAP_OLD
#define ATTN_MAP_OLD 0
#endif
#ifndef ATTN_NOWAIT_PROBE
#define ATTN_NOWAIT_PROBE 0
#endif
#ifndef ATTN_TIMING
#define ATTN_TIMING 0
#endif
#ifndef ATTN_VD
#define ATTN_VD 4
#endif
#ifndef ATTN_DMA_EARLY
#define ATTN_DMA_EARLY 0
#endif
#ifndef ATTN_KRD_EARLY
#define ATTN_KRD_EARLY 1
#endif
#ifndef ATTN_TSET
#define ATTN_TSET 1
#endif
#ifndef ATTN_DMA_SPLIT
#define ATTN_DMA_SPLIT 0
#endif
#ifndef ATTN_PRIO
#define ATTN_PRIO 1
#endif
#ifndef ATTN_HALF_PROBE
#define ATTN_HALF_PROBE 0
#endif
namespace attn128 {
using bf16=__hip_bfloat16;
using bf16x8=__attribute__((ext_vector_type(8)))short;
using s16x4=__attribute__((ext_vector_type(4)))short;
using f32x16=__attribute__((ext_vector_type(16)))float;
using u32x4=__attribute__((ext_vector_type(4)))unsigned;
constexpr int BATCH=8,NHEAD=16,SEQ=4096,D=64,DM=NHEAD*D;
constexpr int NW=8,QBLK=32,QB=QBLK*NW,KVBLK=64,NQB=SEQ/QB;
constexpr int ATTN_PITCH=DM, ATTN_UNIT_ROWS=QB;
__device__ __forceinline__ int crow(int r,int hi){return (r&3)+8*(r>>2)+4*hi;}
#define SBAR() __builtin_amdgcn_sched_barrier(0)
__device__ __forceinline__ void cmask(f32x16&p0,f32x16&p1,int jb,int wid){
  const float NEG=-INFINITY;
  if(jb>(wid>>1)){
  #pragma unroll
  for(int r=0;r<16;++r){p0[r]=NEG;p1[r]=NEG;} }
}

constexpr int NSLOT=3, SLOTB=8192, VD=ATTN_VD;
constexpr int LDS_K=0, LDS_V=NSLOT*SLOTB, LDS_WS=LDS_V+2*NSLOT*SLOTB, LDS_OST=LDS_WS+NW*64*4, LDS_BYTES=LDS_OST+NW*8192;
constexpr float C2=0.125f*1.4426950408889634f;
__device__ __forceinline__ void glds16(const void*gsrc,unsigned lds_dst){unsigned keep;
  asm volatile("s_mov_b32 %0, m0\n\ts_mov_b32 m0, %2\n\ts_nop 0\n\tglobal_load_lds_dwordx4 %1, off\n\ts_mov_b32 m0, %0":"=&s"(keep):"v"(gsrc),"s"(lds_dst):"memory");}
__device__ __forceinline__ float max3f(float a,float b,float c){float r;asm("v_max3_f32 %0, %1, %2, %3":"=v"(r):"v"(a),"v"(b),"v"(c));return r;}
__device__ __forceinline__ float max2f(float a,float b){float r;asm("v_max_f32_e32 %0, %1, %2":"=v"(r):"v"(a),"v"(b));return r;}
__device__ __forceinline__ float fadd_s(float a,float b){float r;asm("v_add_f32_e32 %0, %1, %2":"=v"(r):"v"(a),"v"(b));return r;}
__device__ __forceinline__ float fsub_s(float a,float b){float r;asm("v_sub_f32_e32 %0, %1, %2":"=v"(r):"v"(a),"v"(b));return r;}
typedef float f32x2_t __attribute__((ext_vector_type(2))); typedef __bf16 bf16x2_t __attribute__((ext_vector_type(2)));
__device__ __forceinline__ unsigned cvtpk_s(float lo,float hi){f32x2_t v={lo,hi};bf16x2_t b=__builtin_convertvector(v,bf16x2_t);return __builtin_bit_cast(unsigned,b);}
#define WAIT_BAR(N) asm volatile("s_waitcnt vmcnt(" #N ") lgkmcnt(0)\n\ts_barrier":::"memory")
#if ATTN_NOWAIT_PROBE
#define WAIT_BARX(N) do{ if(dbg_half){ asm volatile("s_waitcnt lgkmcnt(0)\n\ts_barrier":::"memory"); } else { WAIT_BAR(N); } }while(0)
#else
#if ATTN_TSET == 2
#define WAIT_BARX(N) do{ asm volatile("s_waitcnt vmcnt(" #N ") lgkmcnt(0)":::"memory"); TS(TS_WAIT); asm volatile("s_barrier":::"memory"); }while(0)
#else
#define WAIT_BARX(N) WAIT_BAR(N)
#endif
#endif

__device__ __forceinline__ void qkt(f32x16&p0,f32x16&p1,const char*Kslot,const bf16x8*qr,int r32,int hi){
  const char*kb=Kslot+hi*1024+r32*16; const f32x16 z=f32x16{};
  #pragma unroll
  for(int d0=0;d0<4;++d0){
    const bf16x8 b0=*reinterpret_cast<const bf16x8*>(kb+d0*2048);
    const bf16x8 b1=*reinterpret_cast<const bf16x8*>(kb+d0*2048+512);
    if(d0==0){p0=__builtin_amdgcn_mfma_f32_32x32x16_bf16(b0,qr[0],z,0,0,0);p1=__builtin_amdgcn_mfma_f32_32x32x16_bf16(b1,qr[0],z,0,0,0);}
    else{p0=__builtin_amdgcn_mfma_f32_32x32x16_bf16(b0,qr[d0],p0,0,0,0);p1=__builtin_amdgcn_mfma_f32_32x32x16_bf16(b1,qr[d0],p1,0,0,0);}}
}
typedef __attribute__((address_space(3))) const char* lds_cptr;
typedef short v4i16_t __attribute__((ext_vector_type(4)));
__device__ __forceinline__ void kload8(bf16x8*kf,lds_cptr kp){
  kf[0]=*(const __attribute__((address_space(3))) bf16x8*)(kp);      kf[1]=*(const __attribute__((address_space(3))) bf16x8*)(kp+512);
  kf[2]=*(const __attribute__((address_space(3))) bf16x8*)(kp+2048); kf[3]=*(const __attribute__((address_space(3))) bf16x8*)(kp+2560);
  kf[4]=*(const __attribute__((address_space(3))) bf16x8*)(kp+4096); kf[5]=*(const __attribute__((address_space(3))) bf16x8*)(kp+4608);
  kf[6]=*(const __attribute__((address_space(3))) bf16x8*)(kp+6144); kf[7]=*(const __attribute__((address_space(3))) bf16x8*)(kp+6656);
}
__device__ __forceinline__ void kload2(bf16x8*kf,lds_cptr kp,int j){ kf[2*j]=*(const __attribute__((address_space(3))) bf16x8*)(kp+j*2048); kf[2*j+1]=*(const __attribute__((address_space(3))) bf16x8*)(kp+j*2048+512); }
__device__ __forceinline__ s16x4 vtr(lds_cptr p){ return __builtin_bit_cast(s16x4,__builtin_amdgcn_ds_read_tr16_b64_v4i16((__attribute__((address_space(3))) v4i16_t*)p)); }
__device__ __forceinline__ float rowmax(const f32x16&p0,const f32x16&p1){
  float a=max3f(p0[0],p0[1],p1[0]),b=max3f(p0[2],p0[3],p1[1]);a=max3f(a,p1[2],p1[3]);
  #pragma unroll
  for(int r=4;r<16;r+=4){a=max3f(a,p0[r],p0[r+1]);b=max3f(b,p0[r+2],p0[r+3]);a=max3f(a,p1[r],p1[r+1]);b=max3f(b,p1[r+2],p1[r+3]);}
  const float m=max2f(a,b);
  auto rr=__builtin_amdgcn_permlane32_swap(__float_as_uint(m),__float_as_uint(m),false,false);
  return max2f(__uint_as_float(rr[0]),__uint_as_float(rr[1]));
}
__device__ __forceinline__ void pv(f32x16*o,int vb,bf16x8 pa0,bf16x8 pa1,bf16x8 pa2,bf16x8 pa3){
  #pragma unroll
  for(int d0=0;d0<4;++d0){s16x4 lo[4],hi[4];
    #pragma unroll
    for(int ks=0;ks<4;++ks){
      asm volatile("ds_read_b64_tr_b16 %0,%1 offset:%c2":"=&v"(lo[ks]):"v"(vb),"i"(d0*4096+ks*1024):"memory");
      asm volatile("ds_read_b64_tr_b16 %0,%1 offset:%c2":"=&v"(hi[ks]):"v"(vb),"i"(d0*4096+ks*1024+512):"memory");}
    asm volatile("s_waitcnt lgkmcnt(0)":::"memory");SBAR();
    #define PK(k) (bf16x8){lo[k][0],lo[k][1],lo[k][2],lo[k][3],hi[k][0],hi[k][1],hi[k][2],hi[k][3]}
    o[d0]=__builtin_amdgcn_mfma_f32_32x32x16_bf16(pa0,PK(0),o[d0],0,0,0);
    o[d0]=__builtin_amdgcn_mfma_f32_32x32x16_bf16(pa1,PK(1),o[d0],0,0,0);
    o[d0]=__builtin_amdgcn_mfma_f32_32x32x16_bf16(pa2,PK(2),o[d0],0,0,0);
    o[d0]=__builtin_amdgcn_mfma_f32_32x32x16_bf16(pa3,PK(3),o[d0],0,0,0);
    #undef PK
  }
}

#ifndef ATTN_STORE16
#define ATTN_STORE16(p,v) (*(u32x4*)(p)=(v))
#endif
template<int THRL> __device__ __forceinline__ void attn_unit(int b,int head,int qb,const bf16*Q,const bf16*__restrict__ K,const bf16*__restrict__ V,bf16*YA,char*shm,const float lam,const float*gsub,const int wid_in,const bool dbg_half,unsigned&tac0,unsigned&tac1,unsigned&tac2,unsigned&tac3){
  int wid=wid_in; asm volatile("":"+s"(wid));
  int lane; asm volatile("v_mbcnt_lo_u32_b32 %0, -1, 0\n\tv_mbcnt_hi_u32_b32 %0, -1, %0":"=v"(lane));
  const int r32=lane&31,hi=lane>>5;
  const long rowbase=(long)b*SEQ; const int q0=qb*QB;
  const bf16*Qw=Q+(rowbase+q0+wid*QBLK)*DM+head*D;
  const bf16*Kh=K+rowbase*DM+head*D,*Vh=V+rowbase*DM+head*128;
  const unsigned lds0=(unsigned)(uintptr_t)shm;
  float*wsf=(float*)(shm+LDS_WS)+wid*64;
  const bf16*ksrc=Kh+(long)lane*DM+wid*8;
  const bf16*vsrc=Vh+(long)(16*(wid&3)+(lane>>2))*DM+(wid>>2)*32+(lane&3)*8;
  const unsigned kdst=lds0+LDS_K+wid*1024, vdst=lds0+LDS_V+wid*1024;
  #define KOFS(t) (((t)<NT)?(long)(t)*KVBLK*DM:(long)((t)-NT)*KVBLK*DM+512)
  #define VOFS(t) ((long)(((t)<NT)?(t):(t)-NT)*KVBLK*DM)
  #define DMA_K(t,slot) glds16(ksrc+KOFS(t),(unsigned)__builtin_amdgcn_readfirstlane(kdst+(slot)))
  #define DMA_V0(t,slot) glds16(vsrc+VOFS(t),(unsigned)__builtin_amdgcn_readfirstlane(vdst+2*(slot)))
  #define DMA_V1(t,slot) glds16(vsrc+VOFS(t)+64,(unsigned)__builtin_amdgcn_readfirstlane(vdst+2*(slot)+8192))
  #define DMA_V(t,slot) do{ glds16(vsrc+VOFS(t),(unsigned)__builtin_amdgcn_readfirstlane(vdst+2*(slot))); glds16(vsrc+VOFS(t)+64,(unsigned)__builtin_amdgcn_readfirstlane(vdst+2*(slot)+8192)); }while(0)
  const char*Kbase=shm+LDS_K; bf16x8 kf[8];
  const lds_cptr shm3=(lds_cptr)shm; const lds_cptr kp0=shm3+LDS_K+hi*1024+r32*16; const lds_cptr vp0=shm3+LDS_V+((lane>>4)&1)*32+(lane&3)*8+(4*hi+((lane&15)>>2))*64;
  const int NT=(q0+QB)/KVBLK;
  DMA_K(0,0);DMA_V(0,0);DMA_K(1,SLOTB);
  bf16x8 qr[4];
  #pragma unroll
  for(int d0=0;d0<4;++d0)qr[d0]=*reinterpret_cast<const bf16x8*>(&Qw[(long)r32*DM+d0*16+hi*8]);
  float mhat=0.f,l_reg=0.f;f32x16 o[4];o[0]=f32x16{};o[1]=f32x16{};o[2]=f32x16{};o[3]=f32x16{};

  int mbase=NT-4; float lsave=0.f; const int N2=2*NT;
  #define CMASK(P0,P1,t) do{int jb_=(t)-mbase; if(jb_>=0&&jb_<4)cmask(P0,P1,jb_,wid);}while(0)
  bool resc=false;
  #define START(P0,P1) do{ const float rm=rowmax(P0,P1); resc=false; mhat=rm; \
    _Pragma("unroll") for(int r=0;r<16;++r)P0[r]=__builtin_amdgcn_exp2f(P0[r]-mhat); }while(0)
  #define RESC() do{ if(resc){ asm volatile("s_waitcnt lgkmcnt(0)":::"memory"); \
      _Pragma("unroll") for(int d_=0;d_<4;++d_) _Pragma("unroll") for(int r=0;r<16;++r)o[d_][r]*=wsf[crow(r,hi)]; } }while(0)
  f32x16 pA0,pA1,pB0,pB1;
  int sl_prev=0,sl_cur=0,sl_next=SLOTB;
  #define ROT() do{sl_prev=sl_cur;sl_cur=sl_next;sl_next=(sl_next==(NSLOT-1)*SLOTB)?0:sl_next+SLOTB;}while(0)
  DMA_K(2,2*SLOTB);
  WAIT_BAR(3);
  qkt(pA0,pA1,Kbase,qr,r32,hi);asm volatile("s_nop 15\n\ts_nop 7":"+v"(pA0),"+v"(pA1));CMASK(pA0,pA1,0);
  START(pA0,pA1);
  _Pragma("unroll") for(int r=0;r<16;++r)pA1[r]=__builtin_amdgcn_exp2f(pA1[r]-mhat);
  WAIT_BAR(0);
  DMA_K(3,0);DMA_V(1,SLOTB);
  ROT();
  kload8(kf,kp0+sl_cur);
  WAIT_BAR(3);
  s16x4 vlo[VD],vhi[VD]; u32x4 pw0,pw1,pw2,pw3;
  #define PKW(P,B) cvtpk_s(P[B],P[B+1])
  #define PAF(k) __builtin_bit_cast(bf16x8,pw##k)
  #define VFR(i) (bf16x8){vlo[i][0],vlo[i][1],vlo[i][2],vlo[i][3],vhi[i][0],vhi[i][1],vhi[i][2],vhi[i][3]}
  #define PIN(x) asm volatile("":"+v"(x))
  #define MX3(a,b,c) __builtin_fmaxf(__builtin_fmaxf((a),(b)),(c))
  #define GAPA(MF,A0,A1,A2,A3,W0,W1,PW) do{ if(QKON){ MF; } if(PVON){ sacc+=A0; sacc+=A1; sacc+=A2; sacc+=A3; PIN(sacc); W0; W1; PIN(PW); } SBAR(); }while(0)
  #define EX(v) __builtin_amdgcn_exp2f((v)-mhat)
  #define VOFF(j) ((((j)&3)*4096)+(((j)>>2)*1024))
  #define VRDS(j) do{ if(PVON){ vlo[(j)%VD]=vtr(vp_+VOFF(j)); vhi[(j)%VD]=vtr(vp_+VOFF(j)+512); } }while(0)
  #define VRDA(j) do{ if((j)<VD){ VRDS(j); } }while(0)
  #define VRDB(j) do{ if((j)+VD<16){ VRDS((j)+VD); } }while(0)
  #define GAPB(j,X,B,RD) do{ if(PVON){ o[(j)&3]=__builtin_amdgcn_mfma_f32_32x32x16_bf16(PAF_SEL(j),VFR((j)%VD),o[(j)&3],0,0,0); } if(QKON){ X[B]=EX(X[B]); X[B+1]=EX(X[B+1]); PIN(X); } RD; SBAR(); }while(0)
  #define PAF_SEL(j) (((j)>>2)==0?PAF(0):((j)>>2)==1?PAF(1):((j)>>2)==2?PAF(2):PAF(3))
  #define KRD(G,j) do{ if(G){ kload2(kf,kp0+sl_next,j); } }while(0)
  #define KRDE(G,j) do{ if(ATTN_KRD_EARLY){ KRD(G,j); } }while(0)
  #define KRDL(G,j) do{ if(!ATTN_KRD_EARLY){ KRD(G,j); } }while(0)
  #define STEP(C0,C1,P0,P1,t,GK,GV,GL,PRE,SW,QK_,PV_) do{ SBAR(); TS(TS_START); \
    const bool QKON=(QK_) ATTN_LIVE, PVON=(PV_) ATTN_LIVE;     \
    const lds_cptr vp_=vp0+2*sl_prev; const f32x16 zc_=f32x16{}; \
    float sacc=(P0[0]+P0[1]); \
    GAPA(C0=__builtin_amdgcn_mfma_f32_32x32x16_bf16(kf[0],qr[0],zc_,0,0,0), P0[2],P0[3],P0[4],P0[5],     pw0[0]=PKW(P0,0), pw0[1]=PKW(P0,2), pw0); \
    if(ATTN_DMA_EARLY){ if(GK){DMA_K((t)+3,sl_cur);} SBAR(); }     \
    GAPA(C1=__builtin_amdgcn_mfma_f32_32x32x16_bf16(kf[1],qr[0],zc_,0,0,0), P0[6],P0[7],P0[8],P0[9],     pw0[2]=PKW(P0,4), pw0[3]=PKW(P0,6), pw0); \
    if(ATTN_DMA_EARLY){ if(GV){DMA_V0((t)+1,sl_next);} SBAR(); } \
    GAPA(C0=__builtin_amdgcn_mfma_f32_32x32x16_bf16(kf[2],qr[1],C0,0,0,0),   P0[10],P0[11],P0[12],P0[13], pw1[0]=PKW(P0,8), pw1[1]=PKW(P0,10), pw1); \
    if(ATTN_DMA_EARLY){ if(GV){DMA_V1((t)+1,sl_next);} SBAR(); } \
    GAPA(C1=__builtin_amdgcn_mfma_f32_32x32x16_bf16(kf[3],qr[1],C1,0,0,0),   P0[14],P0[15],P1[0],P1[1],   pw1[2]=PKW(P0,12),pw1[3]=PKW(P0,14), pw1); \
    VRDS(0); VRDA(4); SBAR(); GAPA(C0=__builtin_amdgcn_mfma_f32_32x32x16_bf16(kf[4],qr[2],C0,0,0,0),   P1[2],P1[3],P1[4],P1[5],     pw2[0]=PKW(P1,0), pw2[1]=PKW(P1,2), pw2); \
    VRDS(1); VRDA(5); SBAR(); GAPA(C1=__builtin_amdgcn_mfma_f32_32x32x16_bf16(kf[5],qr[2],C1,0,0,0),   P1[6],P1[7],P1[8],P1[9],     pw2[2]=PKW(P1,4), pw2[3]=PKW(P1,6), pw2); \
    VRDS(2); VRDA(6); SBAR(); GAPA(C0=__builtin_amdgcn_mfma_f32_32x32x16_bf16(kf[6],qr[3],C0,0,0,0),   P1[10],P1[11],P1[12],P1[13], pw3[0]=PKW(P1,8), pw3[1]=PKW(P1,10), pw3); \
    VRDS(3); VRDA(7); SBAR(); GAPA(C1=__builtin_amdgcn_mfma_f32_32x32x16_bf16(kf[7],qr[3],C1,0,0,0),   P1[14],P1[15],0.f,0.f,       pw3[2]=PKW(P1,12),pw3[3]=PKW(P1,14), pw3); \
    if(PVON){ l_reg+=sacc; } TS(TS_ENDA); \
    PRE; \
    if(!ATTN_DMA_EARLY && !(ATTN_DMA_SPLIT && wid>=4)){ if(GK){DMA_K((t)+3,sl_cur);} if(GV){DMA_V((t)+1,sl_next);} } TSDMA(); \
    resc=false; \
    if(QKON){ float a=MX3(C0[0],C0[1],C1[0]),b=MX3(C0[2],C0[3],C1[1]); a=MX3(a,C1[2],C1[3]); \
      _Pragma("unroll") for(int r=4;r<16;r+=4){a=MX3(a,C0[r],C0[r+1]);b=MX3(b,C0[r+2],C0[r+3]);a=MX3(a,C1[r],C1[r+1]);b=MX3(b,C1[r+2],C1[r+3]);} \
      float rm=__builtin_fmaxf(a,b); { auto rr=__builtin_amdgcn_permlane32_swap(__float_as_uint(rm),__float_as_uint(rm),false,false); rm=__builtin_fmaxf(__uint_as_float(rr[0]),__uint_as_float(rr[1])); } \
      if(SW){ lsave=l_reg; l_reg=0.f; mhat=rm; }     \
      else{ const float rmr=rm-mhat; \
      if(__builtin_expect(__any(rmr>(float)THRL),0)){ const float dl=__builtin_fmaxf(rmr,0.f); mhat+=dl; \
        const float f=__builtin_amdgcn_exp2f(-dl); l_reg*=f; { int l2_=lane; asm volatile("":"+v"(l2_)); if((l2_>>5)==0)wsf[l2_&31]=f; } resc=true; } } } \
    TS(TS_MAX); SBAR(); \
    GAPB(0, C0,0,  VRDB(0)); \
    GAPB(1, C0,2,  VRDB(1)); \
    GAPB(2, C0,4,  VRDB(2)); \
    GAPB(3, C0,6,  VRDB(3)); \
    GAPB(4, C0,8,  VRDB(4)); \
    GAPB(5, C0,10,  VRDB(5)); \
    GAPB(6, C0,12,  VRDB(6)); \
    GAPB(7, C0,14,  VRDB(7)); \
    if(!ATTN_DMA_EARLY && ATTN_DMA_SPLIT && wid>=4){ if(GK){DMA_K((t)+3,sl_cur);} if(GV){DMA_V((t)+1,sl_next);} SBAR(); }     \
    GAPB(8, C1,0,  VRDB(8);  KRDE(GL,0)); \
    GAPB(9, C1,2,  VRDB(9);  KRDE(GL,1)); \
    GAPB(10, C1,4,  VRDB(10); KRDE(GL,2)); \
    GAPB(11, C1,6,  VRDB(11); KRDE(GL,3)); \
    GAPB(12,C1,8,  KRDL(GL,0)); \
    GAPB(13,C1,10, KRDL(GL,1)); \
    GAPB(14,C1,12, KRDL(GL,2)); \
    GAPB(15,C1,14, KRDL(GL,3)); \
    TS(TS_ENDB); }while(0)
#if ATTN_TIMING
  unsigned tprev=(unsigned)__builtin_amdgcn_s_memtime();
  #define TS(a_) do{ const unsigned now_=(unsigned)__builtin_amdgcn_s_memtime(); a_+=now_-tprev; tprev=now_; }while(0)
#else
  #define TS(a_) do{}while(0)
#endif
  unsigned tdum=0u; (void)tdum;
#if ATTN_TSET == 2
  #define TS_START tac3
  #define TS_ENDA tdum
  #define TSDMA() TS(tac0)
  #define TS_MAX tac1
  #define TS_ENDB tdum
  #define TS_WAIT tac2
#else
  #define TS_START tac3
  #define TS_ENDA tac0
  #define TSDMA() do{}while(0)
  #define TS_MAX tac1
  #define TS_ENDB tac2
  #define TS_WAIT tdum
#endif
  if(ATTN_PRIO==1 && wid>=4) __builtin_amdgcn_s_setprio(1);
  int t=1; const int wch=wid>>1;
#if ATTN_HALF_PROBE
  const bool live_=!(dbg_half&&wid>=ATTN_HALF_PROBE);
  #define ATTN_LIVE &&live_
#else
  #define ATTN_LIVE
#endif
  #define QKV(t) true
  #define PVV(t) true
  #define QPRE(tt) do{ int l3_=lane; asm volatile("":"+v"(l3_)); _Pragma("unroll") for(int d0=0;d0<4;++d0)qr[d0]=*reinterpret_cast<const bf16x8*>(&Qw[(long)(l3_&31)*DM+512+d0*16+(l3_>>5)*8]); }while(0)
  #define MAP0_FIN() do{ float lt_=lsave; {auto rr=__builtin_amdgcn_permlane32_swap(__float_as_uint(lt_),__float_as_uint(lt_),false,false);lt_=__uint_as_float(rr[0])+__uint_as_float(rr[1]);} \
      { int l2_=lane; asm volatile("":"+v"(l2_)); if((l2_>>5)==0)wsf[32+(l2_&31)]=lt_; } asm volatile("s_waitcnt lgkmcnt(0)":::"memory"); \
      bf16*stg_=(bf16*)(shm+LDS_OST)+wid*4096; \
      _Pragma("unroll") for(int r=0;r<16;++r){ const int orow=crow(r,hi); const float rl_=__builtin_amdgcn_rcpf(wsf[32+orow]); \
        _Pragma("unroll") for(int d0=0;d0<4;++d0){ stg_[orow*128+d0*32+r32]=__float2bfloat16(o[d0][r]*rl_); } } \
      o[0]=f32x16{};o[1]=f32x16{};o[2]=f32x16{};o[3]=f32x16{}; }while(0)
  #undef QKV
  #undef PVV
  #define QKV(t) true
  #define PVV(t) true
  for(;t+5<NT;t+=2){
    STEP(pB0,pB1,pA0,pA1,t,true,true,true,,0,QKV(t),PVV(t));     WAIT_BARX(3); RESC(); ROT();
    STEP(pA0,pA1,pB0,pB1,t+1,true,true,true,,0,QKV(t+1),PVV(t+1));   WAIT_BARX(3); RESC(); ROT();
  }
  #undef QKV
  #undef PVV
  #define QKV(t) (((t)-mbase)<=wch)
  #define PVV(t) (((t)-mbase-1)<=wch)
  for(;t+1<NT;t+=2){
    STEP(pB0,pB1,pA0,pA1,t,true,true,true,,0,QKV(t),PVV(t));     WAIT_BARX(3); RESC(); ROT();
    STEP(pA0,pA1,pB0,pB1,t+1,true,true,true,,0,QKV(t+1),PVV(t+1));   WAIT_BARX(3); RESC(); ROT();
  }
  STEP(pB0,pB1,pA0,pA1,t,true,true,true,QPRE(t),0,QKV(t),PVV(t));  WAIT_BARX(3); RESC(); ROT();
  STEP(pA0,pA1,pB0,pB1,t+1,true,true,true,,1,true,(wch==3));       WAIT_BAR(3); MAP0_FIN(); ROT();
  t+=2;
  mbase=N2-4;
  #undef QKV
  #undef PVV
  #define QKV(t) true
  #define PVV(t) true
  for(;t+5<N2;t+=2){
    STEP(pB0,pB1,pA0,pA1,t,true,true,true,,0,QKV(t),PVV(t));     WAIT_BARX(3); RESC(); ROT();
    STEP(pA0,pA1,pB0,pB1,t+1,true,true,true,,0,QKV(t+1),PVV(t+1));   WAIT_BARX(3); RESC(); ROT();
  }
  #undef QKV
  #undef PVV
  #define QKV(t) (((t)-mbase)<=wch)
  #define PVV(t) (((t)-mbase-1)<=wch)
  #define ENDW(tt) do{ if((tt)+3<N2){WAIT_BAR(3);} else if((tt)+2<N2){WAIT_BAR(2);} else {WAIT_BAR(0);} }while(0)
  for(;t+1<N2;t+=2){
    STEP(pB0,pB1,pA0,pA1,t,(t+3<N2),(t+1<N2),(t+1<N2),,0,QKV(t),PVV(t));       ENDW(t);   RESC(); ROT();
    STEP(pA0,pA1,pB0,pB1,t+1,(t+4<N2),(t+2<N2),(t+2<N2),,0,QKV(t+1),PVV(t+1));     ENDW(t+1); RESC(); ROT();
  }
  STEP(pB0,pB1,pA0,pA1,N2-1,false,false,false,,0,QKV(N2-1),PVV(N2-1)); RESC();
  if(ATTN_PRIO==1) __builtin_amdgcn_s_setprio(0);
  if(wch==3){ float sacc=pB0[0]+pB0[1]; _Pragma("unroll") for(int r=2;r<16;++r)sacc+=pB0[r]; _Pragma("unroll") for(int r=0;r<16;++r)sacc+=pB1[r]; l_reg+=sacc;
    pw0=(u32x4){PKW(pB0,0),PKW(pB0,2),PKW(pB0,4),PKW(pB0,6)};pw1=(u32x4){PKW(pB0,8),PKW(pB0,10),PKW(pB0,12),PKW(pB0,14)};pw2=(u32x4){PKW(pB1,0),PKW(pB1,2),PKW(pB1,4),PKW(pB1,6)};pw3=(u32x4){PKW(pB1,8),PKW(pB1,10),PKW(pB1,12),PKW(pB1,14)};
    SBAR();
    int ln_=lane; asm volatile("":"+v"(ln_));
    const int vb0=(int)(lds0+LDS_V)+((ln_>>4)&1)*32+(ln_&3)*8+(4*(ln_>>5)+((ln_&15)>>2))*64;
    pv(o,vb0+2*sl_cur,PAF(0),PAF(1),PAF(2),PAF(3)); }
  #undef PKW
  #undef PAF
  #undef VFR
  #undef PIN
  #undef MX3
  #undef GAPA
  #undef GAPB
  #undef EX
  #undef VRDS
  #undef VOFF
  #undef PAF_SEL
  #undef VRDA
  #undef VRDB
  #undef TS
  #undef ATTN_LIVE
  #undef QKV
  #undef PVV
  #undef KRD
  #undef KRDE
  #undef KRDL
  #undef STEP
  #undef QPRE
  #undef MAP0_FIN
  #undef ENDW
  {auto rr=__builtin_amdgcn_permlane32_swap(__float_as_uint(l_reg),__float_as_uint(l_reg),false,false);l_reg=__uint_as_float(rr[0])+__uint_as_float(rr[1]);}
  { int l2_=lane; asm volatile("":"+v"(l2_)); if((l2_>>5)==0)wsf[32+(l2_&31)]=l_reg; } asm volatile("s_waitcnt lgkmcnt(0)":::"memory");
  float rli[16];
  #pragma unroll
  for(int r=0;r<16;++r)rli[r]=__builtin_amdgcn_rcpf(wsf[32+crow(r,hi)]);
  { bf16*stg=(bf16*)(shm+LDS_OST)+wid*4096;
    if(false){
      #pragma unroll
      for(int r=0;r<16;++r){const int orow=crow(r,hi);
        #pragma unroll
        for(int d0=0;d0<4;++d0)stg[orow*128+d0*32+r32]=__float2bfloat16(o[d0][r]*rli[r]);}
    } else {
      #pragma unroll
      for(int r=0;r<16;++r){const int orow=crow(r,hi);
        #pragma unroll
        for(int d0=0;d0<4;++d0){const float prev=__bfloat162float(stg[orow*128+d0*32+r32]); stg[orow*128+d0*32+r32]=__float2bfloat16(prev-lam*(o[d0][r]*rli[r]));}}
    }
    asm volatile("s_waitcnt lgkmcnt(0)":::"memory");
    {
      int le_=lane; asm volatile("":"+v"(le_));
      const int ch=le_&7;
      float ga[8],gb[8];
      #pragma unroll
      for(int j=0;j<8;++j){ga[j]=gsub[ch*8+j];gb[j]=gsub[64+ch*8+j];}
      bf16*Yw=YA+(rowbase+q0+wid*QBLK)*DM+head*128;
      #pragma unroll
      for(int i=0;i<4;++i){const int row=i*8+(le_>>3);
        const u32x4 va=*(const u32x4*)(stg+row*128+ch*8),vb=*(const u32x4*)(stg+row*128+64+ch*8);
        float a[8],bb[8];
        #pragma unroll
        for(int j=0;j<4;++j){a[2*j]=__uint_as_float(va[j]<<16);a[2*j+1]=__uint_as_float(va[j]&0xffff0000u);bb[2*j]=__uint_as_float(vb[j]<<16);bb[2*j+1]=__uint_as_float(vb[j]&0xffff0000u);}
        float ss=0.f;
        #pragma unroll
        for(int j=0;j<8;++j)ss+=a[j]*a[j]+bb[j]*bb[j];
        ss+=__builtin_bit_cast(float,__builtin_amdgcn_update_dpp(0,__builtin_bit_cast(int,ss),0xB1,0xf,0xf,false));
        ss+=__builtin_bit_cast(float,__builtin_amdgcn_update_dpp(0,__builtin_bit_cast(int,ss),0x4E,0xf,0xf,false));
        ss+=__builtin_bit_cast(float,__builtin_amdgcn_update_dpp(0,__builtin_bit_cast(int,ss),0x141,0xf,0xf,false));
        const float rn=1.0f/sqrtf(ss*(1.f/128.f)+1e-6f);
        u32x4 oa,ob;
        #pragma unroll
        for(int j=0;j<4;++j){oa[j]=cvtpk_s(a[2*j]*rn*ga[2*j],a[2*j+1]*rn*ga[2*j+1]);ob[j]=cvtpk_s(bb[2*j]*rn*gb[2*j],bb[2*j+1]*rn*gb[2*j+1]);}
        ATTN_STORE16(Yw+(long)row*DM+ch*8,oa);ATTN_STORE16(Yw+(long)row*DM+64+ch*8,ob);}
    } }
  asm volatile("s_waitcnt lgkmcnt(0)\n\ts_barrier":::"memory");
  #undef KOFS
  #undef VOFS
  #undef DMA_K
  #undef DMA_V
  #undef DMA_V0
  #undef DMA_V1
  #undef CMASK
  #undef START
  #undef RESC
  #undef ROT
}
constexpr int ATTN_LDS_BYTES=LDS_BYTES;
struct AttnTensors { const bf16* Q; const bf16* K; const bf16* V; bf16* YA; const float* gsub; float lam; int dbg_qb; };
template<int THRL=8> __device__ __forceinline__ unsigned attn_phase(char*lds,const AttnTensors&T,int grid,int block,const int wid){
  unsigned tac0=0u,tac1=0u,tac2=0u,tac3=0u;
  const int vcu=(grid%8==0)?(block%8)*(grid/8)+block/8:block;
  for(int it=vcu;it<256;it+=grid){
    const int b=it>>5,j=it&31,hsel=j>>4,qi=j&15,qj=(qi+8)&15;
    for(int k=0;k<4;++k){
#if ATTN_MAP_OLD
      const int s=it&3,head=(it>>2)&7; const int qb=(T.dbg_qb>=0)?T.dbg_qb:((k==0)?15-s:(k==1)?8+s:(k==2)?7-s:s);
#else
      const int head=2*k+hsel; const int qb=(T.dbg_qb>=0)?T.dbg_qb:((k==0)?qi:(k==1)?15-qi:(k==2)?qj:15-qj);
#endif
      attn_unit<THRL>(b,head,qb,T.Q,T.K,T.V,T.YA,lds,T.lam,T.gsub,wid,T.dbg_qb==-2,tac0,tac1,tac2,tac3);
    }
  }
  return (ATTN_TIMING==1)?tac0:(ATTN_TIMING==2)?tac1:(ATTN_TIMING==3)?tac2:(ATTN_TIMING==4)?tac3:(tac0+tac1+tac2+tac3)*0u;
}
#undef SBAR
#undef WAIT_BAR
#undef WAIT_BARX
}
#define GAS __attribute__((address_space(1)))
#define LAS __attribute__((address_space(3)))
typedef unsigned short bf16;
typedef unsigned v4u __attribute__((ext_vector_type(4)));
typedef unsigned v2u __attribute__((ext_vector_type(2)));
typedef float f32x4 __attribute__((ext_vector_type(4)));
typedef float f32x2 __attribute__((ext_vector_type(2)));
typedef short bf16x8 __attribute__((ext_vector_type(8)));
typedef __bf16 bf16x2_t __attribute__((ext_vector_type(2)));

constexpr int NWAVES = 8, NTHR = NWAVES * 64;
constexpr int LDS_MISC = 147456 - 64;
constexpr int T_ = 32768, D_ = 1024, S_ = 4096, NB_ = 8, DIN_ = 7168, NEXP_ = 16384;
constexpr float EPS_ = 1e-6f;
constexpr float C2_ = 0.125f * 1.4426950408889634f;
constexpr float LAM_INIT_ = 0.2f;

constexpr size_t MiB = 1u << 20;
constexpr size_t WS_CTL = 0;
constexpr size_t WS_WIN = 2 * MiB;
constexpr size_t WS_WA = 16 * MiB;
constexpr size_t WS_WB = 18 * MiB;
constexpr size_t WS_WO = 20 * MiB;
constexpr size_t WS_WQS = 22 * MiB;
constexpr size_t WS_SGW = 26 * MiB;
constexpr size_t WS_GSUB = 27 * MiB;
constexpr size_t WS_UT = 28 * MiB;
constexpr size_t WS_VT = 60 * MiB;
constexpr size_t WS_XN = 96 * MiB;
constexpr size_t WS_Q = 160 * MiB;
constexpr size_t WS_K = 224 * MiB;
constexpr size_t WS_V = 288 * MiB;
constexpr size_t WS_SU = 352 * MiB;
constexpr size_t WS_SV = 416 * MiB;
constexpr size_t WS_SC = 160 * MiB;
constexpr size_t WS_END = 480 * MiB;

__device__ __forceinline__ unsigned f2bf(float f) { unsigned u = __builtin_bit_cast(unsigned, f); return (u + 0x7fffu + ((u >> 16) & 1u)) >> 16; }
__device__ __forceinline__ unsigned pk2(float lo, float hi) { f32x2 v = {lo, hi}; return __builtin_bit_cast(unsigned, __builtin_convertvector(v, bf16x2_t)); }
__device__ __forceinline__ float bflo(unsigned u) { return __builtin_bit_cast(float, u << 16); }
__device__ __forceinline__ float bfhi(unsigned u) { return __builtin_bit_cast(float, u & 0xffff0000u); }
__device__ __forceinline__ float bf2f(bf16 h) { return __builtin_bit_cast(float, (unsigned)h << 16); }
#define WDPP_F(x_, ctrl_) __builtin_bit_cast(float, __builtin_amdgcn_update_dpp(0, __builtin_bit_cast(int, (x_)), (ctrl_), 0xf, 0xf, false))
__device__ __forceinline__ float wave_sum(float v) {
    v += WDPP_F(v, 0xB1); v += WDPP_F(v, 0x4E); v += WDPP_F(v, 0x141); v += WDPP_F(v, 0x140);
    { auto r = __builtin_amdgcn_permlane16_swap(__float_as_uint(v), __float_as_uint(v), false, false); v = __uint_as_float(r[0]) + __uint_as_float(r[1]); }
    { auto r = __builtin_amdgcn_permlane32_swap(__float_as_uint(v), __float_as_uint(v), false, false); v = __uint_as_float(r[0]) + __uint_as_float(r[1]); }
    return v;
}
__device__ __forceinline__ float wave_max(float v) {
    v = fmaxf(v, WDPP_F(v, 0xB1)); v = fmaxf(v, WDPP_F(v, 0x4E)); v = fmaxf(v, WDPP_F(v, 0x141)); v = fmaxf(v, WDPP_F(v, 0x140));
    { auto r = __builtin_amdgcn_permlane16_swap(__float_as_uint(v), __float_as_uint(v), false, false); v = fmaxf(__uint_as_float(r[0]), __uint_as_float(r[1])); }
    { auto r = __builtin_amdgcn_permlane32_swap(__float_as_uint(v), __float_as_uint(v), false, false); v = fmaxf(__uint_as_float(r[0]), __uint_as_float(r[1])); }
    return v;
}
#define XB_TMO      128
#define XB_XCNT(j)  (256  + 64 * (j))
#define XB_XSUB(j)  (1280 + 64 * (j))
#define XB_XGEN(j)  (2304 + 64 * (j))
#define XB_TOP      3328
#define XB_TOPGEN   3392
#define XCD_BAR_WORDS 3456
#define XB_SPIN_CAP (1u << 22)

__device__ __forceinline__ unsigned xb_ld(unsigned* p)              { return __hip_atomic_load(p, __ATOMIC_RELAXED, __HIP_MEMORY_SCOPE_AGENT); }
__device__ __forceinline__ unsigned xb_add(unsigned* p, unsigned v) { return __hip_atomic_fetch_add(p, v, __ATOMIC_RELAXED, __HIP_MEMORY_SCOPE_AGENT); }
__device__ __forceinline__ unsigned xb_xcc_id() { return (unsigned)__builtin_amdgcn_s_getreg((3 << 11) | 20) & 0xFu; }
#define XB_SPIN(cond, bar) do { unsigned _sp = 0; while (cond) { __builtin_amdgcn_s_sleep(1); \
    if ((++_sp & 255u) == 0u) { if (xb_ld(&(bar)[XB_TMO])) break; if (_sp > XB_SPIN_CAP) { atomicAdd(&(bar)[XB_TMO], 1u); break; } } } } while (0)

struct XcdBarrier {
    unsigned* bar; unsigned x;
    volatile LAS unsigned* st;
};

__device__ __forceinline__ XcdBarrier xcd_barrier_post(unsigned* bar, volatile LAS unsigned* st, const int tid) {
    XcdBarrier b; b.bar = bar; b.x = xb_xcc_id(); b.st = st;
    if (tid == 0) st[3] = 1u + xb_add(&bar[XB_XCNT(b.x)], 1u);
    return b;
}
__device__ __forceinline__ void xcd_barrier_complete(unsigned* bar, unsigned x, unsigned& nloc, unsigned& nx, unsigned& uni) {
    const unsigned G = gridDim.x * gridDim.y * gridDim.z;
    unsigned sum, cnt, mine, sp = 0u;
    for (;;) {
        sum = 0u; cnt = 0u; mine = 0u; uni = 1u;
#pragma unroll
        for (unsigned j = 0; j < 16; ++j) { const unsigned c = xb_ld(&bar[XB_XCNT(j)]); sum += c; cnt += (c > 0u) ? 1u : 0u; mine = (j == x) ? c : mine;
            if (c != ((j < 8u && (G & 7u) == 0u) ? G / 8u : 0u)) uni = 2u; }
        if (sum == G) break;
        __builtin_amdgcn_s_sleep(1);
        if ((++sp & 255u) == 0u) { if (xb_ld(&bar[XB_TMO])) break; if (sp > XB_SPIN_CAP) { atomicAdd(&bar[XB_TMO], 1u); break; } }
    }
    nloc = mine > 0u ? mine : 1u; nx = cnt > 0u ? cnt : 1u; if (sum != G) uni = 2u;
}

__device__ __forceinline__ void xcd_barrier(const XcdBarrier& b, const int tid) {
    asm volatile("s_waitcnt vmcnt(0)" ::: "memory");
    __syncthreads();
    if (tid == 0) {
        unsigned* bar = b.bar;
        __builtin_amdgcn_s_waitcnt(0);
        unsigned nloc = b.st[0], nx = b.st[1];
        if (nloc == 0u) { unsigned uni; xcd_barrier_complete(bar, b.x, nloc, nx, uni); b.st[0] = nloc; b.st[1] = nx; b.st[2] = uni; }
        const unsigned old = xb_add(&bar[XB_XSUB(b.x)], 1u);
        const unsigned gen = old / nloc;
        if (old + 1u == (gen + 1u) * nloc) {
            __builtin_amdgcn_fence(__ATOMIC_RELEASE, "agent");
            asm volatile("s_waitcnt vmcnt(0)" ::: "memory");
            const unsigned og = xb_add(&bar[XB_TOP], 1u);
            const unsigned tg = og / nx;
            if (og + 1u == (tg + 1u) * nx) xb_add(&bar[XB_TOPGEN], 1u);
            else XB_SPIN(xb_ld(&bar[XB_TOPGEN]) == tg, bar);
            __builtin_amdgcn_fence(__ATOMIC_ACQUIRE, "agent");
            xb_add(&bar[XB_XGEN(b.x)], 1u);
            asm volatile("s_waitcnt vmcnt(0)" ::: "memory");
        } else {
            XB_SPIN(xb_ld(&bar[XB_XGEN(b.x)]) == gen, bar);
            __builtin_amdgcn_fence(__ATOMIC_ACQUIRE, "agent");
            asm volatile("s_waitcnt vmcnt(0)" ::: "memory");
        }
    }
    __syncthreads();
}

__device__ __forceinline__ void xcd_barrier_local(const XcdBarrier& b, const int tid) {
    asm volatile("s_waitcnt vmcnt(0)" ::: "memory");
    __syncthreads();
    if (tid == 0) {
        unsigned* bar = b.bar;
        __builtin_amdgcn_s_waitcnt(0);
        const unsigned nloc = b.st[0];
        const unsigned old = xb_add(&bar[XB_XSUB(b.x)], 1u);
        const unsigned gen = old / nloc;
        if (old + 1u == (gen + 1u) * nloc) xb_add(&bar[XB_XGEN(b.x)], 1u);
        else XB_SPIN(xb_ld(&bar[XB_XGEN(b.x)]) == gen, bar);
        __builtin_amdgcn_fence(__ATOMIC_ACQUIRE, "agent");
        asm volatile("s_waitcnt vmcnt(0)" ::: "memory");
    }
    __syncthreads();
}
__device__ __forceinline__ float gelu1(float v) {
    const float av = fabsf(v), d = av * 0.2316418882f + 1.0f;
    const float t = __builtin_amdgcn_rcpf(d);
    float q = t * 0.5307027145f + (-0.7265760135f); q = q * t + 0.7107068705f; q = q * t + (-0.142248368f); q = q * t + 0.127414796f; q = q * t;
    const float e = __builtin_amdgcn_exp2f((v * v) * (-0.72134752044f));
    const float m = v * (q * e), r = v - m;
    return v < 0.f ? m : r;
}
__device__ __forceinline__ float sigmoid1(float v) { return __builtin_amdgcn_rcpf(1.0f + __builtin_amdgcn_exp2f(-1.4426950408889634f * v)); }
__device__ __forceinline__ void store4bf(bf16* p, f32x4 v) { v2u w; w.x = pk2(v[0], v[1]); w.y = pk2(v[2], v[3]); *(v2u*)p = w; }

struct Args { const float* in[21]; float* out; unsigned char* ws; int ph_lo, ph_hi; };
struct Frame {
    LAS unsigned char* lds;
    int tid, lane, wave, G, bid;
};
#define WSP(A, off) ((bf16*)((A).ws + (off)))

__device__ __forceinline__ void p0_transpose_item(const float* W, int K, int N, bf16* WT, LAS float* scr, int item, int lane) {
    const int nblk = N / 32, kb = item / nblk, nb = item % nblk, k0 = 64 * kb, n0 = 32 * nb;
#pragma unroll 8
    for (int i = 0; i < 32; ++i) { const int kk = 2 * i + (lane >> 5); scr[kk * 33 + (lane & 31)] = W[(size_t)(k0 + kk) * N + n0 + (lane & 31)]; }
    asm volatile("s_waitcnt lgkmcnt(0)" ::: "memory");
    const int c = lane & 7;
#pragma unroll
    for (int j = 0; j < 4; ++j) { const int n = (lane >> 3) + 8 * j; const LAS float* s = scr + (8 * c) * 33 + n;
        v4u o; o.x = pk2(s[0 * 33], s[1 * 33]); o.y = pk2(s[2 * 33], s[3 * 33]); o.z = pk2(s[4 * 33], s[5 * 33]); o.w = pk2(s[6 * 33], s[7 * 33]);
        *(v4u*)(WT + (size_t)(n0 + n) * K + k0 + 8 * c) = o; }
    asm volatile("s_waitcnt lgkmcnt(0)" ::: "memory");
}

__device__ __forceinline__ int vcu_of(const Frame& F) { int G = F.G; asm volatile("" : "+s"(G));
    return (G % 8 == 0) ? (F.bid % 8) * (G / 8) + F.bid / 8 : F.bid; }
__device__ __forceinline__ unsigned short* sc_row(const Args& A, int t) {
    return (unsigned short*)(A.ws + WS_Q + ((size_t)(t >> 12) << 23) + ((size_t)((t >> 11) & 1) * (WS_K - WS_Q)) + ((size_t)(t & 2047) << 12)); }
__device__ __forceinline__ v2u* lst_row(const Args& A, int t) {
    return (v2u*)(A.ws + WS_SU + ((size_t)(t >> 12) << 23) + ((size_t)(t & 4095) << 10)); }
__device__ __forceinline__ int peer_grp(const Frame& F, int j) { const int gwv = vcu_of(F) * NWAVES + F.wave; return (F.G == 256) ? ((gwv >> 8) << 10) + (j << 8) + (gwv & 255) : gwv + j * F.G * NWAVES; }
__device__ __forceinline__ int peer_ngrp(const Frame& F) { return (F.G == 256) ? 4 : (T_ / 4 - (vcu_of(F) * NWAVES + F.wave) + F.G * NWAVES - 1) / (F.G * NWAVES); }

__device__ __forceinline__ v4u pk8(f32x4 a, f32x4 b);
__device__ __forceinline__ void p0_prologue(Frame& F, const Args& A, const int part, const bool do_w, const int tlo, const int thi) {
    LAS float* scr = (LAS float*)(F.lds + F.wave * 16384);
    const int gw = F.bid * NWAVES + F.wave, NGW = F.G * NWAVES;
    const int gt = F.bid * NTHR + F.tid, NGT = F.G * NTHR;
    constexpr int I_IN = (D_ / 64) * (DIN_ / 32), I_SQ = (D_ / 64) * (D_ / 32);
    constexpr int NITEMS = I_IN + 3 * I_SQ;
    if (part == 0 || do_w) for (int it = gw + (part ? I_IN : 0); it < (part ? NITEMS : I_IN); it += NGW) {
        int r = it;
        if (r < I_IN) { p0_transpose_item(A.in[2], D_, DIN_, WSP(A, WS_WIN), scr, r, F.lane); continue; } r -= I_IN;
        if (r < I_SQ) { p0_transpose_item(A.in[12], D_, D_, WSP(A, WS_WA), scr, r, F.lane); continue; } r -= I_SQ;
        if (r < I_SQ) { p0_transpose_item(A.in[13], D_, D_, WSP(A, WS_WB), scr, r, F.lane); continue; } r -= I_SQ;
        p0_transpose_item(A.in[14], D_, D_, WSP(A, WS_WO), scr, r, F.lane);
    }
    if (part == 1 && do_w) {
        const float* Wq = A.in[16]; const float* sk = A.in[17]; const float* g2 = A.in[15]; bf16* WQS = WSP(A, WS_WQS);
        LAS float* skL = (LAS float*)F.lds;
        LAS float* wqT = (LAS float*)(F.lds + 65536);
        for (int it = F.bid; it < 256; it += F.G) {
            const int sl = it >> 4, db = it & 15, p = sl & 1;
            __syncthreads();
#pragma unroll
            for (int q = 0; q < 8; ++q) { const int idx = F.tid + 512 * q; *(LAS f32x4*)(skL + idx * 4) = *(const f32x4*)(sk + (size_t)p * 16384 + idx * 4); }
#pragma unroll
            for (int q = 0; q < 4; ++q) { const int idx = F.tid + 512 * q, d = idx >> 5, c4 = (idx & 31) * 4;
                const f32x4 w = *(const f32x4*)(Wq + (size_t)(db * 64 + d) * 2048 + sl * 128 + c4);
                wqT[(c4 + 0) * 65 + d] = w[0]; wqT[(c4 + 1) * 65 + d] = w[1]; wqT[(c4 + 2) * 65 + d] = w[2]; wqT[(c4 + 3) * 65 + d] = w[3]; }
            __syncthreads();
            const int d = F.tid & 63, g = F.tid >> 6;
            float acc[16];
#pragma unroll
            for (int i = 0; i < 16; ++i) acc[i] = 0.f;
#pragma unroll 2
            for (int c = 0; c < 128; c += 4) {
                const float w0 = wqT[(c + 0) * 65 + d], w1 = wqT[(c + 1) * 65 + d], w2 = wqT[(c + 2) * 65 + d], w3 = wqT[(c + 3) * 65 + d];
#pragma unroll
                for (int i = 0; i < 16; ++i) { const f32x4 s = *(const LAS f32x4*)(skL + (g * 16 + i) * 128 + c); acc[i] += (w0 * s[0] + w1 * s[1]) + (w2 * s[2] + w3 * s[3]); }
            }
            const float gg = g2[db * 64 + d];
#pragma unroll
            for (int i = 0; i < 16; ++i) WQS[(size_t)(sl * 128 + g * 16 + i) * 1024 + db * 64 + d] = (bf16)f2bf(acc[i] * gg);
        }
        __syncthreads();
    }
    if (part == 0 && gt < 128) ((float*)(A.ws + WS_GSUB))[gt] = A.in[7][gt] * (1.0f - LAM_INIT_);
    if (part == 0) for (int it = gt; it < 8 * 128 * 128; it += NGT) { const int j = it & 127, i = (it >> 7) & 127; const float w = A.in[10][it]; WSP(A, WS_SGW)[it] = (bf16)f2bf(((i >> 6) >= (j >> 6)) ? w : 0.f); }
    if (part == 1) for (int st = tlo; st < thi; ++st) { const int r0 = gw + st * 4 * NGW;
        f32x4 v[4][4];
#pragma unroll
        for (int k = 0; k < 4; ++k) { const int r = min(r0 + k * NGW, 2 * NEXP_ - 1), tb = r >= NEXP_, e = tb ? r - NEXP_ : r;
            const float* src = (tb ? A.in[19] : A.in[18]) + (size_t)e * D_ + 16 * F.lane;
#pragma unroll
            for (int i = 0; i < 4; ++i) v[k][i] = *(const f32x4*)(src + 4 * i); }
#pragma unroll
        for (int k = 0; k < 4; ++k) { const int r = min(r0 + k * NGW, 2 * NEXP_ - 1), tb = r >= NEXP_, e = tb ? r - NEXP_ : r;
            float mx = 0.f;
#pragma unroll
            for (int i = 0; i < 4; ++i) mx = fmaxf(mx, fmaxf(fmaxf(fabsf(v[k][i][0]), fabsf(v[k][i][1])), fmaxf(fabsf(v[k][i][2]), fabsf(v[k][i][3]))));
            mx = wave_max(mx);
            const float top = tb ? 240.0f : 127.0f;
            const float sc = mx > 0.f ? top / mx : 1.0f, inv = mx > 0.f ? mx / top : 1.0f;
            v4u o;
            if (tb) {
#pragma unroll
                for (int i = 0; i < 4; ++i) { int p = __builtin_amdgcn_cvt_pk_fp8_f32(v[k][i][0] * sc, v[k][i][1] * sc, 0, false); p = __builtin_amdgcn_cvt_pk_fp8_f32(v[k][i][2] * sc, v[k][i][3] * sc, p, true); o[i] = (unsigned)p; }
            } else {
#pragma unroll
                for (int i = 0; i < 4; ++i) { const int q0 = __float2int_rn(v[k][i][0] * sc), q1 = __float2int_rn(v[k][i][1] * sc), q2 = __float2int_rn(v[k][i][2] * sc), q3 = __float2int_rn(v[k][i][3] * sc);
                    o[i] = (unsigned)(q0 & 0xff) | ((unsigned)(q1 & 0xff) << 8) | ((unsigned)(q2 & 0xff) << 16) | ((unsigned)(q3 & 0xff) << 24); }
            }
            unsigned char* tab = A.ws + (tb ? WS_VT : WS_UT);
            *(v4u*)(tab + (size_t)e * 1024 + 16 * F.lane) = o;
            if (F.lane == 0) ((float*)(tab + 16 * MiB))[e] = inv; }
    }
    if (part == 0) {
        const float* g1 = A.in[1]; const float* X = A.in[0]; bf16* XN = WSP(A, WS_XN);
        f32x4 gv[4];
#pragma unroll
        for (int j = 0; j < 4; ++j) gv[j] = *(const f32x4*)(g1 + (j >> 1) * 512 + 8 * F.lane + 4 * (j & 1));
        constexpr int XR = P0_XROWS;
        for (int m0 = gw; m0 < T_; m0 += XR * NGW) {
            f32x4 v[XR][4];
#pragma unroll
            for (int k = 0; k < XR; ++k) { const float* xr = X + (size_t)min(m0 + k * NGW, T_ - 1) * D_ + 8 * F.lane;
#pragma unroll
                for (int jj = 0; jj < 4; ++jj) v[k][jj] = *(const f32x4*)(xr + (jj >> 1) * 512 + 4 * (jj & 1)); }
#pragma unroll
            for (int k = 0; k < XR; ++k) { float s = 0.f;
#pragma unroll
                for (int jj = 0; jj < 4; ++jj) s += (v[k][jj][0] * v[k][jj][0] + v[k][jj][1] * v[k][jj][1]) + (v[k][jj][2] * v[k][jj][2] + v[k][jj][3] * v[k][jj][3]);
                const float rstd = 1.0f / sqrtf(wave_sum(s) * (1.f / D_) + EPS_);
                bf16* o8 = XN + (size_t)min(m0 + k * NGW, T_ - 1) * D_ + 8 * F.lane;
                *(v4u*)o8 = pk8(v[k][0] * rstd * gv[0], v[k][1] * rstd * gv[1]);
                *(v4u*)(o8 + 512) = pk8(v[k][2] * rstd * gv[2], v[k][3] * rstd * gv[3]); }
        }
    }
}

__device__ __forceinline__ void st16(void* p, v4u v) {
#if ST_SC1
    asm volatile("global_store_dwordx4 %0, %1, off sc1\n\ts_nop 1" :: "v"(p), "v"(v) : "memory");
#else
    *(v4u*)p = v;
#endif
}
__device__ __forceinline__ v4u pk8(f32x4 a, f32x4 b) { v4u w; w.x = pk2(a[0], a[1]); w.y = pk2(a[2], a[3]); w.z = pk2(b[0], b[1]); w.w = pk2(b[2], b[3]); return w; }
__device__ __forceinline__ f32x4 gelu4(f32x4 v) { const pg8::f32x2 a = pg8::gelu_pk((pg8::f32x2){v[0], v[1]}), b = pg8::gelu_pk((pg8::f32x2){v[2], v[3]}); return (f32x4){a.x, a.y, b.x, b.y}; }
__device__ __forceinline__ f32x4 sigmoid4(f32x4 v) {
    const f32x4 t = v * (-1.4426950408889634f);
    f32x4 e = {__builtin_amdgcn_exp2f(t[0]), __builtin_amdgcn_exp2f(t[1]), __builtin_amdgcn_exp2f(t[2]), __builtin_amdgcn_exp2f(t[3])};
    e = e + 1.0f;
    return (f32x4){__builtin_amdgcn_rcpf(e[0]), __builtin_amdgcn_rcpf(e[1]), __builtin_amdgcn_rcpf(e[2]), __builtin_amdgcn_rcpf(e[3])};
}
__device__ __forceinline__ f32x4 bf4lo(v4u w) { return (f32x4){bflo(w.x), bfhi(w.x), bflo(w.y), bfhi(w.y)}; }
__device__ __forceinline__ f32x4 bf4hi(v4u w) { return (f32x4){bflo(w.z), bfhi(w.z), bflo(w.w), bfhi(w.w)}; }
struct EpiIn {
    bf16 *Q, *K, *V, *SU, *SV, *GT;
    __device__ __forceinline__ void operator()(int row, int col, f32x4 a, f32x4 b) const {
        if (col < 1024) { st16(Q + (size_t)row * 1024 + col, pk8(a * C2_, b * C2_)); }
        else if (col < 2048) { st16(K + (size_t)row * 1024 + (col - 1024), pk8(a, b)); }
        else if (col < 3072) { st16(V + (size_t)row * 1024 + (col - 2048), pk8(a, b)); }
        else if (col < 4096) { st16(SU + (size_t)row * 1024 + (col - 3072), pk8(gelu4(a), gelu4(b))); }
        else if (col < 5120) { st16(SV + (size_t)row * 1024 + (col - 4096), pk8(gelu4(a), gelu4(b))); }
        else { st16(GT + (size_t)row * 2048 + (col - 5120), pk8(sigmoid4(a), sigmoid4(b))); }
    }
};
struct EpiBrA {
    const bf16* GT; bf16* TMP;
    __device__ __forceinline__ void operator()(int row, int col, f32x4 a, f32x4 b) const {
        const v4u g = *(const v4u*)(GT + (size_t)row * 2048 + col);
        *(v4u*)(TMP + (size_t)row * 1024 + col) = pk8(a * bf4lo(g), b * bf4hi(g));
    }
};
struct EpiBrB {
    const bf16* GT; const bf16* TMP; bf16* MG;
    __device__ __forceinline__ void operator()(int row, int col, f32x4 a, f32x4 b) const {
        const v4u g = *(const v4u*)(GT + (size_t)row * 2048 + 1024 + col);
        const v4u t = *(const v4u*)(TMP + (size_t)row * 1024 + col);
        *(v4u*)(MG + (size_t)row * 1024 + col) = pk8(bf4lo(t) + a * bf4lo(g), bf4hi(t) + b * bf4hi(g));
    }
};
struct EpiOut {
    const float* X; bf16* HB;
    __device__ __forceinline__ void operator()(int row, int col, f32x4 a, f32x4 b) const {
        const float* xp = X + (size_t)row * 1024 + col;
        const f32x4 h0 = *(const f32x4*)xp + a, h1 = *(const f32x4*)(xp + 4) + b;
        st16(HB + (size_t)row * 1024 + col, pk8(h0, h1));
    }
};
typedef _Float16 h16x2 __attribute__((ext_vector_type(2)));
__device__ __forceinline__ unsigned pkh2(float lo, float hi) { f32x2 v = {lo, hi}; return __builtin_bit_cast(unsigned, __builtin_convertvector(v, h16x2)); }
struct EpiSc {
    const Args* AP;
    __device__ __forceinline__ void operator()(int row, int col, f32x4 a, f32x4 b) const {
        v4u w; w.x = pkh2(a[0], a[1]); w.y = pkh2(a[2], a[3]); w.z = pkh2(b[0], b[1]); w.w = pkh2(b[2], b[3]);
        st16(sc_row(*AP, row) + col, w);
    }
};

template <class T> __device__ __forceinline__ auto qptr_(const T& t, int) -> decltype(t.Q) { return t.Q; }
template <class T> __device__ __forceinline__ bf16* qptr_(const T&, long) { return nullptr; }
template <class T> __device__ __forceinline__ auto gptr_(const T& t, int) -> decltype(t.GT) { return t.GT; }
template <class T> __device__ __forceinline__ bf16* gptr_(const T&, long) { return nullptr; }
template <class Fn> struct EpiWrap {
    static constexpr bool PERM = true, AFTER_DRAIN = false, KSPLIT = false; static constexpr int NSTORE = EPI_SKIP ? 0 : 16;
    Fn f; int skip;
    __device__ __forceinline__ void operator()(const pg8::f32x4 (&acc)[2][2][4][2], const pg8::Unit& u, int wr, int wc, int fr, int fq) const {
        asm volatile("" : "+v"(fr), "+v"(fq));
#if EPI_SKIP == 1
        if (skip) {
#pragma unroll
            for (int ai = 0; ai < 2; ++ai)
#pragma unroll
                for (int m = 0; m < 4; ++m)
#pragma unroll
                    for (int bj = 0; bj < 2; ++bj) asm volatile("" :: "v"(acc[ai][bj][m][0]), "v"(acc[ai][bj][m][1]));
            return; }
#endif
#if EPI_SKIP == 3
        if (skip) {
            const int wid_ = wr * 4 + wc, lane_ = fq * 16 + fr;
            const int ti_ = u.pm * 28 + u.pn; bf16* tb_ = (ti_ < 2560) ? qptr_(f, 0) + (size_t)ti_ * 65536 : gptr_(f, 0) + (size_t)(ti_ - 2560) * 65536;
#pragma unroll
            for (int ai = 0; ai < 2; ++ai)
#pragma unroll
                for (int m = 0; m < 4; ++m)
#pragma unroll
                    for (int bj = 0; bj < 2; ++bj) { const int col_ = u.pn * 256 + bj * 128 + wc * 32 + 8 * fq;
                        const f32x4 a_ = acc[ai][bj][m][0], b_ = acc[ai][bj][m][1];
                        v4u w_;
                        if (col_ < 1024) w_ = pk8(a_ * C2_, b_ * C2_); else if (col_ < 3072) w_ = pk8(a_, b_); else if (col_ < 5120) w_ = pk8(gelu4(a_), gelu4(b_)); else w_ = pk8(sigmoid4(a_), sigmoid4(b_));
                        *(v4u*)(tb_ + ((ai * 4 + m) * 2 + bj) * 4096 + wid_ * 512 + lane_ * 8) = w_; }
            return; }
#endif
#if EPI_SKIP == 2
        if (skip) {
#pragma unroll
            for (int ai = 0; ai < 2; ++ai)
#pragma unroll
                for (int m = 0; m < 4; ++m)
#pragma unroll
                    for (int bj = 0; bj < 2; ++bj) { const int col_ = u.pn * 256 + bj * 128 + wc * 32 + 8 * fq;
                        f((u.pm & 3) * 256 + ai * 128 + wr * 64 + m * 16 + fr, (col_ & ~1023) | (col_ & 255), acc[ai][bj][m][0], acc[ai][bj][m][1]); }
            return; }
#endif
#pragma unroll
        for (int ai = 0; ai < 2; ++ai)
#pragma unroll
            for (int m = 0; m < 4; ++m)
#pragma unroll
                for (int bj = 0; bj < 2; ++bj)
                    f(u.pm * 256 + ai * 128 + wr * 64 + m * 16 + fr, u.pn * 256 + bj * 128 + wc * 32 + 8 * fq, acc[ai][bj][m][0], acc[ai][bj][m][1]);
    }
};

struct EpiMerge {
    static constexpr bool PERM = true, AFTER_DRAIN = false, KSPLIT = true; static constexpr int NSTORE = 16;
    const bf16* GT; bf16* MG;
    __device__ __forceinline__ void mid(pg8::f32x4 (&acc)[2][2][4][2], const pg8::Unit& u, int wr, int wc, int fr, int fq) const {
        asm volatile("" : "+v"(fr), "+v"(fq));
#pragma unroll
        for (int ai = 0; ai < 2; ++ai)
#pragma unroll
            for (int m = 0; m < 4; ++m)
#pragma unroll
                for (int bj = 0; bj < 2; ++bj) {
                    const int row = u.pm * 256 + ai * 128 + wr * 64 + m * 16 + fr, col = u.pn * 256 + bj * 128 + wc * 32 + 8 * fq;
                    const v4u ga = *(const v4u*)(GT + (size_t)row * 2048 + col), gb = *(const v4u*)(GT + (size_t)row * 2048 + 1024 + col);
                    const f32x4 b0 = bf4lo(gb), b1 = bf4hi(gb);
                    const f32x4 r0 = bf4lo(ga) * (f32x4){__builtin_amdgcn_rcpf(fmaxf(b0[0], 1e-20f)), __builtin_amdgcn_rcpf(fmaxf(b0[1], 1e-20f)), __builtin_amdgcn_rcpf(fmaxf(b0[2], 1e-20f)), __builtin_amdgcn_rcpf(fmaxf(b0[3], 1e-20f))};
                    const f32x4 r1 = bf4hi(ga) * (f32x4){__builtin_amdgcn_rcpf(fmaxf(b1[0], 1e-20f)), __builtin_amdgcn_rcpf(fmaxf(b1[1], 1e-20f)), __builtin_amdgcn_rcpf(fmaxf(b1[2], 1e-20f)), __builtin_amdgcn_rcpf(fmaxf(b1[3], 1e-20f))};
                    acc[ai][bj][m][0] = acc[ai][bj][m][0] * r0; acc[ai][bj][m][1] = acc[ai][bj][m][1] * r1;
                }
    }
    __device__ __forceinline__ void operator()(const pg8::f32x4 (&acc)[2][2][4][2], const pg8::Unit& u, int wr, int wc, int fr, int fq) const {
        asm volatile("" : "+v"(fr), "+v"(fq));
#pragma unroll
        for (int ai = 0; ai < 2; ++ai)
#pragma unroll
            for (int m = 0; m < 4; ++m)
#pragma unroll
                for (int bj = 0; bj < 2; ++bj) {
                    const int row = u.pm * 256 + ai * 128 + wr * 64 + m * 16 + fr, col = u.pn * 256 + bj * 128 + wc * 32 + 8 * fq;
                    const v4u gb = *(const v4u*)(GT + (size_t)row * 2048 + 1024 + col);
                    const f32x4 b0 = bf4lo(gb), b1 = bf4hi(gb);
                    const f32x4 c0 = {fmaxf(b0[0], 1e-20f), fmaxf(b0[1], 1e-20f), fmaxf(b0[2], 1e-20f), fmaxf(b0[3], 1e-20f)}, c1 = {fmaxf(b1[0], 1e-20f), fmaxf(b1[1], 1e-20f), fmaxf(b1[2], 1e-20f), fmaxf(b1[3], 1e-20f)};
                    st16(MG + (size_t)row * 1024 + col, pk8(acc[ai][bj][m][0] * c0, acc[ai][bj][m][1] * c1));
                }
    }
};
__device__ __forceinline__ void gemm_merge(Frame& F, const bf16* YA, const bf16* WA, long dA, long dB, const bf16* GT, bf16* MG) {
    pg8::Gemm g{YA, WA, T_, D_, D_, 2, dA, dB}; pg8::StaticOrder S; S.init(T_, D_, F.G, F.bid);
    EpiMerge E{GT, MG};
    pg8::gemm_phase<EpiMerge, pg8::StaticOrder, true, true>(F.lds, g, S, E, F.tid);
}

template <class Fn>
__device__ __forceinline__ void gemm_any(Frame& F, const bf16* A, const bf16* Bt, int M, int N, int K, const Fn& f, const int skip = 0) {
    pg8::Gemm g{A, Bt, M, N, K, 1, 0, 0}; pg8::StaticOrder S; S.init(M, N, F.G, F.bid);
    EpiWrap<Fn> E{f, skip};
    pg8::gemm_phase<EpiWrap<Fn>, pg8::StaticOrder, true, true>(F.lds, g, S, E, F.tid);
}

__device__ __forceinline__ void gmlp_naive(Frame& F, const Args& A) {
    bf16* SU = WSP(A, WS_SU); const bf16* SV = WSP(A, WS_SV);
    LAS float* vn = (LAS float*)F.lds;
    LAS float* Wl = (LAS float*)(F.lds + 65536);
    LAS float* st = (LAS float*)(F.lds + 131072);
    const float* lng = A.in[8]; const float* lnb = A.in[9]; const float* sgw = A.in[10]; const float* sgb = A.in[11];
    for (int u = F.bid; u < T_ / 128; u += F.G) {
        const int r0 = u * 128;
        __syncthreads();
        for (int rr = 0; rr < 16; ++rr) {
            const int j = F.wave * 16 + rr;
            const bf16* row = SV + (size_t)(r0 + j) * 1024;
            const v4u a = *(const v4u*)(row + 8 * F.lane), b = *(const v4u*)(row + 512 + 8 * F.lane);
            float x[16] = {bflo(a.x), bfhi(a.x), bflo(a.y), bfhi(a.y), bflo(a.z), bfhi(a.z), bflo(a.w), bfhi(a.w),
                           bflo(b.x), bfhi(b.x), bflo(b.y), bfhi(b.y), bflo(b.z), bfhi(b.z), bflo(b.w), bfhi(b.w)};
            float s = 0.f;
#pragma unroll
            for (int i = 0; i < 16; ++i) s += x[i];
            const float mean = wave_sum(s) * (1.f / 1024.f);
            float q = 0.f;
#pragma unroll
            for (int i = 0; i < 16; ++i) { const float d = x[i] - mean; q += d * d; }
            const float rstd = 1.0f / sqrtf(wave_sum(q) * (1.f / 1024.f) + EPS_);
            if (F.lane == 0) { st[2 * j] = mean; st[2 * j + 1] = rstd; }
        }
        __syncthreads();
        for (int g = 0; g < 8; ++g) {
            for (int idx = F.tid; idx < 16384; idx += NTHR) {
                const int j = idx >> 7, c = idx & 127;
                const float x = bf2f(SV[(size_t)(r0 + j) * 1024 + g * 128 + c]);
                vn[idx] = (x - st[2 * j]) * st[2 * j + 1] * lng[g * 128 + c] + lnb[g * 128 + c];
                const int i = j;
                const float w = sgw[(size_t)g * 16384 + idx];
                Wl[idx] = ((i >> 6) >= (c >> 6)) ? w : 0.f;
            }
            __syncthreads();
            const int c = F.tid & 127, rg = F.tid >> 7;
            float acc[32];
#pragma unroll
            for (int ii = 0; ii < 32; ++ii) acc[ii] = 0.f;
            for (int j = 0; j < 128; j += 4) {
                const float v0 = vn[(j + 0) * 128 + c], v1 = vn[(j + 1) * 128 + c], v2 = vn[(j + 2) * 128 + c], v3 = vn[(j + 3) * 128 + c];
#pragma unroll
                for (int ii = 0; ii < 32; ++ii) { const f32x4 w = *(const LAS f32x4*)(Wl + (rg * 32 + ii) * 128 + j); acc[ii] += w[0] * v0 + w[1] * v1 + w[2] * v2 + w[3] * v3; }
            }
#pragma unroll
            for (int ii = 0; ii < 32; ++ii) {
                const int i = rg * 32 + ii; bf16* p = SU + (size_t)(r0 + i) * 1024 + g * 128 + c;
                *p = (bf16)f2bf(bf2f(*p) * (acc[ii] + sgb[g * 128 + i]));
            }
            __syncthreads();
        }
    }
}

typedef short v4i16_t __attribute__((ext_vector_type(4)));
__device__ __forceinline__ void gmlp_mfma(Frame& F, const Args& A) {
    bf16* SU = WSP(A, WS_SU); const bf16* SV = WSP(A, WS_SV); const bf16* SGW = WSP(A, WS_SGW);
    const float* lng = A.in[8]; const float* lnb = A.in[9]; const float* sgb = A.in[11];
    LAS float* st = (LAS float*)(F.lds + 65536);
    const int lane = F.lane, w = F.wave, tid = F.tid;
    const int l15 = lane & 15, gq = lane >> 4, q4 = (lane & 15) >> 2, p4 = lane & 3;
    const int fsw = q4 | ((gq & 1) << 2);
    for (int u = vcu_of(F); u < T_ / 128; u += F.G) {
        const int r0 = u * 128;
        __syncthreads();
#pragma unroll 4
        for (int rr = 0; rr < 16; ++rr) {
            const int j = w * 16 + rr;
            const bf16* row = SV + (size_t)(r0 + j) * 1024;
            const v4u a = *(const v4u*)(row + 8 * lane), b = *(const v4u*)(row + 512 + 8 * lane);
            float x[16] = {bflo(a.x), bfhi(a.x), bflo(a.y), bfhi(a.y), bflo(a.z), bfhi(a.z), bflo(a.w), bfhi(a.w),
                           bflo(b.x), bfhi(b.x), bflo(b.y), bfhi(b.y), bflo(b.z), bfhi(b.z), bflo(b.w), bfhi(b.w)};
            float s = 0.f;
#pragma unroll
            for (int i = 0; i < 16; ++i) s += x[i];
            const float mean = wave_sum(s) * (1.f / 1024.f);
            float q = 0.f;
#pragma unroll
            for (int i = 0; i < 16; ++i) { const float d = x[i] - mean; q += d * d; }
            const float rstd = 1.0f / sqrtf(wave_sum(q) * (1.f / 1024.f) + EPS_);
            if (lane == 0) { st[2 * j] = mean; st[2 * j + 1] = rstd; }
        }
        v4u raw[4];
#define GM_LOAD(g_) do { _Pragma("unroll") for (int q_ = 0; q_ < 4; ++q_) { const int p_ = tid + 512 * q_; raw[q_] = *(const v4u*)(SV + (size_t)(r0 + (p_ >> 4)) * 1024 + (g_) * 128 + (p_ & 15) * 8); } } while (0)
#define GM_WRITE(buf_, g_) do { _Pragma("unroll") for (int q_ = 0; q_ < 4; ++q_) { const int p_ = tid + 512 * q_, j_ = p_ >> 4, ch_ = p_ & 15; \
            const float mu_ = st[2 * j_], rs_ = st[2 * j_ + 1]; \
            const f32x4 ga_ = *(const f32x4*)(lng + (g_) * 128 + ch_ * 8), gb_ = *(const f32x4*)(lng + (g_) * 128 + ch_ * 8 + 4), ba_ = *(const f32x4*)(lnb + (g_) * 128 + ch_ * 8), bb_ = *(const f32x4*)(lnb + (g_) * 128 + ch_ * 8 + 4); \
            v4u o_; \
            o_.x = pk2((bflo(raw[q_].x) - mu_) * rs_ * ga_[0] + ba_[0], (bfhi(raw[q_].x) - mu_) * rs_ * ga_[1] + ba_[1]); \
            o_.y = pk2((bflo(raw[q_].y) - mu_) * rs_ * ga_[2] + ba_[2], (bfhi(raw[q_].y) - mu_) * rs_ * ga_[3] + ba_[3]); \
            o_.z = pk2((bflo(raw[q_].z) - mu_) * rs_ * gb_[0] + bb_[0], (bfhi(raw[q_].z) - mu_) * rs_ * gb_[1] + bb_[1]); \
            o_.w = pk2((bflo(raw[q_].w) - mu_) * rs_ * gb_[2] + bb_[2], (bfhi(raw[q_].w) - mu_) * rs_ * gb_[3] + bb_[3]); \
            const int fj_ = (j_ & 3) | (((j_ >> 3) & 1) << 2); \
            *(LAS v4u*)(F.lds + (buf_) * 32768 + j_ * 256 + (((ch_ >> 1) ^ fj_) * 32) + (ch_ & 1) * 16) = o_; } } while (0)
        GM_LOAD(0);
        __syncthreads();
        GM_WRITE(0, 0);
#pragma unroll 1
        for (int g = 0; g < 8; ++g) {
            __syncthreads();
            if (g + 1 < 8) GM_LOAD(g + 1);
            {
                LAS unsigned char* tb = F.lds + (g & 1) * 32768;
                const int i = w * 16 + l15;
                bf16x8 wf[4];
#pragma unroll
                for (int ks = 0; ks < 4; ++ks) wf[ks] = *(const bf16x8*)(SGW + (size_t)(g * 128 + i) * 128 + ks * 32 + 8 * gq);
                const float bias = sgb[g * 128 + i];
                f32x4 acc[8];
#pragma unroll
                for (int cb = 0; cb < 8; ++cb) acc[cb] = (f32x4){bias, bias, bias, bias};
                const int nks = (w < 4) ? 2 : 4;
#pragma unroll
                for (int ks = 0; ks < 4; ++ks) if (ks < nks) {
#pragma unroll
                    for (int cb = 0; cb < 8; ++cb) {
                        const LAS unsigned char* pa = tb + (ks * 32 + 8 * gq + q4) * 256 + ((cb ^ fsw) * 32) + 8 * p4;
                        const v4i16_t lo = __builtin_amdgcn_ds_read_tr16_b64_v4i16((LAS v4i16_t*)pa);
                        const v4i16_t hi = __builtin_amdgcn_ds_read_tr16_b64_v4i16((LAS v4i16_t*)(pa + 4 * 256));
                        const bf16x8 vf = (bf16x8){lo[0], lo[1], lo[2], lo[3], hi[0], hi[1], hi[2], hi[3]};
                        acc[cb] = __builtin_amdgcn_mfma_f32_16x16x32_bf16(vf, wf[ks], acc[cb], 0, 0, 0);
                    }
                }
#pragma unroll
                for (int cb = 0; cb < 8; ++cb) {
                    bf16* p = SU + (size_t)(r0 + i) * 1024 + g * 128 + cb * 16 + 4 * gq;
                    const v2u uu = *(const v2u*)p;
                    store4bf(p, (f32x4){bflo(uu.x) * acc[cb][0], bfhi(uu.x) * acc[cb][1], bflo(uu.y) * acc[cb][2], bfhi(uu.y) * acc[cb][3]});
                }
            }
            if (g + 1 < 8) GM_WRITE((g + 1) & 1, g + 1);
        }
#undef GM_LOAD
#undef GM_WRITE
    }
}

__device__ __forceinline__ void attn_naive(Frame& F, const Args& A, bf16* O1, bf16* O2) {
    const bf16* Qp = WSP(A, WS_Q); const bf16* Kp = WSP(A, WS_K); const bf16* Vp = WSP(A, WS_V);
    const int gw = F.bid * NWAVES + F.wave, NGW = F.G * NWAVES;
    for (int it = gw; it < NB_ * 16 * S_; it += NGW) {
        const int q = it & (S_ - 1), hm = (it >> 12) & 15, b = it >> 16, head = hm & 7, map = hm >> 3;
        const size_t rowb = (size_t)b * S_;
        float qf[64];
        { const bf16* qp = Qp + (rowb + q) * 1024 + hm * 64;
#pragma unroll
          for (int i = 0; i < 8; ++i) { const v4u w = *(const v4u*)(qp + 8 * i); qf[8 * i + 0] = bflo(w.x); qf[8 * i + 1] = bfhi(w.x); qf[8 * i + 2] = bflo(w.y); qf[8 * i + 3] = bfhi(w.y); qf[8 * i + 4] = bflo(w.z); qf[8 * i + 5] = bfhi(w.z); qf[8 * i + 6] = bflo(w.w); qf[8 * i + 7] = bfhi(w.w); } }
        float m = -INFINITY, l = 0.f, o0 = 0.f, o1 = 0.f;
        const int nt = (q >> 6) + 1;
        for (int tt = 0; tt < nt; ++tt) {
            const bf16* kp = Kp + (rowb + tt * 64 + F.lane) * 1024 + hm * 64;
            float s = 0.f;
#pragma unroll
            for (int i = 0; i < 8; ++i) { const v4u w = *(const v4u*)(kp + 8 * i);
                s += qf[8 * i + 0] * bflo(w.x) + qf[8 * i + 1] * bfhi(w.x) + qf[8 * i + 2] * bflo(w.y) + qf[8 * i + 3] * bfhi(w.y) + qf[8 * i + 4] * bflo(w.z) + qf[8 * i + 5] * bfhi(w.z) + qf[8 * i + 6] * bflo(w.w) + qf[8 * i + 7] * bfhi(w.w); }
            const float mt = wave_max(s), mn = fmaxf(m, mt), al = __builtin_amdgcn_exp2f(m - mn), p = __builtin_amdgcn_exp2f(s - mn);
            l = l * al + wave_sum(p); o0 *= al; o1 *= al; m = mn;
            const bf16* vp = Vp + (rowb + tt * 64) * 1024 + head * 128 + 2 * F.lane;
            for (int j = 0; j < 64; ++j) { const float pj = __shfl(p, j); const unsigned w = *(const unsigned*)(vp + (size_t)j * 1024); o0 += pj * bflo(w); o1 += pj * bfhi(w); }
        }
        const float il = 1.0f / l;
        bf16* op = (map ? O2 : O1) + (rowb + q) * 1024 + head * 128 + 2 * F.lane;
        *(unsigned*)op = pk2(o0 * il, o1 * il);
    }
}

__device__ __forceinline__ void combine_phase(Frame& F, const Args& A, bf16* O1, const bf16* O2) {
    const int gw = F.bid * NWAVES + F.wave, NGW = F.G * NWAVES;
    const float s1 = wave_sum(A.in[3][F.lane] * A.in[4][F.lane]), s2 = wave_sum(A.in[5][F.lane] * A.in[6][F.lane]);
    const float lam = expf(s1) - expf(s2) + LAM_INIT_;
    float sg[16];
#pragma unroll
    for (int i = 0; i < 16; ++i) sg[i] = A.in[7][(16 * F.lane + i) & 127] * (1.0f - LAM_INIT_);
    for (int t = gw; t < T_; t += NGW) {
        bf16* p1 = O1 + (size_t)t * 1024 + 16 * F.lane; const bf16* p2 = O2 + (size_t)t * 1024 + 16 * F.lane;
        const v4u a0 = *(const v4u*)p1, a1 = *(const v4u*)(p1 + 8), b0 = *(const v4u*)p2, b1 = *(const v4u*)(p2 + 8);
        float d[16] = {bflo(a0.x) - lam * bflo(b0.x), bfhi(a0.x) - lam * bfhi(b0.x), bflo(a0.y) - lam * bflo(b0.y), bfhi(a0.y) - lam * bfhi(b0.y),
                       bflo(a0.z) - lam * bflo(b0.z), bfhi(a0.z) - lam * bfhi(b0.z), bflo(a0.w) - lam * bflo(b0.w), bfhi(a0.w) - lam * bfhi(b0.w),
                       bflo(a1.x) - lam * bflo(b1.x), bfhi(a1.x) - lam * bfhi(b1.x), bflo(a1.y) - lam * bflo(b1.y), bfhi(a1.y) - lam * bfhi(b1.y),
                       bflo(a1.z) - lam * bflo(b1.z), bfhi(a1.z) - lam * bfhi(b1.z), bflo(a1.w) - lam * bflo(b1.w), bfhi(a1.w) - lam * bfhi(b1.w)};
        float ss = 0.f;
#pragma unroll
        for (int i = 0; i < 16; ++i) ss += d[i] * d[i];
        ss += __shfl_xor(ss, 1); ss += __shfl_xor(ss, 2); ss += __shfl_xor(ss, 4);
        const float r = 1.0f / sqrtf(ss * (1.f / 128.f) + EPS_);
        v4u o0, o1;
        o0.x = pk2(d[0] * r * sg[0], d[1] * r * sg[1]); o0.y = pk2(d[2] * r * sg[2], d[3] * r * sg[3]); o0.z = pk2(d[4] * r * sg[4], d[5] * r * sg[5]); o0.w = pk2(d[6] * r * sg[6], d[7] * r * sg[7]);
        o1.x = pk2(d[8] * r * sg[8], d[9] * r * sg[9]); o1.y = pk2(d[10] * r * sg[10], d[11] * r * sg[11]); o1.z = pk2(d[12] * r * sg[12], d[13] * r * sg[13]); o1.w = pk2(d[14] * r * sg[14], d[15] * r * sg[15]);
        *(v4u*)p1 = o0; *(v4u*)(p1 + 8) = o1;
    }
}

__device__ const unsigned char CAND_IJ[56] = {
    0x00, 0x01, 0x02, 0x03, 0x04, 0x05, 0x06, 0x07, 0x08, 0x09, 0x0a, 0x0b, 0x0c, 0x0d, 0x0e, 0x0f,
    0x10, 0x11, 0x12, 0x13, 0x14, 0x15, 0x16, 0x17,
    0x20, 0x21, 0x22, 0x23, 0x24,
    0x30, 0x31, 0x32, 0x33,
    0x40, 0x41, 0x42,
    0x50, 0x51, 0x60, 0x61, 0x70, 0x71,
    0x80, 0x90, 0xa0, 0xb0, 0xc0, 0xd0, 0xe0, 0xf0,
    0xff, 0xff, 0xff, 0xff, 0xff, 0xff};
__device__ __forceinline__ unsigned fkey(float f) { const unsigned b = __builtin_bit_cast(unsigned, f); return b ^ ((unsigned)((int)b >> 31) | 0x80000000u); }
__device__ __forceinline__ unsigned fkeyb(unsigned b) { return b ^ ((unsigned)((int)b >> 31) | 0x80000000u); }
__device__ __forceinline__ float hkeyf(unsigned k) { const unsigned b = (k & 0x80000000u) ? (k ^ 0x80000000u) : ~k; return (float)__builtin_bit_cast(_Float16, (unsigned short)(b >> 16)); }
__device__ __forceinline__ float keyf(unsigned k) { const unsigned b = (k & 0x80000000u) ? (k ^ 0x80000000u) : ~k; return __builtin_bit_cast(float, b); }
#define DPP_U(x, ctrl) ((unsigned)__builtin_amdgcn_update_dpp(0, (int)(x), (ctrl), 0xf, 0xf, false))
#define DPP_F(x, ctrl) __builtin_bit_cast(float, __builtin_amdgcn_update_dpp(0, __builtin_bit_cast(int, (float)(x)), (ctrl), 0xf, 0xf, false))
__device__ __forceinline__ unsigned umax_(unsigned a, unsigned b) { return a > b ? a : b; }
__device__ __forceinline__ unsigned umin_(unsigned a, unsigned b) { return a < b ? a : b; }
__device__ __forceinline__ unsigned rowmax16_u(unsigned v) {
    v = umax_(v, DPP_U(v, 0xB1)); v = umax_(v, DPP_U(v, 0x4E)); v = umax_(v, DPP_U(v, 0x141)); v = umax_(v, DPP_U(v, 0x140)); return v; }
__device__ __forceinline__ unsigned grpmax8_u(unsigned v) {
    v = umax_(v, DPP_U(v, 0xB1)); v = umax_(v, DPP_U(v, 0x4E)); v = umax_(v, DPP_U(v, 0x141)); return v; }
__device__ __forceinline__ float grpmax8_f(float v) { v = fmaxf(v, DPP_F(v, 0xB1)); v = fmaxf(v, DPP_F(v, 0x4E)); v = fmaxf(v, DPP_F(v, 0x141)); return v; }
__device__ __forceinline__ float grpsum8_f(float v) { v += DPP_F(v, 0xB1); v += DPP_F(v, 0x4E); v += DPP_F(v, 0x141); return v; }
#define CEX(a, b) do { const unsigned _hi = umax_(a, b), _lo = umin_(a, b); a = _hi; b = _lo; } while (0)

__device__ __forceinline__ float dot2bf(unsigned a, unsigned b, float acc) { return __builtin_amdgcn_fdot2_f32_bf16(__builtin_bit_cast(bf16x2_t, a), __builtin_bit_cast(bf16x2_t, b), acc, false); }

template <int VARIANT>
__device__ __forceinline__ void peer_phase(Frame& F, const Args& A) {
    const unsigned char* U8 = A.ws + WS_UT; const unsigned char* V8 = A.ws + WS_VT;
    const float* SUs = (const float*)(A.ws + WS_UT + 16 * MiB); const float* SVs = (const float*)(A.ws + WS_VT + 16 * MiB);
    const float* SC = (const float*)(A.ws + WS_SC); float* OUT = A.out;
    const int lane = F.lane, gw = F.bid * NWAVES + F.wave, NGW = F.G * NWAVES;
    LAS unsigned* kl = (LAS unsigned*)(F.lds + F.wave * 4096);
    LAS int* exl = (LAS int*)(F.lds + F.wave * 4096 + 1024);
    LAS float* sul = (LAS float*)(F.lds + F.wave * 4096 + 1536);
    LAS float* gvl = (LAS float*)(F.lds + F.wave * 4096 + 2048);
    const float* g2 = A.in[15]; const float* gfin = A.in[20];
    const bf16* HB = WSP(A, WS_XN);
    const int li = lane & 15, rho = lane >> 4;
    const int eidx = (rho & 1) + 2 * ((lane >> 3) & 1) + 4 * (rho >> 1);
    for (int t = gw; t < T_; t += NGW) {
        const bf16* hp = HB + (size_t)t * 1024 + 16 * lane;
        f32x4 hv[4];
        { const v4u h0 = *(const v4u*)hp, h1 = *(const v4u*)(hp + 8); hv[0] = bf4lo(h0); hv[1] = bf4hi(h0); hv[2] = bf4lo(h1); hv[3] = bf4hi(h1); }
        float ss = 0.f;
#pragma unroll
        for (int i = 0; i < 4; ++i) ss += (hv[i][0] * hv[i][0] + hv[i][1] * hv[i][1]) + (hv[i][2] * hv[i][2] + hv[i][3] * hv[i][3]);
        const float rstd2 = 1.0f / sqrtf(wave_sum(ss) * (1.f / 1024.f) + EPS_);
        f32x2 xn[8];
#pragma unroll
        for (int i = 0; i < 4; ++i) { const f32x4 gg = *(const f32x4*)(g2 + 16 * lane + 4 * i); xn[2 * i] = (f32x2){hv[i][0] * rstd2 * gg[0], hv[i][1] * rstd2 * gg[1]}; xn[2 * i + 1] = (f32x2){hv[i][2] * rstd2 * gg[2], hv[i][3] * rstd2 * gg[3]}; }
        if constexpr (VARIANT != 0) {
            const int e0_ = (VARIANT == 1) ? ((t * 131 + lane * 977) & 16383) : lane * 128, e1_ = (VARIANT == 1) ? ((t * 137 + (lane + 64) * 977) & 16383) : (lane + 64) * 128;
            exl[lane] = e0_; exl[lane + 64] = e1_; sul[lane] = SUs[e0_]; sul[lane + 64] = SUs[e1_]; gvl[lane] = SVs[e0_] * (1.f / 16.f); gvl[lane + 64] = SVs[e1_] * (1.f / 16.f);
        } else {
        const float* sp = SC + (size_t)t * 2048;
#pragma unroll 1
        for (int r = 0; r < 4; ++r) {
            const int gi = 4 * r + rho;
            const f32x4 s0 = *(const f32x4*)(sp + gi * 128 + 8 * li), s1 = *(const f32x4*)(sp + gi * 128 + 8 * li + 4);
            unsigned k0 = (fkey(s0[0]) & ~127u) | (unsigned)(127 - (8 * li + 0)), k1 = (fkey(s0[1]) & ~127u) | (unsigned)(127 - (8 * li + 1)),
                     k2 = (fkey(s0[2]) & ~127u) | (unsigned)(127 - (8 * li + 2)), k3 = (fkey(s0[3]) & ~127u) | (unsigned)(127 - (8 * li + 3)),
                     k4 = (fkey(s1[0]) & ~127u) | (unsigned)(127 - (8 * li + 4)), k5 = (fkey(s1[1]) & ~127u) | (unsigned)(127 - (8 * li + 5)),
                     k6 = (fkey(s1[2]) & ~127u) | (unsigned)(127 - (8 * li + 6)), k7 = (fkey(s1[3]) & ~127u) | (unsigned)(127 - (8 * li + 7));
            CEX(k0, k1); CEX(k2, k3); CEX(k4, k5); CEX(k6, k7);
            CEX(k0, k2); CEX(k1, k3); CEX(k4, k6); CEX(k5, k7);
            CEX(k1, k2); CEX(k5, k6); CEX(k0, k4); CEX(k3, k7);
            CEX(k1, k5); CEX(k2, k6);
            CEX(k1, k4); CEX(k3, k6);
            CEX(k2, k4); CEX(k3, k5);
            CEX(k3, k4);
            unsigned rec = 0u;
#pragma unroll
            for (int itx = 0; itx < 16; ++itx) {
                const unsigned mk = rowmax16_u(k0);
                rec = (li == itx) ? mk : rec;
                const bool own = (k0 == mk);
                k0 = own ? k1 : k0; k1 = own ? k2 : k1; k2 = own ? k3 : k2; k3 = own ? k4 : k3; k4 = own ? k5 : k4; k5 = own ? k6 : k5; k6 = own ? k7 : k6; k7 = own ? 0u : k7;
            }
            kl[gi * 16 + li] = rec;
        }
        asm volatile("s_waitcnt lgkmcnt(0)" ::: "memory");
        {
            const int hh = lane >> 3, q8 = lane & 7;
            unsigned c[7];
#pragma unroll
            for (int mth = 0; mth < 7; ++mth) {
                const int cid = q8 + 8 * mth; const unsigned ij = CAND_IJ[cid];
                if (ij == 0xffu) { c[mth] = 0u; }
                else { const unsigned ka = kl[(2 * hh) * 16 + (ij >> 4)], kb = kl[(2 * hh + 1) * 16 + (ij & 15)];
                       const float sum = keyf(ka & ~127u) + keyf(kb & ~127u);
                       c[mth] = (fkey(sum) & ~63u) | (unsigned)(63 - cid); }
            }
            CEX(c[0], c[6]); CEX(c[2], c[3]); CEX(c[4], c[5]);
            CEX(c[0], c[2]); CEX(c[1], c[4]); CEX(c[3], c[6]);
            CEX(c[0], c[1]); CEX(c[2], c[5]); CEX(c[3], c[4]);
            CEX(c[1], c[2]); CEX(c[4], c[6]);
            CEX(c[2], c[3]); CEX(c[4], c[5]);
            CEX(c[1], c[2]); CEX(c[3], c[4]); CEX(c[5], c[6]);
            unsigned rec0 = 0u, rec1 = 0u;
#pragma unroll
            for (int itx = 0; itx < 16; ++itx) {
                const unsigned mk = grpmax8_u(c[0]);
                if (itx < 8) rec0 = (q8 == itx) ? mk : rec0; else rec1 = (q8 == itx - 8) ? mk : rec1;
                const bool own = (c[0] == mk);
                c[0] = own ? c[1] : c[0]; c[1] = own ? c[2] : c[1]; c[2] = own ? c[3] : c[2]; c[3] = own ? c[4] : c[3]; c[4] = own ? c[5] : c[4]; c[5] = own ? c[6] : c[5]; c[6] = own ? 0u : c[6];
            }
            const int cid0 = 63 - (int)(rec0 & 63u), cid1 = 63 - (int)(rec1 & 63u);
            const unsigned ij0 = CAND_IJ[cid0], ij1 = CAND_IJ[cid1];
            const int e0 = (127 - (int)(kl[(2 * hh) * 16 + (ij0 >> 4)] & 127u)) * 128 + (127 - (int)(kl[(2 * hh + 1) * 16 + (ij0 & 15)] & 127u));
            const int e1 = (127 - (int)(kl[(2 * hh) * 16 + (ij1 >> 4)] & 127u)) * 128 + (127 - (int)(kl[(2 * hh + 1) * 16 + (ij1 & 15)] & 127u));
            const float su0 = SUs[e0], su1 = SUs[e1], sv0 = SVs[e0], sv1 = SVs[e1];
            const float v0 = keyf(rec0 & ~63u) * rstd2, v1 = keyf(rec1 & ~63u) * rstd2;
            const float mx = grpmax8_f(fmaxf(v0, v1));
            const float x0 = __expf(v0 - mx), x1 = __expf(v1 - mx);
            const float inv = 1.0f / grpsum8_f(x0 + x1);
            exl[hh * 16 + q8] = e0; exl[hh * 16 + 8 + q8] = e1;
            sul[hh * 16 + q8] = su0; sul[hh * 16 + 8 + q8] = su1;
            gvl[hh * 16 + q8] = x0 * inv * sv0; gvl[hh * 16 + 8 + q8] = x1 * inv * sv1;
        }
        }
        asm volatile("s_waitcnt lgkmcnt(0)" ::: "memory");
        f32x2 y[8];
#pragma unroll
        for (int i = 0; i < 8; ++i) y[i] = (f32x2){0.f, 0.f};
        v4u UA[8], VA[8], UB[8], VB[8];
#define PEER_LOAD(U_, V_, ch) do { \
            const v4u ea_ = *(const LAS v4u*)(exl + (ch) * 8), eb_ = *(const LAS v4u*)(exl + (ch) * 8 + 4); \
            _Pragma("unroll") for (int i_ = 0; i_ < 8; ++i_) { const unsigned e_ = (unsigned)__builtin_amdgcn_readfirstlane((int)(i_ < 4 ? ea_[i_ & 3] : eb_[i_ & 3])); \
                U_[i_] = *(const v4u*)(U8 + (size_t)e_ * 1024 + 16 * lane); V_[i_] = *(const v4u*)(V8 + (size_t)e_ * 1024 + 16 * lane); } } while (0)
#define PEER_COMP(U_, V_, ch) do { \
            float a_[8]; \
            _Pragma("unroll") for (int i_ = 0; i_ < 8; ++i_) { f32x2 s_ = (f32x2){0.f, 0.f}; \
                _Pragma("unroll") for (int w_ = 0; w_ < 4; ++w_) { const f32x2 lo_ = __builtin_amdgcn_cvt_pk_f32_fp8(U_[i_][w_], false), hi_ = __builtin_amdgcn_cvt_pk_f32_fp8(U_[i_][w_], true); \
                    s_ = __builtin_elementwise_fma(lo_, xn[2 * w_], s_); s_ = __builtin_elementwise_fma(hi_, xn[2 * w_ + 1], s_); } \
                a_[i_] = s_.x + s_.y; } \
            float b_[4]; \
            _Pragma("unroll") for (int i_ = 0; i_ < 4; ++i_) { auto r_ = __builtin_amdgcn_permlane32_swap(__float_as_uint(a_[i_]), __float_as_uint(a_[i_ + 4]), false, false); b_[i_] = __uint_as_float(r_[0]) + __uint_as_float(r_[1]); } \
            float c_[2]; \
            _Pragma("unroll") for (int i_ = 0; i_ < 2; ++i_) { auto r_ = __builtin_amdgcn_permlane16_swap(__float_as_uint(b_[2 * i_]), __float_as_uint(b_[2 * i_ + 1]), false, false); c_[i_] = __uint_as_float(r_[0]) + __uint_as_float(r_[1]); } \
            c_[0] += DPP_F(c_[0], 0x128); c_[1] += DPP_F(c_[1], 0x128); \
            float d_ = (lane & 8) ? c_[1] : c_[0]; \
            d_ += DPP_F(d_, 0xB1); d_ += DPP_F(d_, 0x4E); d_ += DPP_F(d_, 0x141); \
            const float w_ = gvl[(ch) * 8 + eidx] * gelu1(d_ * sul[(ch) * 8 + eidx]); \
            _Pragma("unroll") for (int i_ = 0; i_ < 8; ++i_) { \
                const float ws_ = __builtin_bit_cast(float, __builtin_amdgcn_readlane(__builtin_bit_cast(int, w_), ((i_ & 1) + 2 * (i_ >> 2)) * 16 + ((i_ >> 1) & 1) * 8)); \
                const f32x2 w2_ = (f32x2){ws_, ws_}; \
                _Pragma("unroll") for (int q_ = 0; q_ < 4; ++q_) { const f32x2 lo_ = __builtin_amdgcn_cvt_pk_f32_fp8(V_[i_][q_], false), hi_ = __builtin_amdgcn_cvt_pk_f32_fp8(V_[i_][q_], true); \
                    y[2 * q_] = __builtin_elementwise_fma(lo_, w2_, y[2 * q_]); y[2 * q_ + 1] = __builtin_elementwise_fma(hi_, w2_, y[2 * q_ + 1]); } } } while (0)
        PEER_LOAD(UA, VA, 0);
#pragma unroll 1
        for (int ch = 0; ch < 16; ch += 2) {
            PEER_LOAD(UB, VB, ch + 1);
            PEER_COMP(UA, VA, ch);
            if (ch + 2 < 16) PEER_LOAD(UA, VA, ch + 2);
            PEER_COMP(UB, VB, ch + 1);
        }
#undef PEER_LOAD
#undef PEER_COMP
        f32x4 o[4]; float s2 = 0.f;
        const v4u hr0 = *(const volatile v4u*)hp, hr1 = *(const volatile v4u*)(hp + 8);
#pragma unroll
        for (int i = 0; i < 4; ++i) { const f32x4 hr = (i == 0) ? bf4lo(hr0) : (i == 1) ? bf4hi(hr0) : (i == 2) ? bf4lo(hr1) : bf4hi(hr1);
            o[i] = hr + (f32x4){y[2 * i].x, y[2 * i].y, y[2 * i + 1].x, y[2 * i + 1].y}; s2 += (o[i][0] * o[i][0] + o[i][1] * o[i][1]) + (o[i][2] * o[i][2] + o[i][3] * o[i][3]); }
        const float rf = 1.0f / sqrtf(wave_sum(s2) * (1.f / 1024.f) + EPS_);
        float* op = OUT + (size_t)t * 1024 + 16 * lane;
#pragma unroll
        for (int i = 0; i < 4; ++i) *(f32x4*)(op + 4 * i) = o[i] * rf * *(const f32x4*)(gfin + 16 * lane + 4 * i);
    }
}

constexpr int PG = 2;
constexpr int PW_STRIDE = 16384;
template <bool FIXED>
__device__ __forceinline__ void peer_phase2(Frame& F, const Args& A) {
    const unsigned char* U8 = A.ws + WS_UT; const unsigned char* V8 = A.ws + WS_VT;
    const float* SUs = (const float*)(A.ws + WS_UT + 16 * MiB); const float* SVs = (const float*)(A.ws + WS_VT + 16 * MiB);
    const float* SC = (const float*)(A.ws + WS_SC); float* OUT = A.out;
    const int lane = F.lane, gw = F.bid * NWAVES + F.wave, NGW = F.G * NWAVES;
    LAS unsigned char* wl = F.lds + F.wave * PW_STRIDE;
    LAS unsigned* kl = (LAS unsigned*)wl;
    LAS unsigned char* xnl = wl + 1024;
    LAS int* exl = (LAS int*)(wl + 1024 + PG * 2048);
    LAS float* sul = (LAS float*)(wl + 1024 + PG * 2048 + PG * 512);
    LAS float* gvl = (LAS float*)(wl + 1024 + PG * 2048 + 2 * PG * 512);
    LAS int* ofl = (LAS int*)(wl + 1024 + PG * 2048 + 3 * PG * 512);
    const float* g2 = A.in[15]; const float* gfin = A.in[20];
    const bf16* HB = WSP(A, WS_XN);
    const int li = lane & 15, rho = lane >> 4;
    const int eidx = (rho & 1) + 2 * ((lane >> 3) & 1) + 4 * (rho >> 1);
    const int x0 = (int)xb_xcc_id() & 7;
    for (int grp = gw; grp < T_ / PG; grp += NGW) {
#pragma unroll 1
        for (int n = 0; n < PG; ++n) {
            const int t = grp * PG + n;
            const bf16* hp = HB + (size_t)t * 1024 + 16 * lane;
            f32x4 hv[4];
            { const v4u h0 = *(const v4u*)hp, h1 = *(const v4u*)(hp + 8); hv[0] = bf4lo(h0); hv[1] = bf4hi(h0); hv[2] = bf4lo(h1); hv[3] = bf4hi(h1); }
            float ss = 0.f;
#pragma unroll
            for (int i = 0; i < 4; ++i) ss += (hv[i][0] * hv[i][0] + hv[i][1] * hv[i][1]) + (hv[i][2] * hv[i][2] + hv[i][3] * hv[i][3]);
            const float rstd2 = 1.0f / sqrtf(wave_sum(ss) * (1.f / 1024.f) + EPS_);
            {
                v4u xa, xb;
#pragma unroll
                for (int i = 0; i < 4; ++i) { const f32x4 gg = *(const f32x4*)(g2 + 16 * lane + 4 * i);
                    const unsigned p0 = pk2(hv[i][0] * rstd2 * gg[0], hv[i][1] * rstd2 * gg[1]), p1 = pk2(hv[i][2] * rstd2 * gg[2], hv[i][3] * rstd2 * gg[3]);
                    if (i < 2) { xa[2 * i] = p0; xa[2 * i + 1] = p1; } else { xb[2 * (i - 2)] = p0; xb[2 * (i - 2) + 1] = p1; } }
                *(LAS v4u*)(xnl + n * 2048 + 32 * lane) = xa; *(LAS v4u*)(xnl + n * 2048 + 32 * lane + 16) = xb;
            }
            const float* sp = SC + (size_t)t * 2048;
#pragma unroll 1
            for (int r = 0; r < 4; ++r) {
                const int gi = 4 * r + rho;
                const f32x4 s0 = *(const f32x4*)(sp + gi * 128 + 8 * li), s1 = *(const f32x4*)(sp + gi * 128 + 8 * li + 4);
                unsigned k0 = (fkey(s0[0]) & ~127u) | (unsigned)(127 - (8 * li + 0)), k1 = (fkey(s0[1]) & ~127u) | (unsigned)(127 - (8 * li + 1)),
                         k2 = (fkey(s0[2]) & ~127u) | (unsigned)(127 - (8 * li + 2)), k3 = (fkey(s0[3]) & ~127u) | (unsigned)(127 - (8 * li + 3)),
                         k4 = (fkey(s1[0]) & ~127u) | (unsigned)(127 - (8 * li + 4)), k5 = (fkey(s1[1]) & ~127u) | (unsigned)(127 - (8 * li + 5)),
                         k6 = (fkey(s1[2]) & ~127u) | (unsigned)(127 - (8 * li + 6)), k7 = (fkey(s1[3]) & ~127u) | (unsigned)(127 - (8 * li + 7));
                CEX(k0, k1); CEX(k2, k3); CEX(k4, k5); CEX(k6, k7);
                CEX(k0, k2); CEX(k1, k3); CEX(k4, k6); CEX(k5, k7);
                CEX(k1, k2); CEX(k5, k6); CEX(k0, k4); CEX(k3, k7);
                CEX(k1, k5); CEX(k2, k6);
                CEX(k1, k4); CEX(k3, k6);
                CEX(k2, k4); CEX(k3, k5);
                CEX(k3, k4);
                unsigned rec = 0u;
#pragma unroll
                for (int itx = 0; itx < 16; ++itx) {
                    const unsigned mk = rowmax16_u(k0);
                    rec = (li == itx) ? mk : rec;
                    const bool own = (k0 == mk);
                    k0 = own ? k1 : k0; k1 = own ? k2 : k1; k2 = own ? k3 : k2; k3 = own ? k4 : k3; k4 = own ? k5 : k4; k5 = own ? k6 : k5; k6 = own ? k7 : k6; k7 = own ? 0u : k7;
                }
                kl[gi * 16 + li] = rec;
            }
            asm volatile("s_waitcnt lgkmcnt(0)" ::: "memory");
            {
                const int hh = lane >> 3, q8 = lane & 7;
                unsigned c[7];
#pragma unroll
                for (int mth = 0; mth < 7; ++mth) {
                    const int cid = q8 + 8 * mth; const unsigned ij = CAND_IJ[cid];
                    if (ij == 0xffu) { c[mth] = 0u; }
                    else { const unsigned ka = kl[(2 * hh) * 16 + (ij >> 4)], kb = kl[(2 * hh + 1) * 16 + (ij & 15)];
                           const float sum = keyf(ka & ~127u) + keyf(kb & ~127u);
                           c[mth] = (fkey(sum) & ~63u) | (unsigned)(63 - cid); }
                }
                CEX(c[0], c[6]); CEX(c[2], c[3]); CEX(c[4], c[5]);
                CEX(c[0], c[2]); CEX(c[1], c[4]); CEX(c[3], c[6]);
                CEX(c[0], c[1]); CEX(c[2], c[5]); CEX(c[3], c[4]);
                CEX(c[1], c[2]); CEX(c[4], c[6]);
                CEX(c[2], c[3]); CEX(c[4], c[5]);
                CEX(c[1], c[2]); CEX(c[3], c[4]); CEX(c[5], c[6]);
                unsigned rec0 = 0u, rec1 = 0u;
#pragma unroll
                for (int itx = 0; itx < 16; ++itx) {
                    const unsigned mk = grpmax8_u(c[0]);
                    if (itx < 8) rec0 = (q8 == itx) ? mk : rec0; else rec1 = (q8 == itx - 8) ? mk : rec1;
                    const bool own = (c[0] == mk);
                    c[0] = own ? c[1] : c[0]; c[1] = own ? c[2] : c[1]; c[2] = own ? c[3] : c[2]; c[3] = own ? c[4] : c[3]; c[4] = own ? c[5] : c[4]; c[5] = own ? c[6] : c[5]; c[6] = own ? 0u : c[6];
                }
                const int cid0 = 63 - (int)(rec0 & 63u), cid1 = 63 - (int)(rec1 & 63u);
                const unsigned ij0 = CAND_IJ[cid0], ij1 = CAND_IJ[cid1];
                const int e0r = (127 - (int)(kl[(2 * hh) * 16 + (ij0 >> 4)] & 127u)) * 128 + (127 - (int)(kl[(2 * hh + 1) * 16 + (ij0 & 15)] & 127u));
                const int e1r = (127 - (int)(kl[(2 * hh) * 16 + (ij1 >> 4)] & 127u)) * 128 + (127 - (int)(kl[(2 * hh + 1) * 16 + (ij1 & 15)] & 127u));
                const int e0 = FIXED ? lane * 128 + (lane & 63) : e0r, e1 = FIXED ? (lane + 64) * 128 + lane : e1r;
                const float su0 = SUs[e0], su1 = SUs[e1], sv0 = SVs[e0], sv1 = SVs[e1];
                const float v0 = keyf(rec0 & ~63u) * rstd2, v1 = keyf(rec1 & ~63u) * rstd2;
                const float mx = grpmax8_f(fmaxf(v0, v1));
                const float x0e = __expf(v0 - mx), x1e = __expf(v1 - mx);
                const float inv = 1.0f / grpsum8_f(x0e + x1e);
                const int r0 = e0 >> 11, r1 = e1 >> 11; int pos0 = 0, pos1 = 0, start = 0;
#pragma unroll
                for (int r = 0; r < 8; ++r) {
                    const unsigned long long m0 = __ballot(r0 == r), m1 = __ballot(r1 == r);
                    const int c0 = __popcll(m0), c1 = __popcll(m1);
                    const int b0 = (int)__builtin_amdgcn_mbcnt_hi((unsigned)(m0 >> 32), __builtin_amdgcn_mbcnt_lo((unsigned)m0, 0u));
                    const int b1 = (int)__builtin_amdgcn_mbcnt_hi((unsigned)(m1 >> 32), __builtin_amdgcn_mbcnt_lo((unsigned)m1, 0u));
                    pos0 = (r0 == r) ? start + b0 : pos0; pos1 = (r1 == r) ? start + c0 + b1 : pos1;
                    if (lane == r) ofl[n * 16 + r] = start;
                    start += c0 + c1;
                }
                if (lane == 8) ofl[n * 16 + 8] = 128;
                exl[n * 128 + pos0] = e0; exl[n * 128 + pos1] = e1;
                sul[n * 128 + pos0] = su0; sul[n * 128 + pos1] = su1;
                gvl[n * 128 + pos0] = x0e * inv * sv0; gvl[n * 128 + pos1] = x1e * inv * sv1;
            }
            asm volatile("s_waitcnt lgkmcnt(0)" ::: "memory");
        }
        f32x2 y[PG][8];
#pragma unroll
        for (int n = 0; n < PG; ++n)
#pragma unroll
            for (int i = 0; i < 8; ++i) y[n][i] = (f32x2){0.f, 0.f};
        v4u UA[4], VA[4], UB[4], VB[4];
#define P2_LOAD(U_, V_, bi_, cc_) do { \
            _Pragma("unroll") for (int i_ = 0; i_ < 4; ++i_) { const int ix_ = (bi_) + ((i_ < (cc_)) ? i_ : (cc_) - 1); \
                const unsigned e_ = (unsigned)__builtin_amdgcn_readfirstlane(exl[ix_]); \
                U_[i_] = *(const v4u*)(U8 + (size_t)e_ * 1024 + 16 * lane); V_[i_] = *(const v4u*)(V8 + (size_t)e_ * 1024 + 16 * lane); } } while (0)
#define P2_VSIDE(V_, yy) do { _Pragma("unroll") for (int i_ = 0; i_ < 4; ++i_) { \
                const float ws_ = __builtin_bit_cast(float, __builtin_amdgcn_readlane(__builtin_bit_cast(int, w_), i_ * 16)); \
                const f32x2 w2_ = (f32x2){ws_, ws_}; \
                _Pragma("unroll") for (int q_ = 0; q_ < 4; ++q_) { const f32x2 lo_ = __builtin_amdgcn_cvt_pk_f32_fp8(V_[i_][q_], false), hi_ = __builtin_amdgcn_cvt_pk_f32_fp8(V_[i_][q_], true); \
                    yy[2 * q_] = __builtin_elementwise_fma(lo_, w2_, yy[2 * q_]); yy[2 * q_ + 1] = __builtin_elementwise_fma(hi_, w2_, yy[2 * q_ + 1]); } } } while (0)
#define P2_COMP(U_, V_, n_, bi_, cc_) do { \
            f32x2 xn[8]; \
            { const v4u xa_ = *(const LAS v4u*)(xnl + (n_) * 2048 + 32 * lane), xb_ = *(const LAS v4u*)(xnl + (n_) * 2048 + 32 * lane + 16); \
              _Pragma("unroll") for (int i_ = 0; i_ < 4; ++i_) { xn[i_] = (f32x2){bflo(xa_[i_]), bfhi(xa_[i_])}; xn[4 + i_] = (f32x2){bflo(xb_[i_]), bfhi(xb_[i_])}; } } \
            float a_[4]; \
            _Pragma("unroll") for (int i_ = 0; i_ < 4; ++i_) { f32x2 s_ = (f32x2){0.f, 0.f}; \
                _Pragma("unroll") for (int w4_ = 0; w4_ < 4; ++w4_) { const f32x2 lo_ = __builtin_amdgcn_cvt_pk_f32_fp8(U_[i_][w4_], false), hi_ = __builtin_amdgcn_cvt_pk_f32_fp8(U_[i_][w4_], true); \
                    s_ = __builtin_elementwise_fma(lo_, xn[2 * w4_], s_); s_ = __builtin_elementwise_fma(hi_, xn[2 * w4_ + 1], s_); } \
                a_[i_] = s_.x + s_.y; } \
              \
            float b_[2]; \
            _Pragma("unroll") for (int i_ = 0; i_ < 2; ++i_) { auto r_ = __builtin_amdgcn_permlane32_swap(__float_as_uint(a_[i_]), __float_as_uint(a_[i_ + 2]), false, false); b_[i_] = __uint_as_float(r_[0]) + __uint_as_float(r_[1]); } \
            float d_; { auto r_ = __builtin_amdgcn_permlane16_swap(__float_as_uint(b_[0]), __float_as_uint(b_[1]), false, false); d_ = __uint_as_float(r_[0]) + __uint_as_float(r_[1]); } \
            d_ += DPP_F(d_, 0xB1); d_ += DPP_F(d_, 0x4E); d_ += DPP_F(d_, 0x141); d_ += DPP_F(d_, 0x140); \
            const int lx_ = (bi_) + ((rho < (cc_)) ? rho : (cc_) - 1); \
            const float wv_ = gvl[lx_] * gelu1(d_ * sul[lx_]); \
            const float w_ = (rho < (cc_)) ? wv_ : 0.f; \
            if ((n_) == 0) P2_VSIDE(V_, y[0]); else if ((n_) == 1) P2_VSIDE(V_, y[1]); ; } while (0)
        int k = 0, n = -1, c = 0, cnt = 0, base = 0;
#define P2_NEXT(ok_) do { c += 4; ok_ = true; \
            if (c >= cnt) { for (;;) { ++n; if (n == PG) { n = 0; ++k; } if (k == 8) { ok_ = false; break; } \
                    const int r_ = (x0 + k) & 7; const int s0_ = __builtin_amdgcn_readfirstlane(ofl[n * 16 + r_]), s1_ = __builtin_amdgcn_readfirstlane(ofl[n * 16 + r_ + 1]); \
                    cnt = s1_ - s0_; if (cnt > 0) { base = n * 128 + s0_; c = 0; break; } } } } while (0)
        bool okA, okB;
        P2_NEXT(okA);
        int nA = n, biA = base + c, ccA = (cnt - c < 4) ? cnt - c : 4, nB = 0, biB = 0, ccB = 1;
        P2_LOAD(UA, VA, biA, ccA);
#pragma unroll 1
        for (;;) {
            P2_NEXT(okB);
            if (okB) { nB = n; biB = base + c; ccB = (cnt - c < 4) ? cnt - c : 4; P2_LOAD(UB, VB, biB, ccB); }
            P2_COMP(UA, VA, nA, biA, ccA);
            if (!okB) break;
            P2_NEXT(okA);
            if (okA) { nA = n; biA = base + c; ccA = (cnt - c < 4) ? cnt - c : 4; P2_LOAD(UA, VA, biA, ccA); }
            P2_COMP(UB, VB, nB, biB, ccB);
            if (!okA) break;
        }
#undef P2_LOAD
#undef P2_COMP
#undef P2_VSIDE
#undef P2_NEXT
#pragma unroll
        for (int nn = 0; nn < PG; ++nn) {
            const int t = grp * PG + nn;
            const bf16* hp = HB + (size_t)t * 1024 + 16 * lane;
            const v4u hr0 = *(const v4u*)hp, hr1 = *(const v4u*)(hp + 8);
            f32x4 o[4]; float s2 = 0.f;
#pragma unroll
            for (int i = 0; i < 4; ++i) { const f32x4 hr = (i == 0) ? bf4lo(hr0) : (i == 1) ? bf4hi(hr0) : (i == 2) ? bf4lo(hr1) : bf4hi(hr1);
                o[i] = hr + (f32x4){y[nn][2 * i].x, y[nn][2 * i].y, y[nn][2 * i + 1].x, y[nn][2 * i + 1].y}; s2 += (o[i][0] * o[i][0] + o[i][1] * o[i][1]) + (o[i][2] * o[i][2] + o[i][3] * o[i][3]); }
            const float rf = 1.0f / sqrtf(wave_sum(s2) * (1.f / 1024.f) + EPS_);
            float* op = OUT + (size_t)t * 1024 + 16 * lane;
#pragma unroll
            for (int i = 0; i < 4; ++i) *(f32x4*)(op + 4 * i) = o[i] * rf * *(const f32x4*)(gfin + 16 * lane + 4 * i);
            asm volatile("" ::: "memory");
        }
    }
}

__device__ __forceinline__ void peer_phase3(Frame& F, const Args& A) {
    const unsigned char* U8 = A.ws + WS_UT; const unsigned char* V8 = A.ws + WS_VT;
    const float* SUs = (const float*)(A.ws + WS_UT + 16 * MiB); const float* SVs = (const float*)(A.ws + WS_VT + 16 * MiB);
    const float* SC = (const float*)(A.ws + WS_SC); float* OUT = A.out;
    const int lane = F.lane, gw = F.bid * NWAVES + F.wave, NGW = F.G * NWAVES;
    LAS unsigned char* wl = F.lds + F.wave * 8192;
    LAS unsigned* kl = (LAS unsigned*)wl;
    LAS unsigned char* xnl = wl + 1024;
    LAS int* exl = (LAS int*)(wl + 1024 + 4096);
    LAS float* sul = (LAS float*)(wl + 1024 + 4096 + 1024);
    LAS float* gvl = (LAS float*)(wl + 1024 + 4096 + 2048);
    const float* g2 = A.in[15]; const float* gfin = A.in[20];
    const bf16* HB = WSP(A, WS_XN);
#define OPQ(v_) ({ unsigned o_ = (unsigned)(v_); asm volatile("" : "+v"(o_)); o_; })
    const int li = lane & 15, rho = lane >> 4;
    const int eidx = (rho & 1) + 2 * ((lane >> 3) & 1) + 4 * (rho >> 1);
    const int x0 = ((int)xb_xcc_id() & 7) * (PEER_NR / 8);
    for (int grp = gw; grp < T_ / 2; grp += NGW) {
#if PEER_XSYNC
        {
            __syncthreads();
            if (F.wave == 0 && lane == 0) { unsigned* xsync = (unsigned*)(A.ws + WS_CTL + 32768) + 64 * (xb_xcc_id() & 15);
                const unsigned nloc = ((volatile LAS unsigned*)(F.lds + LDS_MISC))[0], want = nloc * (unsigned)((grp - gw) / NGW + 1);
                __hip_atomic_fetch_add(xsync, 1u, __ATOMIC_RELAXED, __HIP_MEMORY_SCOPE_AGENT); unsigned sp = 0;
                while (__hip_atomic_load(xsync, __ATOMIC_RELAXED, __HIP_MEMORY_SCOPE_AGENT) < want && ++sp < 20000u) __builtin_amdgcn_s_sleep(2); }
            __syncthreads(); }
#endif
#pragma unroll 1
        for (int n = 0; n < 2; ++n) {
            const int t = grp * 2 + n;
            const bf16* hp = (const bf16*)((const char*)(HB + (size_t)t * 1024) + OPQ(32 * lane));
            f32x4 hv[4];
            { const v4u h0 = *(const v4u*)hp, h1 = *(const v4u*)(hp + 8); hv[0] = bf4lo(h0); hv[1] = bf4hi(h0); hv[2] = bf4lo(h1); hv[3] = bf4hi(h1); }
            float ss = 0.f;
#pragma unroll
            for (int i = 0; i < 4; ++i) ss += (hv[i][0] * hv[i][0] + hv[i][1] * hv[i][1]) + (hv[i][2] * hv[i][2] + hv[i][3] * hv[i][3]);
            const float rstd2 = 1.0f / sqrtf(wave_sum(ss) * (1.f / 1024.f) + EPS_);
            {
                v4u xa, xb;
#pragma unroll
                for (int i = 0; i < 4; ++i) { const f32x4 gg = *(const f32x4*)((const char*)g2 + OPQ(64 * lane) + 16 * i);
                    const unsigned p0 = pk2(hv[i][0] * rstd2 * gg[0], hv[i][1] * rstd2 * gg[1]), p1 = pk2(hv[i][2] * rstd2 * gg[2], hv[i][3] * rstd2 * gg[3]);
                    if (i < 2) { xa[2 * i] = p0; xa[2 * i + 1] = p1; } else { xb[2 * (i - 2)] = p0; xb[2 * (i - 2) + 1] = p1; } }
                *(LAS v4u*)(xnl + n * 2048 + 32 * lane) = xa; *(LAS v4u*)(xnl + n * 2048 + 32 * lane + 16) = xb;
            }
            const float* sp = SC + (size_t)t * 2048;
#pragma unroll 1
            for (int r = 0; r < 4; ++r) {
                const int gi = 4 * r + rho;
                const float* spg = (const float*)((const char*)sp + OPQ((gi * 128 + 8 * li) * 4));
                const f32x4 s0 = *(const f32x4*)spg, s1 = *(const f32x4*)(spg + 4);
                unsigned k0 = (fkey(s0[0]) & ~127u) | (unsigned)(127 - (8 * li + 0)), k1 = (fkey(s0[1]) & ~127u) | (unsigned)(127 - (8 * li + 1)),
                         k2 = (fkey(s0[2]) & ~127u) | (unsigned)(127 - (8 * li + 2)), k3 = (fkey(s0[3]) & ~127u) | (unsigned)(127 - (8 * li + 3)),
                         k4 = (fkey(s1[0]) & ~127u) | (unsigned)(127 - (8 * li + 4)), k5 = (fkey(s1[1]) & ~127u) | (unsigned)(127 - (8 * li + 5)),
                         k6 = (fkey(s1[2]) & ~127u) | (unsigned)(127 - (8 * li + 6)), k7 = (fkey(s1[3]) & ~127u) | (unsigned)(127 - (8 * li + 7));
                CEX(k0, k1); CEX(k2, k3); CEX(k4, k5); CEX(k6, k7);
                CEX(k0, k2); CEX(k1, k3); CEX(k4, k6); CEX(k5, k7);
                CEX(k1, k2); CEX(k5, k6); CEX(k0, k4); CEX(k3, k7);
                CEX(k1, k5); CEX(k2, k6);
                CEX(k1, k4); CEX(k3, k6);
                CEX(k2, k4); CEX(k3, k5);
                CEX(k3, k4);
                unsigned rec = 0u;
#pragma unroll
                for (int itx = 0; itx < 16; ++itx) {
                    const unsigned mk = rowmax16_u(k0);
                    rec = (li == itx) ? mk : rec;
                    const bool own = (k0 == mk);
                    k0 = own ? k1 : k0; k1 = own ? k2 : k1; k2 = own ? k3 : k2; k3 = own ? k4 : k3; k4 = own ? k5 : k4; k5 = own ? k6 : k5; k6 = own ? k7 : k6; k7 = own ? 0u : k7;
                }
                kl[gi * 16 + li] = rec;
            }
            asm volatile("s_waitcnt lgkmcnt(0)" ::: "memory");
            {
                const int hh = lane >> 3, q8 = lane & 7;
                unsigned c[7];
#pragma unroll
                for (int mth = 0; mth < 7; ++mth) {
                    const int cid = q8 + 8 * mth; const unsigned ij = CAND_IJ[cid];
                    if (ij == 0xffu) { c[mth] = 0u; }
                    else { const unsigned ka = kl[(2 * hh) * 16 + (ij >> 4)], kb = kl[(2 * hh + 1) * 16 + (ij & 15)];
                           const float sum = keyf(ka & ~127u) + keyf(kb & ~127u);
                           c[mth] = (fkey(sum) & ~63u) | (unsigned)(63 - cid); }
                }
                CEX(c[0], c[6]); CEX(c[2], c[3]); CEX(c[4], c[5]);
                CEX(c[0], c[2]); CEX(c[1], c[4]); CEX(c[3], c[6]);
                CEX(c[0], c[1]); CEX(c[2], c[5]); CEX(c[3], c[4]);
                CEX(c[1], c[2]); CEX(c[4], c[6]);
                CEX(c[2], c[3]); CEX(c[4], c[5]);
                CEX(c[1], c[2]); CEX(c[3], c[4]); CEX(c[5], c[6]);
                unsigned rec0 = 0u, rec1 = 0u;
#pragma unroll
                for (int itx = 0; itx < 16; ++itx) {
                    const unsigned mk = grpmax8_u(c[0]);
                    if (itx < 8) rec0 = (q8 == itx) ? mk : rec0; else rec1 = (q8 == itx - 8) ? mk : rec1;
                    const bool own = (c[0] == mk);
                    c[0] = own ? c[1] : c[0]; c[1] = own ? c[2] : c[1]; c[2] = own ? c[3] : c[2]; c[3] = own ? c[4] : c[3]; c[4] = own ? c[5] : c[4]; c[5] = own ? c[6] : c[5]; c[6] = own ? 0u : c[6];
                }
                const int cid0 = 63 - (int)(rec0 & 63u), cid1 = 63 - (int)(rec1 & 63u);
                const unsigned ij0 = CAND_IJ[cid0], ij1 = CAND_IJ[cid1];
                const int e0r = (127 - (int)(kl[(2 * hh) * 16 + (ij0 >> 4)] & 127u)) * 128 + (127 - (int)(kl[(2 * hh + 1) * 16 + (ij0 & 15)] & 127u));
                const int e1r = (127 - (int)(kl[(2 * hh) * 16 + (ij1 >> 4)] & 127u)) * 128 + (127 - (int)(kl[(2 * hh + 1) * 16 + (ij1 & 15)] & 127u));
                const int e0 = e0r, e1 = e1r;
                const float su0 = SUs[e0], su1 = SUs[e1], sv0 = SVs[e0], sv1 = SVs[e1];
                const float v0 = keyf(rec0 & ~63u) * rstd2, v1 = keyf(rec1 & ~63u) * rstd2;
                const float mx = grpmax8_f(fmaxf(v0, v1));
                const float x0e = __expf(v0 - mx), x1e = __expf(v1 - mx);
                const float inv = 1.0f / grpsum8_f(x0e + x1e);
                const int r0 = ((e0 / (16384 / PEER_NR)) - x0) & (PEER_NR - 1), r1 = ((e1 / (16384 / PEER_NR)) - x0) & (PEER_NR - 1); int pos0 = 0, pos1 = 0, start = 0;
#pragma unroll
                for (int r = 0; r < PEER_NR; ++r) {
                    const unsigned long long m0 = __ballot(r0 == r), m1 = __ballot(r1 == r);
                    const int c0 = __popcll(m0), c1 = __popcll(m1);
                    const int b0 = (int)__builtin_amdgcn_mbcnt_hi((unsigned)(m0 >> 32), __builtin_amdgcn_mbcnt_lo((unsigned)m0, 0u));
                    const int b1 = (int)__builtin_amdgcn_mbcnt_hi((unsigned)(m1 >> 32), __builtin_amdgcn_mbcnt_lo((unsigned)m1, 0u));
                    pos0 = (r0 == r) ? start + b0 : pos0; pos1 = (r1 == r) ? start + c0 + b1 : pos1;
                    start += c0 + c1;
                }
                exl[n * 128 + pos0] = e0; exl[n * 128 + pos1] = e1;
                sul[n * 128 + pos0] = su0; sul[n * 128 + pos1] = su1;
                gvl[n * 128 + pos0] = x0e * inv * sv0; gvl[n * 128 + pos1] = x1e * inv * sv1;
            }
            asm volatile("s_waitcnt lgkmcnt(0)" ::: "memory");
        }
        unsigned xn0[8], xn1[8];
        { const v4u a0 = *(const LAS v4u*)(xnl + 32 * lane), a1 = *(const LAS v4u*)(xnl + 32 * lane + 16), b0 = *(const LAS v4u*)(xnl + 2048 + 32 * lane), b1 = *(const LAS v4u*)(xnl + 2048 + 32 * lane + 16);
#pragma unroll
          for (int i = 0; i < 4; ++i) { xn0[i] = a0[i]; xn0[4 + i] = a1[i]; xn1[i] = b0[i]; xn1[4 + i] = b1[i]; } }
        f32x2 y0[8], y1[8];
#pragma unroll
        for (int i = 0; i < 8; ++i) { y0[i] = (f32x2){0.f, 0.f}; y1[i] = (f32x2){0.f, 0.f}; }
        v4u UA[8], VA[8], UB[8], VB[8];
#define P3_LOAD(U_, V_, li0_) do { \
            const v4u ea_ = *(const LAS v4u*)(exl + (li0_)), eb_ = *(const LAS v4u*)(exl + (li0_) + 4); \
            _Pragma("unroll") for (int i_ = 0; i_ < 8; ++i_) { const unsigned e_ = (unsigned)__builtin_amdgcn_readfirstlane((int)(i_ < 4 ? ea_[i_ & 3] : eb_[i_ & 3])); \
                const unsigned l16_ = OPQ(16 * lane); \
                U_[i_] = *(const v4u*)(U8 + (size_t)e_ * 1024 + l16_); V_[i_] = *(const v4u*)(V8 + (size_t)e_ * 1024 + l16_); } } while (0)
#define P3_COMP(U_, V_, li0_, xn_, y_) do { \
            float a_[8]; \
            _Pragma("unroll") for (int i_ = 0; i_ < 8; ++i_) { float s_ = 0.f; \
                _Pragma("unroll") for (int w4_ = 0; w4_ < 4; ++w4_) { \
                    s_ = __builtin_amdgcn_fdot2_f32_bf16(__builtin_amdgcn_cvt_scalef32_pk_bf16_fp8(U_[i_][w4_], 1.0f, false), __builtin_bit_cast(bf16x2_t, xn_[2 * w4_]), s_, false); \
                    s_ = __builtin_amdgcn_fdot2_f32_bf16(__builtin_amdgcn_cvt_scalef32_pk_bf16_fp8(U_[i_][w4_], 1.0f, true), __builtin_bit_cast(bf16x2_t, xn_[2 * w4_ + 1]), s_, false); } \
                a_[i_] = s_; } \
            float b_[4]; \
            _Pragma("unroll") for (int i_ = 0; i_ < 4; ++i_) { auto r_ = __builtin_amdgcn_permlane32_swap(__float_as_uint(a_[i_]), __float_as_uint(a_[i_ + 4]), false, false); b_[i_] = __uint_as_float(r_[0]) + __uint_as_float(r_[1]); } \
            float c_[2]; \
            _Pragma("unroll") for (int i_ = 0; i_ < 2; ++i_) { auto r_ = __builtin_amdgcn_permlane16_swap(__float_as_uint(b_[2 * i_]), __float_as_uint(b_[2 * i_ + 1]), false, false); c_[i_] = __uint_as_float(r_[0]) + __uint_as_float(r_[1]); } \
            c_[0] += DPP_F(c_[0], 0x128); c_[1] += DPP_F(c_[1], 0x128); \
            float d_ = (lane & 8) ? c_[1] : c_[0]; \
            d_ += DPP_F(d_, 0xB1); d_ += DPP_F(d_, 0x4E); d_ += DPP_F(d_, 0x141); \
            const float w_ = gvl[(li0_) + eidx] * gelu1(d_ * sul[(li0_) + eidx]); \
            if (DBG_LIST && (lane & 7) == 0) { ((v2u*)(A.ws + WS_SV))[(size_t)(grp * 2) * 128 + (li0_) + eidx] = (v2u){(unsigned)exl[(li0_) + eidx], __float_as_uint(DBG_LIST == 3 ? 0.f : w_)}; } \
            _Pragma("unroll") for (int i_ = 0; i_ < 8; ++i_) { \
                const float ws_ = __builtin_bit_cast(float, __builtin_amdgcn_readlane(__builtin_bit_cast(int, w_), ((i_ & 1) + 2 * (i_ >> 2)) * 16 + ((i_ >> 1) & 1) * 8)); \
                const f32x2 w2_ = (f32x2){ws_, ws_}; \
                _Pragma("unroll") for (int q_ = 0; q_ < 4; ++q_) { const f32x2 lo_ = __builtin_amdgcn_cvt_pk_f32_fp8(V_[i_][q_], false), hi_ = __builtin_amdgcn_cvt_pk_f32_fp8(V_[i_][q_], true); \
                    y_[2 * q_] = __builtin_elementwise_fma(lo_, w2_, y_[2 * q_]); y_[2 * q_ + 1] = __builtin_elementwise_fma(hi_, w2_, y_[2 * q_ + 1]); } } } while (0)
        P3_LOAD(UA, VA, 0);
#pragma unroll 1
        for (int ch = 0; ch < 16; ++ch) {
            P3_LOAD(UB, VB, 128 + ch * 8);
            P3_COMP(UA, VA, ch * 8, xn0, y0);
            if (ch + 1 < 16) P3_LOAD(UA, VA, (ch + 1) * 8);
            P3_COMP(UB, VB, 128 + ch * 8, xn1, y1);
        }
#undef P3_LOAD
#undef P3_COMP
#pragma unroll
        for (int nn = 0; nn < 2; ++nn) {
            const int t = grp * 2 + nn;
            const bf16* hp = (const bf16*)((const char*)(HB + (size_t)t * 1024) + OPQ(32 * lane));
            const v4u hr0 = *(const v4u*)hp, hr1 = *(const v4u*)(hp + 8);
            f32x4 o[4]; float s2 = 0.f;
#pragma unroll
            for (int i = 0; i < 4; ++i) { const f32x4 hr = (i == 0) ? bf4lo(hr0) : (i == 1) ? bf4hi(hr0) : (i == 2) ? bf4lo(hr1) : bf4hi(hr1);
                const f32x2 ya = nn ? y1[2 * i] : y0[2 * i], yb = nn ? y1[2 * i + 1] : y0[2 * i + 1];
                o[i] = hr + (f32x4){ya.x, ya.y, yb.x, yb.y}; s2 += (o[i][0] * o[i][0] + o[i][1] * o[i][1]) + (o[i][2] * o[i][2] + o[i][3] * o[i][3]); }
            const float rf = 1.0f / sqrtf(wave_sum(s2) * (1.f / 1024.f) + EPS_);
            float* op = (float*)((char*)(OUT + (size_t)t * 1024) + OPQ(64 * lane));
            const float* gp = (const float*)((const char*)gfin + OPQ(64 * lane));
#pragma unroll
            for (int i = 0; i < 4; ++i) *(f32x4*)(op + 4 * i) = o[i] * rf * *(const f32x4*)(gp + 4 * i);
            asm volatile("" ::: "memory");
        }
    }
}

__device__ __forceinline__ void peer_u_phase(Frame& F, const Args& A) {
    const unsigned char* U8 = A.ws + WS_UT; const unsigned char* V8 = A.ws + WS_VT;
    const float* SUs = (const float*)(A.ws + WS_UT + 16 * MiB); const float* SVs = (const float*)(A.ws + WS_VT + 16 * MiB);
    const float* SC = (const float*)(A.ws + WS_SC); float* OUT = A.out;
    const int lane = F.lane, gw = F.bid * NWAVES + F.wave, NGW = F.G * NWAVES;
    LAS unsigned char* wl = F.lds + F.wave * 16384;
    LAS unsigned* kl = (LAS unsigned*)wl;
    LAS unsigned char* xnl = wl + 1024;
    LAS int* exl = (LAS int*)(wl + 1024 + 8192);
    LAS float* sul = (LAS float*)(wl + 1024 + 8192 + 2048);
    LAS float* gvl = (LAS float*)(wl + 1024 + 8192 + 4096);
    const float* g2 = A.in[15]; const float* gfin = A.in[20];
    const bf16* HB = WSP(A, WS_XN);
#define OPQ(v_) ({ unsigned o_ = (unsigned)(v_); asm volatile("" : "+v"(o_)); o_; })
    const int li = lane & 15, rho = lane >> 4;
    const int eidx = (rho & 1) + 2 * ((lane >> 3) & 1) + 4 * (rho >> 1);
    const int x0 = ((int)xb_xcc_id() & 7) * (PEER_NR / 8);
    const int ngrp = peer_ngrp(F);
    for (int gj = 0; gj < ngrp; ++gj) { const int grp = peer_grp(F, gj);
#pragma unroll 1
        for (int n = 0; n < 4; ++n) {
            const int t = grp * 4 + n;
            const bf16* hp = (const bf16*)((const char*)(HB + (size_t)t * 1024) + OPQ(32 * lane));
            f32x4 hv[4];
            { const v4u h0 = *(const v4u*)hp, h1 = *(const v4u*)(hp + 8); hv[0] = bf4lo(h0); hv[1] = bf4hi(h0); hv[2] = bf4lo(h1); hv[3] = bf4hi(h1); }
            float ss = 0.f;
#pragma unroll
            for (int i = 0; i < 4; ++i) ss += (hv[i][0] * hv[i][0] + hv[i][1] * hv[i][1]) + (hv[i][2] * hv[i][2] + hv[i][3] * hv[i][3]);
            const float rstd2 = 1.0f / sqrtf(wave_sum(ss) * (1.f / 1024.f) + EPS_);
            float sxn;
            {
                f32x4 xf[4]; float am = 0.f;
#pragma unroll
                for (int i = 0; i < 4; ++i) { const f32x4 gg = *(const f32x4*)((const char*)g2 + OPQ(64 * lane) + 16 * i); xf[i] = hv[i] * rstd2 * gg;
                    am = fmaxf(am, fmaxf(fmaxf(fabsf(xf[i][0]), fabsf(xf[i][1])), fmaxf(fabsf(xf[i][2]), fabsf(xf[i][3])))); }
                am = wave_max(am);
                const float qs = am > 0.f ? 127.0f / am : 1.0f; sxn = am > 0.f ? am * (1.0f / 127.0f) : 1.0f;
                v4u xq;
#pragma unroll
                for (int i = 0; i < 4; ++i) { const int q0 = __float2int_rn(xf[i][0] * qs), q1 = __float2int_rn(xf[i][1] * qs), q2 = __float2int_rn(xf[i][2] * qs), q3 = __float2int_rn(xf[i][3] * qs);
                    xq[i] = (unsigned)(q0 & 0xff) | ((unsigned)(q1 & 0xff) << 8) | ((unsigned)(q2 & 0xff) << 16) | ((unsigned)(q3 & 0xff) << 24); }
                *(LAS v4u*)(xnl + n * 2048 + 16 * lane) = xq;
            }
            const unsigned short* sp = sc_row(A, t);
#define L1_KEYS(k_, w_) \
                unsigned k_##0 = (fkeyb(w_[0] << 16) & 0xffff0000u) | (unsigned)(127 - (8 * li + 0)), k_##1 = (fkeyb(w_[0] & 0xffff0000u) & 0xffff0000u) | (unsigned)(127 - (8 * li + 1)), \
                         k_##2 = (fkeyb(w_[1] << 16) & 0xffff0000u) | (unsigned)(127 - (8 * li + 2)), k_##3 = (fkeyb(w_[1] & 0xffff0000u) & 0xffff0000u) | (unsigned)(127 - (8 * li + 3)), \
                         k_##4 = (fkeyb(w_[2] << 16) & 0xffff0000u) | (unsigned)(127 - (8 * li + 4)), k_##5 = (fkeyb(w_[2] & 0xffff0000u) & 0xffff0000u) | (unsigned)(127 - (8 * li + 5)), \
                         k_##6 = (fkeyb(w_[3] << 16) & 0xffff0000u) | (unsigned)(127 - (8 * li + 6)), k_##7 = (fkeyb(w_[3] & 0xffff0000u) & 0xffff0000u) | (unsigned)(127 - (8 * li + 7)); \
                CEX(k_##0, k_##1); CEX(k_##2, k_##3); CEX(k_##4, k_##5); CEX(k_##6, k_##7); \
                CEX(k_##0, k_##2); CEX(k_##1, k_##3); CEX(k_##4, k_##6); CEX(k_##5, k_##7); \
                CEX(k_##1, k_##2); CEX(k_##5, k_##6); CEX(k_##0, k_##4); CEX(k_##3, k_##7); \
                CEX(k_##1, k_##5); CEX(k_##2, k_##6); \
                CEX(k_##1, k_##4); CEX(k_##3, k_##6); \
                CEX(k_##2, k_##4); CEX(k_##3, k_##5); \
                CEX(k_##3, k_##4);
#define L1_STEP(k_, rec_, itx_) { const unsigned mk_ = rowmax16_u(k_##0); rec_ = (li == (itx_)) ? mk_ : rec_; const bool own_ = (k_##0 == mk_); \
                    k_##0 = own_ ? k_##1 : k_##0; k_##1 = own_ ? k_##2 : k_##1; k_##2 = own_ ? k_##3 : k_##2; k_##3 = own_ ? k_##4 : k_##3; k_##4 = own_ ? k_##5 : k_##4; k_##5 = own_ ? k_##6 : k_##5; k_##6 = own_ ? k_##7 : k_##6; k_##7 = own_ ? 0u : k_##7; }
            {
                const unsigned short* spa = (const unsigned short*)((const char*)sp + OPQ(((0 + rho) * 128 + 8 * li) * 2));
                const v4u sa = *(const v4u*)spa, sb = *(const v4u*)(spa + 512), sc = *(const v4u*)(spa + 1024), sd = *(const v4u*)(spa + 1536);
                L1_KEYS(ka, sa) L1_KEYS(kb, sb) L1_KEYS(kc, sc) L1_KEYS(kd, sd)
                unsigned reca = 0u, recb = 0u, recc = 0u, recd = 0u;
#pragma unroll
                for (int itx = 0; itx < 16; ++itx) { L1_STEP(ka, reca, itx) L1_STEP(kb, recb, itx) L1_STEP(kc, recc, itx) L1_STEP(kd, recd, itx) }
                LAS unsigned* kln = (LAS unsigned*)(xnl + n * 2048 + 1024);
                kln[(0 + rho) * 16 + li] = reca; kln[(4 + rho) * 16 + li] = recb; kln[(8 + rho) * 16 + li] = recc; kln[(12 + rho) * 16 + li] = recd;
                if (lane == 0) { ((LAS float*)wl)[2 * n] = rstd2; ((LAS float*)wl)[2 * n + 1] = sxn; }
            }
#undef L1_KEYS
#undef L1_STEP
        }
        asm volatile("s_waitcnt lgkmcnt(0)" ::: "memory");
        {
            const int hh = lane >> 3, q8 = lane & 7;
            unsigned c[4][7], rec0[4], rec1[4];
#pragma unroll
            for (int n = 0; n < 4; ++n) {
                const LAS unsigned* kln = (const LAS unsigned*)(xnl + n * 2048 + 1024);
#pragma unroll
                for (int mth = 0; mth < 7; ++mth) {
                    const int cid = q8 + 8 * mth; const unsigned ij = CAND_IJ[cid];
                    if (ij == 0xffu) { c[n][mth] = 0u; }
                    else { const unsigned ka = kln[(2 * hh) * 16 + (ij >> 4)], kb = kln[(2 * hh + 1) * 16 + (ij & 15)];
                           const float sum = hkeyf(ka) + hkeyf(kb);
                           c[n][mth] = (fkey(sum) & ~63u) | (unsigned)(63 - cid); }
                }
                CEX(c[n][0], c[n][6]); CEX(c[n][2], c[n][3]); CEX(c[n][4], c[n][5]);
                CEX(c[n][0], c[n][2]); CEX(c[n][1], c[n][4]); CEX(c[n][3], c[n][6]);
                CEX(c[n][0], c[n][1]); CEX(c[n][2], c[n][5]); CEX(c[n][3], c[n][4]);
                CEX(c[n][1], c[n][2]); CEX(c[n][4], c[n][6]);
                CEX(c[n][2], c[n][3]); CEX(c[n][4], c[n][5]);
                CEX(c[n][1], c[n][2]); CEX(c[n][3], c[n][4]); CEX(c[n][5], c[n][6]);
                rec0[n] = 0u; rec1[n] = 0u;
            }
#pragma unroll
            for (int itx = 0; itx < 16; ++itx) {
#pragma unroll
                for (int n = 0; n < 4; ++n) {
                    const unsigned mk = grpmax8_u(c[n][0]);
                    if (itx < 8) rec0[n] = (q8 == itx) ? mk : rec0[n]; else rec1[n] = (q8 == itx - 8) ? mk : rec1[n];
                    const bool own = (c[n][0] == mk);
                    c[n][0] = own ? c[n][1] : c[n][0]; c[n][1] = own ? c[n][2] : c[n][1]; c[n][2] = own ? c[n][3] : c[n][2]; c[n][3] = own ? c[n][4] : c[n][3]; c[n][4] = own ? c[n][5] : c[n][4]; c[n][5] = own ? c[n][6] : c[n][5]; c[n][6] = own ? 0u : c[n][6];
                }
            }
#pragma unroll
            for (int n = 0; n < 4; ++n) {
                const LAS unsigned* kln = (const LAS unsigned*)(xnl + n * 2048 + 1024);
                const float rstd2 = ((const LAS float*)wl)[2 * n], sxn = ((const LAS float*)wl)[2 * n + 1];
                const int cid0 = 63 - (int)(rec0[n] & 63u), cid1 = 63 - (int)(rec1[n] & 63u);
                const unsigned ij0 = CAND_IJ[cid0], ij1 = CAND_IJ[cid1];
                const int e0 = (127 - (int)(kln[(2 * hh) * 16 + (ij0 >> 4)] & 127u)) * 128 + (127 - (int)(kln[(2 * hh + 1) * 16 + (ij0 & 15)] & 127u));
                const int e1 = (127 - (int)(kln[(2 * hh) * 16 + (ij1 >> 4)] & 127u)) * 128 + (127 - (int)(kln[(2 * hh + 1) * 16 + (ij1 & 15)] & 127u));
                const float su0 = SUs[e0], su1 = SUs[e1], sv0 = SVs[e0], sv1 = SVs[e1];
                const float v0 = keyf(rec0[n] & ~63u) * rstd2, v1 = keyf(rec1[n] & ~63u) * rstd2;
                const float mx = grpmax8_f(fmaxf(v0, v1));
                const float x0e = __expf(v0 - mx), x1e = __expf(v1 - mx);
                const float inv = 1.0f / grpsum8_f(x0e + x1e);
                const int r0 = ((e0 / (16384 / PEER_NR)) - x0) & (PEER_NR - 1), r1 = ((e1 / (16384 / PEER_NR)) - x0) & (PEER_NR - 1); int pos0 = 0, pos1 = 0, start = 0;
#pragma unroll
                for (int r = 0; r < PEER_NR; ++r) {
                    const unsigned long long m0 = __ballot(r0 == r), m1 = __ballot(r1 == r);
                    const int c0 = __popcll(m0), c1 = __popcll(m1);
                    const int b0 = (int)__builtin_amdgcn_mbcnt_hi((unsigned)(m0 >> 32), __builtin_amdgcn_mbcnt_lo((unsigned)m0, 0u));
                    const int b1 = (int)__builtin_amdgcn_mbcnt_hi((unsigned)(m1 >> 32), __builtin_amdgcn_mbcnt_lo((unsigned)m1, 0u));
                    pos0 = (r0 == r) ? start + b0 : pos0; pos1 = (r1 == r) ? start + c0 + b1 : pos1;
                    start += c0 + c1;
                }
                exl[n * 128 + pos0] = e0; exl[n * 128 + pos1] = e1;
                sul[n * 128 + pos0] = su0 * sxn; sul[n * 128 + pos1] = su1 * sxn;
                gvl[n * 128 + pos0] = x0e * inv * sv0; gvl[n * 128 + pos1] = x1e * inv * sv1;
            }
        }
        asm volatile("s_waitcnt lgkmcnt(0)" ::: "memory");
        const v4u xn0 = *(const LAS v4u*)(xnl + 16 * lane), xn1 = *(const LAS v4u*)(xnl + 2048 + 16 * lane), xn2 = *(const LAS v4u*)(xnl + 4096 + 16 * lane), xn3 = *(const LAS v4u*)(xnl + 6144 + 16 * lane);
        v4u U0[8], U1[8], U2[8], U3[8];
#define PU_LOAD(U_, li0_) do { \
            const v4u ea_ = *(const LAS v4u*)(exl + (li0_)), eb_ = *(const LAS v4u*)(exl + (li0_) + 4); \
            _Pragma("unroll") for (int i_ = 0; i_ < 8; ++i_) { const unsigned e_ = (unsigned)__builtin_amdgcn_readfirstlane((int)(i_ < 4 ? ea_[i_ & 3] : eb_[i_ & 3])); \
                U_[i_] = *(const v4u*)(U8 + (size_t)e_ * 1024 + OPQ(16 * lane)); } } while (0)
#define PU_COMP(U_, li0_, xn_) do { \
            int a_[8]; \
            _Pragma("unroll") for (int i_ = 0; i_ < 8; ++i_) { int s_ = 0; \
                _Pragma("unroll") for (int w4_ = 0; w4_ < 4; ++w4_) s_ = __builtin_amdgcn_sdot4((int)U_[i_][w4_], (int)xn_[w4_], s_, false); \
                a_[i_] = s_; } \
            int b_[4]; \
            _Pragma("unroll") for (int i_ = 0; i_ < 4; ++i_) { auto r_ = __builtin_amdgcn_permlane32_swap((unsigned)a_[i_], (unsigned)a_[i_ + 4], false, false); b_[i_] = (int)r_[0] + (int)r_[1]; } \
            int c_[2]; \
            _Pragma("unroll") for (int i_ = 0; i_ < 2; ++i_) { auto r_ = __builtin_amdgcn_permlane16_swap((unsigned)b_[2 * i_], (unsigned)b_[2 * i_ + 1], false, false); c_[i_] = (int)r_[0] + (int)r_[1]; } \
            c_[0] += (int)DPP_U(c_[0], 0x128); c_[1] += (int)DPP_U(c_[1], 0x128); \
            int di_ = (lane & 8) ? c_[1] : c_[0]; \
            di_ += (int)DPP_U(di_, 0xB1); di_ += (int)DPP_U(di_, 0x4E); di_ += (int)DPP_U(di_, 0x141); \
            const float d_ = (float)di_; \
            const float w_ = gvl[(li0_) + eidx] * gelu1(d_ * sul[(li0_) + eidx]); \
            if ((lane & 7) == 0) gvl[(li0_) + eidx] = w_; } while (0)
        PU_LOAD(U0, 0); PU_LOAD(U1, 128); PU_LOAD(U2, 256); PU_LOAD(U3, 384);
#pragma unroll 1
        for (int ch = 0; ch < 15; ++ch) {
            PU_COMP(U0, ch * 8, xn0);       PU_LOAD(U0, (ch + 1) * 8);
            PU_COMP(U1, 128 + ch * 8, xn1); PU_LOAD(U1, 128 + (ch + 1) * 8);
            PU_COMP(U2, 256 + ch * 8, xn2); PU_LOAD(U2, 256 + (ch + 1) * 8);
            PU_COMP(U3, 384 + ch * 8, xn3); PU_LOAD(U3, 384 + (ch + 1) * 8);
        }
        PU_COMP(U0, 120, xn0); PU_COMP(U1, 248, xn1); PU_COMP(U2, 376, xn2); PU_COMP(U3, 504, xn3);
#undef PU_LOAD
#undef PU_COMP
        asm volatile("s_waitcnt lgkmcnt(0)" ::: "memory");
#pragma unroll
        for (int n = 0; n < 4; ++n) { v2u* lp = lst_row(A, grp * 4 + n);
            lp[lane] = (v2u){(unsigned)exl[n * 128 + lane], __float_as_uint(gvl[n * 128 + lane])};
            lp[lane + 64] = (v2u){(unsigned)exl[n * 128 + 64 + lane], __float_as_uint(gvl[n * 128 + 64 + lane])}; }
        asm volatile("s_waitcnt lgkmcnt(0)" ::: "memory");
    }
}

__device__ __forceinline__ void peer_v_phase(Frame& F, const Args& A) {
    const unsigned char* V8 = A.ws + WS_VT; float* OUT = A.out;
    const int lane = F.lane, gw = F.bid * NWAVES + F.wave, NGW = F.G * NWAVES;
    LAS unsigned char* wl = F.lds + F.wave * 4096;
    LAS int* exl = (LAS int*)wl;
    LAS float* wgl = (LAS float*)(wl + 2048);
    const float* gfin = A.in[20];
    const bf16* HB = WSP(A, WS_XN);
    static_assert(PVT == 4, "the v pass walks the u pass's groups of four tokens");
    const int ngrp = peer_ngrp(F);
    for (int gj = 0; gj < ngrp; ++gj) { const int grp = peer_grp(F, gj);
#pragma unroll
        for (int n = 0; n < PVT; ++n) { const v2u* lp = lst_row(A, grp * PVT + n); const v2u r0 = lp[lane], r1 = lp[lane + 64];
            exl[n * 128 + lane] = (int)r0.x; wgl[n * 128 + lane] = __uint_as_float(r0.y); exl[n * 128 + 64 + lane] = (int)r1.x; wgl[n * 128 + 64 + lane] = __uint_as_float(r1.y); }
        asm volatile("s_waitcnt lgkmcnt(0)" ::: "memory");
        f32x2 y0[8], y1[8], y2[8], y3[8];
#pragma unroll
        for (int i = 0; i < 8; ++i) { y0[i] = (f32x2){0.f, 0.f}; y1[i] = (f32x2){0.f, 0.f}; y2[i] = (f32x2){0.f, 0.f}; y3[i] = (f32x2){0.f, 0.f}; }
        v4u V0[4], V1[4], V2[4], V3[4];
#define PV_LOAD(V_, li0_) do { \
            const v4u ea_ = *(const LAS v4u*)(exl + (li0_)); \
            _Pragma("unroll") for (int i_ = 0; i_ < 4; ++i_) { const unsigned e_ = (unsigned)__builtin_amdgcn_readfirstlane((int)ea_[i_]); \
                V_[i_] = *(const v4u*)(V8 + (size_t)e_ * 1024 + OPQ(16 * lane)); } } while (0)
#define PV_COMP(V_, li0_, y_) do { \
            const v4u wa_ = *(const LAS v4u*)(wgl + (li0_));     \
            _Pragma("unroll") for (int i_ = 0; i_ < 4; ++i_) { \
                const float ws_ = __uint_as_float((unsigned)__builtin_amdgcn_readfirstlane((int)wa_[i_])); \
                const f32x2 w2_ = (f32x2){ws_, ws_}; \
                _Pragma("unroll") for (int q_ = 0; q_ < 4; ++q_) { const f32x2 lo_ = __builtin_amdgcn_cvt_pk_f32_fp8(V_[i_][q_], false), hi_ = __builtin_amdgcn_cvt_pk_f32_fp8(V_[i_][q_], true); \
                    y_[2 * q_] = __builtin_elementwise_fma(lo_, w2_, y_[2 * q_]); y_[2 * q_ + 1] = __builtin_elementwise_fma(hi_, w2_, y_[2 * q_ + 1]); } } } while (0)
#if DBG_VSIMPLE == 2
#pragma unroll 1
        for (int j = 0; j < 128; ++j) {
            { const v2u r = lst_row(A, grp * PVT + 0)[j]; const unsigned e_ = (unsigned)__builtin_amdgcn_readfirstlane((int)r.x); const float ws_ = __uint_as_float((unsigned)__builtin_amdgcn_readfirstlane((int)r.y));
              const v4u vv = *(const v4u*)(V8 + (size_t)e_ * 1024 + 16 * lane); const f32x2 w2_ = (f32x2){ws_, ws_};
#pragma unroll
              for (int q_ = 0; q_ < 4; ++q_) { const f32x2 lo_ = __builtin_amdgcn_cvt_pk_f32_fp8(vv[q_], false), hi_ = __builtin_amdgcn_cvt_pk_f32_fp8(vv[q_], true); y0[2 * q_] = __builtin_elementwise_fma(lo_, w2_, y0[2 * q_]); y0[2 * q_ + 1] = __builtin_elementwise_fma(hi_, w2_, y0[2 * q_ + 1]); } }
            { const v2u r = lst_row(A, grp * PVT + 1)[j]; const unsigned e_ = (unsigned)__builtin_amdgcn_readfirstlane((int)r.x); const float ws_ = __uint_as_float((unsigned)__builtin_amdgcn_readfirstlane((int)r.y));
              const v4u vv = *(const v4u*)(V8 + (size_t)e_ * 1024 + 16 * lane); const f32x2 w2_ = (f32x2){ws_, ws_};
#pragma unroll
              for (int q_ = 0; q_ < 4; ++q_) { const f32x2 lo_ = __builtin_amdgcn_cvt_pk_f32_fp8(vv[q_], false), hi_ = __builtin_amdgcn_cvt_pk_f32_fp8(vv[q_], true); y1[2 * q_] = __builtin_elementwise_fma(lo_, w2_, y1[2 * q_]); y1[2 * q_ + 1] = __builtin_elementwise_fma(hi_, w2_, y1[2 * q_ + 1]); } }
        }
#elif DBG_VSIMPLE
#pragma unroll 1
        for (int ch = 0; ch < 32; ++ch) {
            PV_LOAD(V0, ch * 4); PV_COMP(V0, ch * 4, y0);
            PV_LOAD(V1, 128 + ch * 4); PV_COMP(V1, 128 + ch * 4, y1);
            if (PVT == 4) { PV_LOAD(V2, 256 + ch * 4); PV_COMP(V2, 256 + ch * 4, y2);
            PV_LOAD(V3, 384 + ch * 4); PV_COMP(V3, 384 + ch * 4, y3); }
        }
#else
        PV_LOAD(V0, 0); PV_LOAD(V1, 128); PV_LOAD(V2, 256); PV_LOAD(V3, 384);
#pragma unroll 1
        for (int ch = 0; ch < 31; ++ch) {
            PV_COMP(V0, ch * 4, y0);       PV_LOAD(V0, (ch + 1) * 4);
            PV_COMP(V1, 128 + ch * 4, y1); PV_LOAD(V1, 128 + (ch + 1) * 4);
            PV_COMP(V2, 256 + ch * 4, y2); PV_LOAD(V2, 256 + (ch + 1) * 4);
            PV_COMP(V3, 384 + ch * 4, y3); PV_LOAD(V3, 384 + (ch + 1) * 4);
        }
        PV_COMP(V0, 124, y0); PV_COMP(V1, 252, y1); PV_COMP(V2, 380, y2); PV_COMP(V3, 508, y3);
#endif
#undef PV_LOAD
#undef PV_COMP
#pragma unroll
        for (int nn = 0; nn < PVT; ++nn) {
            const int t = grp * PVT + nn;
            const bf16* hp = (const bf16*)((const char*)(HB + (size_t)t * 1024) + OPQ(32 * lane));
            const v4u hr0 = *(const v4u*)hp, hr1 = *(const v4u*)(hp + 8);
            f32x4 o[4]; float s2 = 0.f;
#pragma unroll
            for (int i = 0; i < 4; ++i) { const f32x4 hr = (i == 0) ? bf4lo(hr0) : (i == 1) ? bf4hi(hr0) : (i == 2) ? bf4lo(hr1) : bf4hi(hr1);
                const f32x2 ya = (nn == 0) ? y0[2 * i] : (nn == 1) ? y1[2 * i] : (nn == 2) ? y2[2 * i] : y3[2 * i], yb = (nn == 0) ? y0[2 * i + 1] : (nn == 1) ? y1[2 * i + 1] : (nn == 2) ? y2[2 * i + 1] : y3[2 * i + 1];
                o[i] = hr + (f32x4){ya.x, ya.y, yb.x, yb.y}; s2 += (o[i][0] * o[i][0] + o[i][1] * o[i][1]) + (o[i][2] * o[i][2] + o[i][3] * o[i][3]); }
            const float rf = 1.0f / sqrtf(wave_sum(s2) * (1.f / 1024.f) + EPS_);
            float* op = (float*)((char*)(OUT + (size_t)t * 1024) + OPQ(64 * lane));
            const float* gp = (const float*)((const char*)gfin + OPQ(64 * lane));
            if ((DBG_VSEL >> nn) & 1) {
#pragma unroll
            for (int i = 0; i < 4; ++i) *(f32x4*)(op + 4 * i) = o[i] * rf * *(const f32x4*)(gp + 4 * i); }
            asm volatile("" ::: "memory");
        }
    }
}

constexpr int LDS_BYTES = 147456;
constexpr int N_PHASES = (USE_PEER2 == 3) ? 8 : 7;
__global__ void __launch_bounds__(NTHR, 2) fwd_kernel(Args args) {
    extern __shared__ __attribute__((aligned(16))) unsigned char lds_raw[];
    Frame F;
    F.lds = (LAS unsigned char*)lds_raw;
    F.wave = __builtin_amdgcn_readfirstlane((int)threadIdx.x >> 6);
#define RETID() do { int l_; asm volatile("v_mbcnt_lo_u32_b32 %0, -1, 0\n\tv_mbcnt_hi_u32_b32 %0, -1, %0" : "=v"(l_)); F.lane = l_; F.tid = F.wave * 64 + l_; F.bid = __builtin_amdgcn_readfirstlane(F.bid); asm volatile("" : "+s"(F.G)); } while (0)
    F.G = gridDim.x; F.bid = blockIdx.x;
    RETID();
    const Args& A = args;
#define IN(k) (lo <= (k) && (k) < hi)
    for (int u = F.tid; u < 16; u += NTHR) ((LAS unsigned*)(F.lds + LDS_MISC))[u] = 0u;
    __syncthreads();
#if ONE_LAUNCH
    XcdBarrier bar = xcd_barrier_post((unsigned*)(A.ws + WS_CTL), (volatile LAS unsigned*)(F.lds + LDS_MISC), F.tid);
    if (args.ph_lo < 0) cg::this_grid().sync();
#define XL_() (XLOCAL && ONE_LAUNCH && __builtin_amdgcn_readfirstlane((int)((volatile LAS unsigned*)(F.lds + LDS_MISC))[2]) == 1)
#define SEAM(k) do { RETID(); if (IN(k) && IN((k) + 1)) { if ((k) > 0 && XL_()) xcd_barrier_local(bar, F.tid); else xcd_barrier(bar, F.tid); \
        if ((k) == 0 && XLOCAL) { const unsigned uni_ = ((volatile LAS unsigned*)(F.lds + LDS_MISC))[2], rk_ = ((volatile LAS unsigned*)(F.lds + LDS_MISC))[3]; \
            if (__builtin_amdgcn_readfirstlane((int)uni_) == 1) { F.bid = __builtin_amdgcn_readfirstlane((int)(rk_ - 1u) * 8 + (int)bar.x); } } } RETID(); } while (0)
#else
#define SEAM(k) do { RETID(); } while (0)
#endif
#if PROBE_K >= 0
    int lo = 0, hi = PROBE_K + 1;
#elif ONE_LAUNCH
    constexpr int lo = 0, hi = N_PHASES;
#else
    const int lo = args.ph_lo, hi = args.ph_hi;
#endif
#define PHASE_PROGRAM() do { \
    if (IN(0)) { p0_prologue(F, A, 0, false, 0, 0); __syncthreads(); RETID(); p0_prologue(F, A, 1, true, 0, (2 * NEXP_ + 4 * F.G * NWAVES - 1) / (4 * F.G * NWAVES)); } SEAM(0); \
    if (IN(1)) { EpiIn E{WSP(A, WS_Q), WSP(A, WS_K), WSP(A, WS_V), WSP(A, WS_SU), WSP(A, WS_SV), (bf16*)A.out}; gemm_any(F, WSP(A, WS_XN), WSP(A, WS_WIN), T_, DIN_, D_, E, (EPI_SKIP && first_) ? 1 : 0); } SEAM(1); \
    if (IN(2)) {   \
                 const bool gfirst_ = !(P2_SPLIT && XL_() && (F.bid & 4)); \
                 _Pragma("nounroll") for (int part_ = 0; part_ < 2; ++part_) { \
                 if ((part_ == 0) == gfirst_) { gmlp_mfma(F, A); } else { \
                 const float s1_ = wave_sum(A.in[3][F.lane] * A.in[4][F.lane]), s2_ = wave_sum(A.in[5][F.lane] * A.in[6][F.lane]); \
                 const float lam_ = __builtin_bit_cast(float, __builtin_amdgcn_readfirstlane(__builtin_bit_cast(int, expf(s1_) - expf(s2_) + LAM_INIT_))); \
                 const attn128::AttnTensors AT{(const attn128::bf16*)WSP(A, WS_Q), (const attn128::bf16*)WSP(A, WS_K), (const attn128::bf16*)WSP(A, WS_V), (attn128::bf16*)WSP(A, WS_XN), (const float*)(A.ws + WS_GSUB), lam_, (first_ && DBG_ATTN_QB != -1) ? DBG_ATTN_QB : -1}; \
                 const unsigned tcy_ = attn128::attn_phase<8>((char*)lds_raw, AT, F.G, F.bid, F.wave); \
                 if (ATTN_TIMING && first_) { const unsigned long long t0_ = __builtin_amdgcn_s_memtime(); while (__builtin_amdgcn_s_memtime() - t0_ < 4ull * tcy_) __builtin_amdgcn_s_sleep(2); } } \
                 __syncthreads(); RETID(); } } SEAM(2); \
    if (IN(3)) { gemm_merge(F, WSP(A, WS_XN), WSP(A, WS_WA), (long)(WS_SU - WS_XN), (long)(WS_WB - WS_WA), (const bf16*)A.out, WSP(A, WS_Q)); } SEAM(3); \
    if (IN(4)) { EpiOut E{A.in[0], WSP(A, WS_XN)}; gemm_any(F, WSP(A, WS_Q), WSP(A, WS_WO), T_, D_, D_, E); } SEAM(4); \
    if (IN(5)) { EpiSc E{&A}; gemm_any(F, WSP(A, WS_XN), WSP(A, WS_WQS), T_, 2048, D_, E); } SEAM(5); \
    if (USE_PEER2 == 3) { if (IN(6)) { if (DBG_LIST) peer_phase3(F, A); else peer_u_phase(F, A); } SEAM(6); if (IN(7)) { if (DBG_LIST != 2) peer_v_phase(F, A); } } else \
    if (IN(6)) { if (PEER_VARIANT != 0 && first_) peer_phase<PEER_VARIANT>(F, A); else if (USE_PEER2 == 2) peer_phase3(F, A); else if (USE_PEER2 == 1) { if (PEER2_FIXED && first_) peer_phase2<true>(F, A); else peer_phase2<false>(F, A); } else peer_phase<0>(F, A); } \
    } while (0)
    bool first_ = (PROBE_K >= 0);
    PHASE_PROGRAM();
#if PROBE_K >= 0
    RETID(); xcd_barrier(bar, F.tid); RETID();
    hi = N_PHASES; first_ = false;
    PHASE_PROGRAM();
#endif
#undef IN
#undef SEAM
}

extern "C" void kernel_launch(void* const* d_in, const int* in_sizes, int n_in, void* d_out, int out_size, void* d_ws, size_t ws_size, hipStream_t stream) {
    static int grid = 0;
    if (grid == 0) {
        if (n_in != 21 || in_sizes[0] != T_ * D_ || out_size != T_ * D_ || ws_size < WS_END) { fprintf(stderr, "kernel_launch: unexpected problem: n_in %d in0 %d out %d ws %zu (need %zu)\n", n_in, n_in > 0 ? in_sizes[0] : -1, out_size, ws_size, (size_t)WS_END); grid = -1; return; }
        int dev = 0, cus = 0, per_cu = 0;
        if (hipGetDevice(&dev) != hipSuccess || hipDeviceGetAttribute(&cus, hipDeviceAttributeMultiprocessorCount, dev) != hipSuccess) { grid = -1; return; }
        if (hipFuncSetAttribute((const void*)fwd_kernel, hipFuncAttributeMaxDynamicSharedMemorySize, LDS_BYTES) != hipSuccess) { fprintf(stderr, "kernel_launch: hipFuncSetAttribute failed\n"); grid = -1; return; }
        if (hipOccupancyMaxActiveBlocksPerMultiprocessor(&per_cu, (const void*)fwd_kernel, NTHR, LDS_BYTES) != hipSuccess || per_cu < 1) { fprintf(stderr, "kernel_launch: occupancy query says %d\n", per_cu); per_cu = 1; }
        (void)hipGetLastError();
        grid = cus;
    }
    if (grid < 0) return;
    if (hipMemsetAsync((char*)d_ws + WS_CTL, 0, 65536, stream) != hipSuccess) { fprintf(stderr, "kernel_launch: memset failed\n"); return; }
    Args a{};
    for (int i = 0; i < 21; ++i) a.in[i] = (const float*)d_in[i];
    a.out = (float*)d_out; a.ws = (unsigned char*)d_ws;
#if ONE_LAUNCH
    a.ph_lo = 0; a.ph_hi = N_PHASES;
    void* kargs[] = {&a};
#if PLAIN_LAUNCH
    (void)kargs; hipLaunchKernelGGL(fwd_kernel, dim3(grid), dim3(NTHR), LDS_BYTES, stream, a); hipError_t e = hipPeekAtLastError();
#else
    hipError_t e = hipLaunchCooperativeKernel((const void*)fwd_kernel, dim3(grid), dim3(NTHR), kargs, LDS_BYTES, stream);
#endif
    if (e != hipSuccess) fprintf(stderr, "cooperative launch failed: %s (grid %d)\n", hipGetErrorString(e), grid);
#else
    for (int p = 0; p < N_PHASES; ++p) {
        a.ph_lo = p; a.ph_hi = p + 1;
        hipLaunchKernelGGL(fwd_kernel, dim3(grid), dim3(NTHR), LDS_BYTES, stream, a);
    }
#endif
}
```

```cpp
#include <hip/hip_runtime.h>
#include <hip/hip_cooperative_groups.h>
#include <hip/hip_bf16.h>
#include <cstdio>
#include <cstdint>
#include <cmath>
namespace cg = cooperative_groups;

#ifndef USE_PG8
#define USE_PG8 1
#endif
#ifndef USE_ATTN
#define USE_ATTN 1
#endif
#ifndef USE_GMLP
#define USE_GMLP 1
#endif
#ifndef ONE_LAUNCH
#define ONE_LAUNCH 1
#endif
#ifndef PROBE_K
#define PROBE_K -1
#endif
#ifndef PEER_VARIANT
#define PEER_VARIANT 0
#endif
#ifndef USE_PEER2
#define USE_PEER2 3
#endif
#ifndef PEER2_FIXED
#define PEER2_FIXED 0
#endif
#ifndef PEER_XSYNC
#define PEER_XSYNC 0
#endif
#ifndef PEER_NR
#define PEER_NR 16
#endif
#ifndef DBG_LIST
#define DBG_LIST 0
#endif
#ifndef DBG_VSIMPLE
#define DBG_VSIMPLE 0
#endif
#ifndef DBG_VSEL
#define DBG_VSEL 15
#endif
#ifndef PVT
#define PVT 4
#endif
#ifndef PG8_WGM
#define PG8_WGM 8
#endif
#ifndef PEER_UV_BARRIER
#define PEER_UV_BARRIER 0
#endif
#ifndef EPI_PLAIN
#define EPI_PLAIN 0
#endif
#ifndef PG8_ALIGN_EPI
#define PG8_ALIGN_EPI 1
#endif
#ifndef DBG_ATTN_QB
#define DBG_ATTN_QB -1
#endif
#ifndef PLAIN_LAUNCH
#define PLAIN_LAUNCH 0
#endif
#ifndef EPI_SKIP
#define EPI_SKIP 0
#endif
#ifndef STAGGER
#define STAGGER 1
#endif
#ifndef SKEW_TEST
#define SKEW_TEST 0
#endif
#ifndef ST_SC1
#define ST_SC1 0
#endif
#ifndef PG8_RELAX
#define PG8_RELAX 0
#endif
#ifndef XLOCAL
#define XLOCAL 1
#endif
#ifndef P2_SPLIT
#define P2_SPLIT 1
#endif
#ifndef P0_XROWS
#define P0_XROWS 8
#endif
#ifndef PEER_U_DELAY
#define PEER_U_DELAY 0
#endif
#ifndef PEER_U_OFFSET
#define PEER_U_OFFSET 1
#endif
#ifndef P0_XCONSEC
#define P0_XCONSEC 0
#endif
#ifndef P0_SKIP
#define P0_SKIP 0
#endif
#ifndef P0_XFIRST
#define P0_XFIRST 0
#endif
#ifndef PG8_REVODD
#define PG8_REVODD 2
#endif
#ifndef PG8_ROT_ALL
#define PG8_ROT_ALL 0
#endif
#ifndef PG8_KROT
#define PG8_KROT 1
#endif
#ifndef PG8_PNSPREAD
#define PG8_PNSPREAD 0
#endif
#ifndef PG8_ROT_SC
#define PG8_ROT_SC 1
#endif
#ifndef PG8_SP2X
#define PG8_SP2X 1
#endif
namespace pg8 {
#define PG8_LAS __attribute__((address_space(3)))
typedef unsigned short bf16_t;
typedef short bf16x8 __attribute__((ext_vector_type(8)));
typedef float f32x4 __attribute__((ext_vector_type(4)));
typedef unsigned u32x4 __attribute__((ext_vector_type(4)));
constexpr int BM = 256, BK = 64, HALF = 128, HTB = HALF * BK * 2  , STAGE_BYTES = 8 * HTB, NXCD = 8, WGM = PG8_WGM;

__host__ __device__ __forceinline__ int lds_byte(int r, int c) { const int st = (r >> 4) * 2 + (c >> 5), rr = r & 15, cc = c & 31, ob = rr * 64 + cc * 2; return st * 1024 + (ob ^ (((ob >> 9) & 1) << 5)); }
__host__ __device__ __forceinline__ void stage_rc(int b, int& R, int& C) { const int st = b / 1024, sb = b % 1024, swz = sb ^ (((sb >> 9) & 1) << 5); R = (st >> 1) * 16 + swz / 64; C = (st & 1) * 32 + (swz % 64) / 2; }
__host__ __device__ __forceinline__ int perm32(int rho) { const int n = rho >> 4, i = rho & 15; return 8 * (i >> 2) + 4 * n + (i & 3); }

struct Unit { int pm, pn; };
struct Gemm { const bf16_t* A; const bf16_t* Bt; int M, N, K; int nseg; long dA, dB; };

struct StaticOrder {
    int nM, nN, nwg, G, c, rev;
    __host__ __device__ void init(int M, int N, int G_, int c_, int rev_ = 0) { nM = M / BM; nN = N / BM; nwg = nM * nN; G = G_; c = c_; rev = rev_; }
    __host__ __device__ bool next(int i, Unit& u) const {
        const long L = (long)i * G + c; if (L >= nwg) return false;
        int wgid = (int)L; { const int q = nwg / NXCD, r = nwg % NXCD, xcd = wgid % NXCD, off = wgid / NXCD; wgid = (xcd < r ? xcd * (q + 1) : r * (q + 1) + (xcd - r) * q) + off; }
        const int nig = WGM * nN, gid = wgid / nig, fm = gid * WGM, gsz = (nM - fm) < WGM ? (nM - fm) : WGM;
        u.pm = fm + ((wgid % nig) % gsz); u.pn = (wgid % nig) / gsz; if (PG8_REVODD == 1 && rev && ((c % NXCD) & 1)) u.pn = nN - 1 - u.pn;
        if (PG8_REVODD == 2 && rev) { if (PG8_PNSPREAD && (nN & 3) == 0) u.pn = (u.pn & 3) * (nN >> 2) + (u.pn >> 2);
            u.pn = (u.pn + ((c % NXCD) * nN) / NXCD) % nN; }
        return true;
    }
    __device__ __forceinline__ void a_ready(const Unit&) const {}
    __device__ __forceinline__ void done(const Unit&) const {}
};

__device__ __forceinline__ unsigned cvt_pk_bf16(float lo, float hi) { unsigned r; asm volatile("v_cvt_pk_bf16_f32 %0, %1, %2" : "=v"(r) : "v"(lo), "v"(hi)); return r; }
typedef float f32x2 __attribute__((ext_vector_type(2)));
__device__ __forceinline__ f32x2 gelu_pk(f32x2 v) {
    const f32x2 av = __builtin_elementwise_abs(v), d = av * 0.2316418882f + 1.0f;
    f32x2 t; t.x = __builtin_amdgcn_rcpf(d.x); t.y = __builtin_amdgcn_rcpf(d.y);
    f32x2 q = t * 0.5307027145f + (-0.7265760135f); q = q * t + 0.7107068705f; q = q * t + (-0.142248368f); q = q * t + 0.127414796f; q = q * t;
    const f32x2 s = (v * v) * (-0.72134752044f);
    f32x2 e; e.x = __builtin_amdgcn_exp2f(s.x); e.y = __builtin_amdgcn_exp2f(s.y);
    const f32x2 m = v * (q * e), r = v - m;
    f32x2 o; o.x = v.x < 0.f ? m.x : r.x; o.y = v.y < 0.f ? m.y : r.y; return o;
}

template <int ACT  > struct EpiBf16 {
    static constexpr bool PERM = true, AFTER_DRAIN = false; static_assert(ACT == 0 || ACT == 1, "EpiBf16: ACT is 0 (none) or 1 (gelu_pk)");
    bf16_t* O; int ldc; const float* bias; int split_cols; size_t split_stride; float scale0;
    __device__ __forceinline__ void operator()(const f32x4 (&acc)[2][2][4][2], const Unit& u, int wr, int wc, int fr, int fq) const {
        const int row0 = u.pm * BM + wr * 64 + fr; int colt = u.pn * BM; bf16_t* base = O;
        float sc = 1.f; if (split_cols) { const int t = colt / split_cols; base += (size_t)t * split_stride; colt -= t * split_cols; if (t == 0) sc = scale0; }
        const int col0 = colt + wc * 32 + 8 * fq, bcol0 = u.pn * BM + wc * 32 + 8 * fq;
        f32x4 bv[2][2];
#pragma unroll
        for (int bj = 0; bj < 2; ++bj)
#pragma unroll
            for (int n = 0; n < 2; ++n) bv[bj][n] = bias ? *(const f32x4*)(bias + bcol0 + bj * HALF + 4 * n) : (f32x4){0.f, 0.f, 0.f, 0.f};
#pragma unroll
        for (int ai = 0; ai < 2; ++ai)
#pragma unroll
            for (int m = 0; m < 4; ++m) { bf16_t* rowp = base + (size_t)(row0 + ai * HALF + m * 16) * ldc + col0;
#pragma unroll
                for (int bj = 0; bj < 2; ++bj) { f32x4 v0 = acc[ai][bj][m][0] + bv[bj][0], v1 = acc[ai][bj][m][1] + bv[bj][1];
                    if (ACT == 1) { f32x2 a = gelu_pk((f32x2){v0[0], v0[1]}), b = gelu_pk((f32x2){v0[2], v0[3]}), c = gelu_pk((f32x2){v1[0], v1[1]}), d = gelu_pk((f32x2){v1[2], v1[3]});
                        v0 = (f32x4){a.x, a.y, b.x, b.y}; v1 = (f32x4){c.x, c.y, d.x, d.y}; }
                    v0 = v0 * sc; v1 = v1 * sc; u32x4 w; w.x = cvt_pk_bf16(v0[0], v0[1]); w.y = cvt_pk_bf16(v0[2], v0[3]); w.z = cvt_pk_bf16(v1[0], v1[1]); w.w = cvt_pk_bf16(v1[2], v1[3]);
                    *(u32x4*)(rowp + bj * HALF) = w; } }
    }
};

struct PanelStats {
    unsigned* xbuf;
    unsigned* cnt;
    unsigned* tmo;
    int ntn; float eps;
    unsigned code;
    __device__ __forceinline__ bool run(const f32x4 (&v)[2][2][4][2], const Unit& u, int wr, int wc, int fr, int fq, PG8_LAS unsigned char* lds, int wid, int lane) const {
        typedef float f32x2v __attribute__((ext_vector_type(2)));
        PG8_LAS f32x2v* P = (PG8_LAS f32x2v*)lds;
        PG8_LAS f32x2v* S = (PG8_LAS f32x2v*)(lds + 8192);
        PG8_LAS unsigned* flag = (PG8_LAS unsigned*)(lds + 8192 + 2048);
#pragma unroll
        for (int ai = 0; ai < 2; ++ai)
#pragma unroll
            for (int m = 0; m < 4; ++m) {
                float s = 0.f;
#pragma unroll
                for (int bj = 0; bj < 2; ++bj)
#pragma unroll
                    for (int n = 0; n < 2; ++n) { const f32x4 x = v[ai][bj][m][n]; s += (x[0] + x[1]) + (x[2] + x[3]); }
                s += __shfl_xor(s, 16); s += __shfl_xor(s, 32);
                const float mw = s * (1.0f / 64.0f); float q = 0.f;
#pragma unroll
                for (int bj = 0; bj < 2; ++bj)
#pragma unroll
                    for (int n = 0; n < 2; ++n) { const f32x4 d = v[ai][bj][m][n] - mw; q += (d[0] * d[0] + d[1] * d[1]) + (d[2] * d[2] + d[3] * d[3]); }
                q += __shfl_xor(q, 16); q += __shfl_xor(q, 32);
                if (fq == 0) P[(ai * HALF + wr * 64 + m * 16 + fr) * 4 + wc] = (f32x2v){mw, q};
            }
        asm volatile("s_waitcnt lgkmcnt(0)" ::: "memory"); __builtin_amdgcn_s_barrier(); asm volatile("" ::: "memory");
#if defined(BROKEN_EXCHANGE_NO_WAIT)
#warning BROKEN CONTROL BUILD: the row-statistics exchange does not wait; results are wrong by design
        if (blockIdx.x >= 64) { const long long t0_ = clock64(); while (clock64() - t0_ < 60000) __builtin_amdgcn_s_sleep(8); }
#endif
        const int row = wid * 32 + (lane & 31);
        if (lane < 32) {
            const f32x2v a = P[row * 4 + 0], b = P[row * 4 + 1], c = P[row * 4 + 2], d = P[row * 4 + 3];
            const float mt = (a.x + b.x + c.x + d.x) * 0.25f;
            const float da = a.x - mt, db = b.x - mt, dc = c.x - mt, dd = d.x - mt;
            const float m2 = (a.y + b.y) + (c.y + d.y) + 64.0f * ((da * da + db * db) + (dc * dc + dd * dd));
            unsigned long long* slot = (unsigned long long*)xbuf + ((size_t)(u.pm * BM + row) * 4 + u.pn);
            __hip_atomic_store(slot, ((unsigned long long)__float_as_uint(m2) << 32) | __float_as_uint(mt), __ATOMIC_RELAXED, __HIP_MEMORY_SCOPE_AGENT);
        }
        asm volatile("s_waitcnt vmcnt(0)" ::: "memory");
        if (lane == 0) __hip_atomic_fetch_add(cnt + 64 * u.pm, 1u, __ATOMIC_RELAXED, __HIP_MEMORY_SCOPE_AGENT);
        if (wid == 0) {
            bool dead = false; const unsigned long long t0 = __builtin_amdgcn_s_memrealtime(); const unsigned want = 8u * (unsigned)ntn;
            for (;;) {
#if defined(BROKEN_EXCHANGE_NO_WAIT)
                break;
#endif
                if ((unsigned)__builtin_amdgcn_readfirstlane(__hip_atomic_load(cnt + 64 * u.pm, __ATOMIC_RELAXED, __HIP_MEMORY_SCOPE_AGENT)) >= want) break;
                if (__builtin_amdgcn_s_memrealtime() - t0 > 2000000ull) {
                    if (lane == 0) { unsigned expect = 0u; __hip_atomic_compare_exchange_strong(tmo + 1, &expect, code | (unsigned)(u.pm & 0xff), __ATOMIC_RELAXED, __ATOMIC_RELAXED, __HIP_MEMORY_SCOPE_AGENT);
                                     __hip_atomic_store(tmo, 1u, __ATOMIC_RELAXED, __HIP_MEMORY_SCOPE_AGENT); }
                    dead = true; break; }
                __builtin_amdgcn_s_sleep(2);
            }
            __builtin_amdgcn_fence(__ATOMIC_ACQUIRE, "agent");
            if (lane == 0) flag[0] = dead ? 1u : 0u;
        }
        asm volatile("s_waitcnt vmcnt(0) lgkmcnt(0)" ::: "memory"); __builtin_amdgcn_s_barrier(); asm volatile("" ::: "memory");
        const bool bad = flag[0] != 0u;
        if (lane < 32) {
            const unsigned long long* slot = (const unsigned long long*)xbuf + (size_t)(u.pm * BM + row) * 4; float mt[4], m2[4]; float ms = 0.f;
#pragma unroll
            for (int t = 0; t < 4; ++t) { if (t < ntn) { const unsigned long long w = __hip_atomic_load(slot + t, __ATOMIC_RELAXED, __HIP_MEMORY_SCOPE_AGENT); mt[t] = __uint_as_float((unsigned)w); m2[t] = __uint_as_float((unsigned)(w >> 32)); } else { mt[t] = 0.f; m2[t] = 0.f; } ms += mt[t]; }
            const float mean = ms / (float)ntn; float q = 0.f;
#pragma unroll
            for (int t = 0; t < 4; ++t) if (t < ntn) { const float dm = mt[t] - mean; q += m2[t] + 256.0f * dm * dm; }
            S[row] = (f32x2v){mean, 1.0f / sqrtf(q / (256.0f * (float)ntn) + eps)};
        }
        asm volatile("s_waitcnt lgkmcnt(0)" ::: "memory"); __builtin_amdgcn_s_barrier(); asm volatile("" ::: "memory");
        return bad;
    }
};
struct EpiLnRes {
    static constexpr bool PERM = false, AFTER_DRAIN = true;
    const float* base; float* out; int ldc; const float* bias; PanelStats st; unsigned poison;
    __device__ __forceinline__ void fused(f32x4 (&acc)[2][2][4][2], const Unit& u, int wr, int wc, int fr, int fq, PG8_LAS unsigned char* lds, int wid, int lane) const {
        typedef float f32x2v __attribute__((ext_vector_type(2)));
        const PG8_LAS f32x2v* S = (const PG8_LAS f32x2v*)(lds + 8192);
        const int col0 = u.pn * BM + wc * 32 + 4 * fq;
#pragma unroll
        for (int bj = 0; bj < 2; ++bj)
#pragma unroll
            for (int n = 0; n < 2; ++n) { const f32x4 bv = bias ? *(const f32x4*)(bias + col0 + bj * HALF + n * 16) : (f32x4){0.f, 0.f, 0.f, 0.f};
#pragma unroll
                for (int ai = 0; ai < 2; ++ai)
#pragma unroll
                    for (int m = 0; m < 4; ++m) acc[ai][bj][m][n] += bv; }
        f32x4 pre[4][2][2];
#pragma unroll
        for (int m = 0; m < 4; ++m) { const size_t off = (size_t)(u.pm * BM + wr * 64 + m * 16 + fr) * ldc + col0;
#pragma unroll
            for (int bj = 0; bj < 2; ++bj)
#pragma unroll
                for (int n = 0; n < 2; ++n) pre[m][bj][n] = *(const f32x4*)(base + off + bj * HALF + n * 16); }
        const bool bad = st.run(acc, u, wr, wc, fr, fq, lds, wid, lane) || poison != 0u;
        const float qnan = __builtin_nanf("");
#pragma unroll
        for (int ai = 0; ai < 2; ++ai)
#pragma unroll
            for (int m = 0; m < 4; ++m) { const int r = ai * HALF + wr * 64 + m * 16 + fr; const f32x2v sr = S[r]; const size_t off = (size_t)(u.pm * BM + r) * ldc + col0;
#pragma unroll
                for (int bj = 0; bj < 2; ++bj)
#pragma unroll
                    for (int n = 0; n < 2; ++n) { const f32x4 bs = ai == 0 ? pre[m][bj][n] : *(const f32x4*)(base + off + bj * HALF + n * 16); f32x4 o = bs + (acc[ai][bj][m][n] - sr.x) * sr.y;
                        if (bad) o = (f32x4){qnan, qnan, qnan, qnan}; *(f32x4*)(out + off + bj * HALF + n * 16) = o; }
                if (m & 1) asm volatile("" ::: "memory"); }
    }
};
struct EpiLnResLn {
    static constexpr bool PERM = false, AFTER_DRAIN = true;
    const float* base; float* out; bf16_t* xn; int ldc; const float* bias; PanelStats st1, st2; unsigned poison;
    __device__ __forceinline__ void fused(f32x4 (&acc)[2][2][4][2], const Unit& u, int wr, int wc, int fr, int fq, PG8_LAS unsigned char* lds, int wid, int lane) const {
        typedef float f32x2v __attribute__((ext_vector_type(2))); typedef unsigned u32x2v __attribute__((ext_vector_type(2)));
        const PG8_LAS f32x2v* S = (const PG8_LAS f32x2v*)(lds + 8192);
        const int col0 = u.pn * BM + wc * 32 + 4 * fq;
#pragma unroll
        for (int bj = 0; bj < 2; ++bj)
#pragma unroll
            for (int n = 0; n < 2; ++n) { const f32x4 bv = bias ? *(const f32x4*)(bias + col0 + bj * HALF + n * 16) : (f32x4){0.f, 0.f, 0.f, 0.f};
#pragma unroll
                for (int ai = 0; ai < 2; ++ai)
#pragma unroll
                    for (int m = 0; m < 4; ++m) acc[ai][bj][m][n] += bv; }
        bool bad = st1.run(acc, u, wr, wc, fr, fq, lds, wid, lane) || poison != 0u;
        const float qnan = __builtin_nanf("");
#pragma unroll
        for (int ai = 0; ai < 2; ++ai)
#pragma unroll
            for (int m = 0; m < 4; ++m) { const int r = ai * HALF + wr * 64 + m * 16 + fr; const f32x2v sr = S[r]; const size_t off = (size_t)(u.pm * BM + r) * ldc + col0;
#pragma unroll
                for (int bj = 0; bj < 2; ++bj)
#pragma unroll
                    for (int n = 0; n < 2; ++n) { const f32x4 bs = *(const f32x4*)(base + off + bj * HALF + n * 16); acc[ai][bj][m][n] = bs + (acc[ai][bj][m][n] - sr.x) * sr.y; }
                asm volatile("" : "+v"(acc[ai][0][m][0]), "+v"(acc[ai][0][m][1]), "+v"(acc[ai][1][m][0]), "+v"(acc[ai][1][m][1]));
                if (m & 1) asm volatile("" ::: "memory"); }
        const bool bad1 = bad;
        bad = st2.run(acc, u, wr, wc, fr, fq, lds, wid, lane) || bad;
#pragma unroll
        for (int ai = 0; ai < 2; ++ai)
#pragma unroll
            for (int m = 0; m < 4; ++m) { const int r = ai * HALF + wr * 64 + m * 16 + fr; const f32x2v sr = S[r]; const size_t off = (size_t)(u.pm * BM + r) * ldc + col0;
#pragma unroll
                for (int bj = 0; bj < 2; ++bj)
#pragma unroll
                    for (int n = 0; n < 2; ++n) { const f32x4 x1 = acc[ai][bj][m][n]; *(f32x4*)(out + off + bj * HALF + n * 16) = bad1 ? (f32x4){qnan, qnan, qnan, qnan} : x1;
                        const f32x4 o = (x1 - sr.x) * sr.y; u32x2v w; w.x = cvt_pk_bf16(o[0], o[1]); w.y = cvt_pk_bf16(o[2], o[3]);
                        if (bad) { w.x = 0x7fc07fc0u; w.y = 0x7fc07fc0u; } *(u32x2v*)(xn + off + bj * HALF + n * 16) = w; }
                asm volatile("" ::: "memory"); }
    }
};

template <class Epi, class Sched, bool ALIGN_EPI = false, bool SP2 = false>
__device__ __forceinline__ void gemm_phase(PG8_LAS unsigned char* lds, const Gemm g, const Sched& S, const Epi& E, const int tid) {
    const int wid = __builtin_amdgcn_readfirstlane(tid >> 6), lane = tid & 63, wr = wid >> 2, wc = wid & 3, fr = lane & 15, fq = lane >> 4;
    const int K = g.K, seg = K / BK, nt = (g.nseg > 1) ? seg * g.nseg : seg;
    constexpr bool RELAX = PG8_RELAX && SP2 && ALIGN_EPI && !Epi::AFTER_DRAIN && (Epi::NSTORE == 16);
    unsigned voffA[2], voffB[2];
#pragma unroll
    for (int i = 0; i < 2; ++i) { int R, C; stage_rc(tid * 16 + i * 8192, R, C); const int Rb = Epi::PERM ? ((R & ~31) + perm32(R & 31)) : R;
        voffA[i] = (unsigned)(R * K + C) * 2u; voffB[i] = (unsigned)(Rb * K + C) * 2u; }
    const size_t kstep = (size_t)(BK * 2);
    const long jA = g.dA - (long)seg * (long)kstep, jB = g.dB - (long)seg * (long)kstep;
    const size_t hstep = (size_t)HALF * K * 2;
    const size_t tstep = 2 * hstep;
    const unsigned ldsw = (unsigned)wid * 1024u;
    const int aoff = lds_byte(wr * 64 + fr, fq * 8), boff = lds_byte(wc * 32 + fr, fq * 8);
#define PG8_SA(b, h) (((b) * 2 + (h)) * HTB)
#define PG8_SB(b, h) ((4 + (b) * 2 + (h)) * HTB)
#define PG8_STAGE(bufoff, gbase, voff) do { _Pragma("unroll") for (int _i = 0; _i < 2; ++_i) \
        __builtin_amdgcn_global_load_lds((const unsigned*)((const char*)(gbase) + (voff)[_i]), (PG8_LAS unsigned*)(lds + (bufoff) + ldsw + _i * 8192), 16, 0, 0); } while (0)
#define PG8_LDA(dst, b, h) do { _Pragma("unroll") for (int m = 0; m < 4; ++m) _Pragma("unroll") for (int k = 0; k < 2; ++k) dst[m][k] = *(const PG8_LAS bf16x8*)(lds + PG8_SA(b, h) + aoff + m * 2048 + k * 1024); } while (0)
#define PG8_LDB(dst, b, h) do { _Pragma("unroll") for (int n = 0; n < 2; ++n) _Pragma("unroll") for (int k = 0; k < 2; ++k) dst[n][k] = *(const PG8_LAS bf16x8*)(lds + PG8_SB(b, h) + boff + n * 2048 + k * 1024); } while (0)
#define PG8_MMA(ai, bj, At, Bt) do { __builtin_amdgcn_s_setprio(1); _Pragma("unroll") for (int m = 0; m < 4; ++m) _Pragma("unroll") for (int n = 0; n < 2; ++n) _Pragma("unroll") for (int k = 0; k < 2; ++k) \
        acc[ai][bj][m][n] = __builtin_amdgcn_mfma_f32_16x16x32_bf16(Bt[n][k], At[m][k], acc[ai][bj][m][n], 0, 0, 0); __builtin_amdgcn_s_setprio(0); } while (0)
#define PG8_WAIT_V(n) asm volatile("s_waitcnt vmcnt(" #n ")" ::: "memory")
#define PG8_WAIT_L(n) asm volatile("s_waitcnt lgkmcnt(" #n ")" ::: "memory")
#define PG8_BAR __builtin_amdgcn_s_barrier()
#define PG8_SCHED __builtin_amdgcn_sched_barrier(0)
    Unit cur, nxt; int ui = 0;
    if (!S.next(0, cur)) return;
    f32x4 acc[2][2][4][2];
#pragma unroll
    for (int a = 0; a < 2; ++a)
#pragma unroll
        for (int b = 0; b < 2; ++b)
#pragma unroll
            for (int m = 0; m < 4; ++m)
#pragma unroll
                for (int n = 0; n < 2; ++n) acc[a][b][m][n] = (f32x4){0.f, 0.f, 0.f, 0.f};
    bf16x8 At[4][2], B0[2][2], B1[2][2];
    const char* cA = (const char*)g.A + (size_t)cur.pm * tstep; const char* cB = (const char*)g.Bt + (size_t)cur.pn * tstep;
    S.a_ready(cur);
    if constexpr (SP2) {
        PG8_STAGE(PG8_SB(0, 0), cB, voffB); PG8_STAGE(PG8_SB(0, 1), cB + hstep, voffB); PG8_STAGE(PG8_SA(0, 0), cA, voffA); PG8_STAGE(PG8_SA(0, 1), cA + hstep, voffA);
        if (wr == 1) PG8_BAR;
        PG8_WAIT_V(2); PG8_BAR;
        PG8_STAGE(PG8_SB(1, 0), cB + kstep, voffB); PG8_STAGE(PG8_SA(1, 0), cA + kstep, voffA); PG8_STAGE(PG8_SB(1, 1), cB + hstep + kstep, voffB);
        PG8_WAIT_V(6); PG8_BAR;
    } else {
        PG8_STAGE(PG8_SB(0, 0), cB, voffB); PG8_STAGE(PG8_SA(0, 0), cA, voffA); PG8_STAGE(PG8_SB(0, 1), cB + hstep, voffB); PG8_STAGE(PG8_SA(0, 1), cA + hstep, voffA);
        if (wr == 1) PG8_BAR;
        PG8_WAIT_V(4); PG8_BAR;
        PG8_STAGE(PG8_SB(1, 0), cB + kstep, voffB); PG8_STAGE(PG8_SA(1, 0), cA + kstep, voffA); PG8_STAGE(PG8_SB(1, 1), cB + hstep + kstep, voffB);
        PG8_WAIT_V(6); PG8_BAR;
    }
    for (;;) {
        const bool has_next = S.next(ui + 1, nxt);
        const char* nA = has_next ? (const char*)g.A + (size_t)nxt.pm * tstep : cA; const char* nB = has_next ? (const char*)g.Bt + (size_t)nxt.pn * tstep : cB;
#define PG8_KOFF(x, j) ((size_t)(x) * kstep + (((x) >= seg) ? (size_t)(j) : (size_t)0))
#define PG8_ITER(RLX_) { \
            const bool last = (t == nt - 2); \
            if constexpr (Epi::KSPLIT) { if (t == seg) E.mid(acc, cur, wr, wc, fr, fq); } \
            const char* a1 = cA + PG8_KOFF(t + 1, jA); \
            const char* a2 = last ? nA : cA + PG8_KOFF(t + 2, jA); const char* b2 = last ? nB : cB + PG8_KOFF(t + 2, jB); \
            const char* a3 = last ? nA + kstep : cA + PG8_KOFF(t + 3, jA); const char* b3 = last ? nB + kstep : cB + PG8_KOFF(t + 3, jB); \
            if (last && has_next) S.a_ready(nxt); \
            if constexpr (SP2) { \
            constexpr bool rlx = (RLX_); \
            PG8_LDB(B0, 0, 0); PG8_LDB(B1, 0, 1); PG8_SCHED; PG8_LDA(At, 0, 0); if constexpr (!rlx) { PG8_STAGE(PG8_SA(1, 1), a1 + hstep, voffA); } \
            if constexpr (rlx) { PG8_WAIT_V(24); } else { PG8_WAIT_V(8); } PG8_WAIT_L(0); PG8_BAR; PG8_MMA(0, 0, At, B0); PG8_MMA(0, 1, At, B1); PG8_BAR; PG8_SCHED; \
            PG8_LDA(At, 0, 1); PG8_STAGE(PG8_SB(0, 0), b2, voffB); PG8_STAGE(PG8_SB(0, 1), b2 + hstep, voffB); PG8_STAGE(PG8_SA(0, 0), a2, voffA); \
            if constexpr (rlx) { PG8_WAIT_V(24); } else { PG8_WAIT_V(8); } PG8_WAIT_L(0); PG8_BAR; PG8_MMA(1, 0, At, B0); PG8_MMA(1, 1, At, B1); PG8_BAR; PG8_SCHED; \
            PG8_LDB(B0, 1, 0); PG8_LDB(B1, 1, 1); PG8_SCHED; PG8_LDA(At, 1, 0); PG8_STAGE(PG8_SA(0, 1), a2 + hstep, voffA); \
            if constexpr (rlx) { PG8_WAIT_V(24); } else { PG8_WAIT_V(8); } PG8_WAIT_L(0); PG8_BAR; PG8_MMA(0, 0, At, B0); PG8_MMA(0, 1, At, B1); PG8_BAR; PG8_SCHED; \
            PG8_LDA(At, 1, 1); PG8_STAGE(PG8_SB(1, 0), b3, voffB); PG8_STAGE(PG8_SB(1, 1), b3 + hstep, voffB); PG8_STAGE(PG8_SA(1, 0), a3, voffA); \
            PG8_WAIT_V(8); PG8_WAIT_L(0); PG8_BAR; PG8_MMA(1, 0, At, B0); PG8_MMA(1, 1, At, B1); PG8_BAR; PG8_SCHED; \
            } else { \
            PG8_LDB(B0, 0, 0); PG8_SCHED; PG8_LDA(At, 0, 0); PG8_STAGE(PG8_SA(1, 1), a1 + hstep, voffA); \
            PG8_WAIT_L(8); PG8_BAR; PG8_WAIT_L(0); PG8_MMA(0, 0, At, B0); PG8_BAR; PG8_SCHED; \
            PG8_LDB(B1, 0, 1); PG8_STAGE(PG8_SB(0, 0), b2, voffB); \
            PG8_BAR; PG8_WAIT_L(0); PG8_MMA(0, 1, At, B1); PG8_BAR; \
            PG8_LDA(At, 0, 1); PG8_STAGE(PG8_SA(0, 0), a2, voffA); \
            PG8_BAR; PG8_WAIT_L(0); PG8_MMA(1, 0, At, B0); PG8_BAR; PG8_SCHED; \
            PG8_STAGE(PG8_SB(0, 1), b2 + hstep, voffB); \
            PG8_WAIT_V(6); PG8_BAR; PG8_MMA(1, 1, At, B1); PG8_BAR; \
            PG8_LDB(B0, 1, 0); PG8_SCHED; PG8_LDA(At, 1, 0); PG8_STAGE(PG8_SA(0, 1), a2 + hstep, voffA); \
            PG8_WAIT_L(8); PG8_BAR; PG8_WAIT_L(0); PG8_MMA(0, 0, At, B0); PG8_BAR; PG8_SCHED; \
            PG8_LDB(B1, 1, 1); PG8_STAGE(PG8_SB(1, 0), b3, voffB); \
            PG8_BAR; PG8_WAIT_L(0); PG8_MMA(0, 1, At, B1); PG8_BAR; \
            PG8_LDA(At, 1, 1); PG8_STAGE(PG8_SA(1, 0), a3, voffA); \
            PG8_BAR; PG8_WAIT_L(0); PG8_MMA(1, 0, At, B0); PG8_BAR; PG8_SCHED; \
            PG8_STAGE(PG8_SB(1, 1), b3 + hstep, voffB); \
            PG8_WAIT_V(6); PG8_BAR; PG8_MMA(1, 1, At, B1); PG8_BAR; \
            } \
        }
        int t = 0;
        if constexpr (RELAX) {
#pragma unroll
            for (int a = 0; a < 2; ++a)
#pragma unroll
                for (int b = 0; b < 2; ++b)
#pragma unroll
                    for (int m = 0; m < 4; ++m) asm volatile("" : "+v"(acc[a][b][m][0]), "+v"(acc[a][b][m][1]));
        }
        if (RELAX && ui > 0) { PG8_ITER(true) t = 2; }
        for (; t < nt; t += 2) PG8_ITER(false)
#undef PG8_ITER
        if constexpr (ALIGN_EPI) { if (wr == 0) PG8_BAR; }
        if constexpr (RELAX) { PG8_STAGE(PG8_SA(1, 1), nA + kstep + hstep, voffA); PG8_SCHED; }
        if constexpr (!Epi::AFTER_DRAIN) { E(acc, cur, wr, wc, fr, fq); S.done(cur); }
        if (!has_next) break;
#pragma unroll
        for (int a = 0; a < 2; ++a)
#pragma unroll
            for (int b = 0; b < 2; ++b)
#pragma unroll
                for (int m = 0; m < 4; ++m)
#pragma unroll
                    for (int n = 0; n < 2; ++n) acc[a][b][m][n] = (f32x4){0.f, 0.f, 0.f, 0.f};
        cur = nxt; cA = nA; cB = nB; ++ui;
        if constexpr (ALIGN_EPI) { if (wr == 1) PG8_BAR; }
    }
    PG8_WAIT_V(0);
    if constexpr (!ALIGN_EPI) { if (wr == 0) PG8_BAR; }
    PG8_BAR;
    if constexpr (Epi::AFTER_DRAIN) { E.fused(acc, cur, wr, wc, fr, fq, lds, wid, lane); S.done(cur); }
#undef PG8_KOFF
#undef PG8_SA
#undef PG8_SB
#undef PG8_STAGE
#undef PG8_LDA
#undef PG8_LDB
#undef PG8_MMA
#undef PG8_WAIT_V
#undef PG8_WAIT_L
#undef PG8_BAR
#undef PG8_SCHED
}
}
#include <hip/hip_bf16.h>
#include <cmath>
#ifndef ATTN_MAP_OLD
#define ATTN_MAP_OLD 0
#endif
#ifndef ATTN_NOWAIT_PROBE
#define ATTN_NOWAIT_PROBE 0
#endif
#ifndef ATTN_TIMING
#define ATTN_TIMING 0
#endif
#ifndef ATTN_VD
#define ATTN_VD 4
#endif
#ifndef ATTN_DMA_EARLY
#define ATTN_DMA_EARLY 0
#endif
#ifndef ATTN_KRD_EARLY
#define ATTN_KRD_EARLY 1
#endif
#ifndef ATTN_TSET
#define ATTN_TSET 1
#endif
#ifndef ATTN_DMA_SPLIT
#define ATTN_DMA_SPLIT 0
#endif
#ifndef ATTN_PRIO
#define ATTN_PRIO 0
#endif
#ifndef ATTN_HEADROT
#define ATTN_HEADROT 0
#endif
#ifndef ATTN_HALF_PROBE
#define ATTN_HALF_PROBE 0
#endif
namespace attn128 {
using bf16=__hip_bfloat16;
using bf16x8=__attribute__((ext_vector_type(8)))short;
using s16x4=__attribute__((ext_vector_type(4)))short;
using f32x16=__attribute__((ext_vector_type(16)))float;
using u32x4=__attribute__((ext_vector_type(4)))unsigned;
constexpr int BATCH=8,NHEAD=16,SEQ=4096,D=64,DM=NHEAD*D;
constexpr int NW=8,QBLK=32,QB=QBLK*NW,KVBLK=64,NQB=SEQ/QB;
constexpr int ATTN_PITCH=DM, ATTN_UNIT_ROWS=QB;
__device__ __forceinline__ int crow(int r,int hi){return (r&3)+8*(r>>2)+4*hi;}
#define SBAR() __builtin_amdgcn_sched_barrier(0)
__device__ __forceinline__ void cmask(f32x16&p0,f32x16&p1,int jb,int wid){
  const float NEG=-INFINITY;
  if(jb>(wid>>1)){
  #pragma unroll
  for(int r=0;r<16;++r){p0[r]=NEG;p1[r]=NEG;} }
}

constexpr int NSLOT=3, SLOTB=8192, VD=ATTN_VD;
constexpr int LDS_K=0, LDS_V=NSLOT*SLOTB, LDS_WS=LDS_V+2*NSLOT*SLOTB, LDS_OST=LDS_WS+NW*64*4, LDS_BYTES=LDS_OST+NW*8192;
constexpr float C2=0.125f*1.4426950408889634f;
__device__ __forceinline__ void glds16(const void*gsrc,unsigned lds_dst){unsigned keep;
  asm volatile("s_mov_b32 %0, m0\n\ts_mov_b32 m0, %2\n\ts_nop 0\n\tglobal_load_lds_dwordx4 %1, off\n\ts_mov_b32 m0, %0":"=&s"(keep):"v"(gsrc),"s"(lds_dst):"memory");}
__device__ __forceinline__ float max3f(float a,float b,float c){float r;asm("v_max3_f32 %0, %1, %2, %3":"=v"(r):"v"(a),"v"(b),"v"(c));return r;}
__device__ __forceinline__ float max2f(float a,float b){float r;asm("v_max_f32_e32 %0, %1, %2":"=v"(r):"v"(a),"v"(b));return r;}
__device__ __forceinline__ float fadd_s(float a,float b){float r;asm("v_add_f32_e32 %0, %1, %2":"=v"(r):"v"(a),"v"(b));return r;}
__device__ __forceinline__ float fsub_s(float a,float b){float r;asm("v_sub_f32_e32 %0, %1, %2":"=v"(r):"v"(a),"v"(b));return r;}
typedef float f32x2_t __attribute__((ext_vector_type(2))); typedef __bf16 bf16x2_t __attribute__((ext_vector_type(2)));
__device__ __forceinline__ unsigned cvtpk_s(float lo,float hi){f32x2_t v={lo,hi};bf16x2_t b=__builtin_convertvector(v,bf16x2_t);return __builtin_bit_cast(unsigned,b);}
#define WAIT_BAR(N) asm volatile("s_waitcnt vmcnt(" #N ") lgkmcnt(0)\n\ts_barrier":::"memory")
#if ATTN_NOWAIT_PROBE
#define WAIT_BARX(N) do{ if(dbg_half){ asm volatile("s_waitcnt lgkmcnt(0)\n\ts_barrier":::"memory"); } else { WAIT_BAR(N); } }while(0)
#else
#if ATTN_TSET == 2
#define WAIT_BARX(N) do{ asm volatile("s_waitcnt vmcnt(" #N ") lgkmcnt(0)":::"memory"); TS(TS_WAIT); asm volatile("s_barrier":::"memory"); }while(0)
#else
#define WAIT_BARX(N) WAIT_BAR(N)
#endif
#endif

__device__ __forceinline__ void qkt(f32x16&p0,f32x16&p1,const char*Kslot,const bf16x8*qr,int r32,int hi){
  const char*kb=Kslot+hi*1024+r32*16; const f32x16 z=f32x16{};
  #pragma unroll
  for(int d0=0;d0<4;++d0){
    const bf16x8 b0=*reinterpret_cast<const bf16x8*>(kb+d0*2048);
    const bf16x8 b1=*reinterpret_cast<const bf16x8*>(kb+d0*2048+512);
    if(d0==0){p0=__builtin_amdgcn_mfma_f32_32x32x16_bf16(b0,qr[0],z,0,0,0);p1=__builtin_amdgcn_mfma_f32_32x32x16_bf16(b1,qr[0],z,0,0,0);}
    else{p0=__builtin_amdgcn_mfma_f32_32x32x16_bf16(b0,qr[d0],p0,0,0,0);p1=__builtin_amdgcn_mfma_f32_32x32x16_bf16(b1,qr[d0],p1,0,0,0);}}
}
typedef __attribute__((address_space(3))) const char* lds_cptr;
typedef short v4i16_t __attribute__((ext_vector_type(4)));
__device__ __forceinline__ void kload8(bf16x8*kf,lds_cptr kp){
  kf[0]=*(const __attribute__((address_space(3))) bf16x8*)(kp);      kf[1]=*(const __attribute__((address_space(3))) bf16x8*)(kp+512);
  kf[2]=*(const __attribute__((address_space(3))) bf16x8*)(kp+2048); kf[3]=*(const __attribute__((address_space(3))) bf16x8*)(kp+2560);
  kf[4]=*(const __attribute__((address_space(3))) bf16x8*)(kp+4096); kf[5]=*(const __attribute__((address_space(3))) bf16x8*)(kp+4608);
  kf[6]=*(const __attribute__((address_space(3))) bf16x8*)(kp+6144); kf[7]=*(const __attribute__((address_space(3))) bf16x8*)(kp+6656);
}
__device__ __forceinline__ void kload2(bf16x8*kf,lds_cptr kp,int j){ kf[2*j]=*(const __attribute__((address_space(3))) bf16x8*)(kp+j*2048); kf[2*j+1]=*(const __attribute__((address_space(3))) bf16x8*)(kp+j*2048+512); }
__device__ __forceinline__ s16x4 vtr(lds_cptr p){ return __builtin_bit_cast(s16x4,__builtin_amdgcn_ds_read_tr16_b64_v4i16((__attribute__((address_space(3))) v4i16_t*)p)); }
__device__ __forceinline__ float rowmax(const f32x16&p0,const f32x16&p1){
  float a=max3f(p0[0],p0[1],p1[0]),b=max3f(p0[2],p0[3],p1[1]);a=max3f(a,p1[2],p1[3]);
  #pragma unroll
  for(int r=4;r<16;r+=4){a=max3f(a,p0[r],p0[r+1]);b=max3f(b,p0[r+2],p0[r+3]);a=max3f(a,p1[r],p1[r+1]);b=max3f(b,p1[r+2],p1[r+3]);}
  const float m=max2f(a,b);
  auto rr=__builtin_amdgcn_permlane32_swap(__float_as_uint(m),__float_as_uint(m),false,false);
  return max2f(__uint_as_float(rr[0]),__uint_as_float(rr[1]));
}
__device__ __forceinline__ void pv(f32x16*o,int vb,bf16x8 pa0,bf16x8 pa1,bf16x8 pa2,bf16x8 pa3){
  #pragma unroll
  for(int d0=0;d0<4;++d0){s16x4 lo[4],hi[4];
    #pragma unroll
    for(int ks=0;ks<4;++ks){
      asm volatile("ds_read_b64_tr_b16 %0,%1 offset:%c2":"=&v"(lo[ks]):"v"(vb),"i"(d0*4096+ks*1024):"memory");
      asm volatile("ds_read_b64_tr_b16 %0,%1 offset:%c2":"=&v"(hi[ks]):"v"(vb),"i"(d0*4096+ks*1024+512):"memory");}
    asm volatile("s_waitcnt lgkmcnt(0)":::"memory");SBAR();
    #define PK(k) (bf16x8){lo[k][0],lo[k][1],lo[k][2],lo[k][3],hi[k][0],hi[k][1],hi[k][2],hi[k][3]}
    o[d0]=__builtin_amdgcn_mfma_f32_32x32x16_bf16(pa0,PK(0),o[d0],0,0,0);
    o[d0]=__builtin_amdgcn_mfma_f32_32x32x16_bf16(pa1,PK(1),o[d0],0,0,0);
    o[d0]=__builtin_amdgcn_mfma_f32_32x32x16_bf16(pa2,PK(2),o[d0],0,0,0);
    o[d0]=__builtin_amdgcn_mfma_f32_32x32x16_bf16(pa3,PK(3),o[d0],0,0,0);
    #undef PK
  }
}

#ifndef ATTN_STORE16
#define ATTN_STORE16(p,v) (*(u32x4*)(p)=(v))
#endif
template<int THRL> __device__ __forceinline__ void attn_unit(int b,int head,int qb,const bf16*Q,const bf16*__restrict__ K,const bf16*__restrict__ V,bf16*YA,char*shm,const float lam,const float*gsub,const int wid_in,const bool dbg_half,unsigned&tac0,unsigned&tac1,unsigned&tac2,unsigned&tac3){
  int wid=wid_in; asm volatile("":"+s"(wid));
  int lane; asm volatile("v_mbcnt_lo_u32_b32 %0, -1, 0\n\tv_mbcnt_hi_u32_b32 %0, -1, %0":"=v"(lane));
  const int r32=lane&31,hi=lane>>5;
#if ATTN_TIMING && ATTN_TSET == 3
  const unsigned tunit0_=(unsigned)__builtin_amdgcn_s_memtime();
#endif
  const long rowbase=(long)b*SEQ; const int q0=qb*QB;
  const bf16*Qw=Q+(rowbase+q0+wid*QBLK)*DM+head*D;
  const bf16*Kh=K+rowbase*DM+head*D,*Vh=V+rowbase*DM+head*128;
  const unsigned lds0=(unsigned)(uintptr_t)shm;
  float*wsf=(float*)(shm+LDS_WS)+wid*64;
  const bf16*ksrc=Kh+(long)lane*DM+wid*8;
  const bf16*vsrc=Vh+(long)(16*(wid&3)+(lane>>2))*DM+(wid>>2)*32+(lane&3)*8;
  const unsigned kdst=lds0+LDS_K+wid*1024, vdst=lds0+LDS_V+wid*1024;
  #define KOFS(t) (((t)<NT)?(long)(t)*KVBLK*DM:(long)((t)-NT)*KVBLK*DM+512)
  #define VOFS(t) ((long)(((t)<NT)?(t):(t)-NT)*KVBLK*DM)
  #define DMA_K(t,slot) glds16(ksrc+KOFS(t),(unsigned)__builtin_amdgcn_readfirstlane(kdst+(slot)))
  #define DMA_V0(t,slot) glds16(vsrc+VOFS(t),(unsigned)__builtin_amdgcn_readfirstlane(vdst+2*(slot)))
  #define DMA_V1(t,slot) glds16(vsrc+VOFS(t)+64,(unsigned)__builtin_amdgcn_readfirstlane(vdst+2*(slot)+8192))
  #define DMA_V(t,slot) do{ glds16(vsrc+VOFS(t),(unsigned)__builtin_amdgcn_readfirstlane(vdst+2*(slot))); glds16(vsrc+VOFS(t)+64,(unsigned)__builtin_amdgcn_readfirstlane(vdst+2*(slot)+8192)); }while(0)
  const char*Kbase=shm+LDS_K; bf16x8 kf[8];
  const lds_cptr shm3=(lds_cptr)shm; const lds_cptr kp0=shm3+LDS_K+hi*1024+r32*16; const lds_cptr vp0=shm3+LDS_V+((lane>>4)&1)*32+(lane&3)*8+(4*hi+((lane&15)>>2))*64;
  const int NT=(q0+QB)/KVBLK;
  DMA_K(0,0);DMA_V(0,0);DMA_K(1,SLOTB);
  bf16x8 qr[4];
  #pragma unroll
  for(int d0=0;d0<4;++d0)qr[d0]=*reinterpret_cast<const bf16x8*>(&Qw[(long)r32*DM+d0*16+hi*8]);
  float mhat=0.f,l_reg=0.f;f32x16 o[4];o[0]=f32x16{};o[1]=f32x16{};o[2]=f32x16{};o[3]=f32x16{};

  int mbase=NT-4; float lsave=0.f; const int N2=2*NT;
  #define CMASK(P0,P1,t) do{int jb_=(t)-mbase; if(jb_>=0&&jb_<4)cmask(P0,P1,jb_,wid);}while(0)
  bool resc=false;
  #define START(P0,P1) do{ const float rm=rowmax(P0,P1); resc=false; mhat=rm; \
    _Pragma("unroll") for(int r=0;r<16;++r)P0[r]=__builtin_amdgcn_exp2f(P0[r]-mhat); }while(0)
  #define RESC() do{ if(resc){ asm volatile("s_waitcnt lgkmcnt(0)":::"memory"); \
      _Pragma("unroll") for(int d_=0;d_<4;++d_) _Pragma("unroll") for(int r=0;r<16;++r)o[d_][r]*=wsf[crow(r,hi)]; } }while(0)
  f32x16 pA0,pA1,pB0,pB1;
  int sl_prev=0,sl_cur=0,sl_next=SLOTB;
  #define ROT() do{sl_prev=sl_cur;sl_cur=sl_next;sl_next=(sl_next==(NSLOT-1)*SLOTB)?0:sl_next+SLOTB;}while(0)
  DMA_K(2,2*SLOTB);
  WAIT_BAR(3);
  qkt(pA0,pA1,Kbase,qr,r32,hi);asm volatile("s_nop 15\n\ts_nop 7":"+v"(pA0),"+v"(pA1));CMASK(pA0,pA1,0);
  START(pA0,pA1);
  _Pragma("unroll") for(int r=0;r<16;++r)pA1[r]=__builtin_amdgcn_exp2f(pA1[r]-mhat);
  WAIT_BAR(0);
  DMA_K(3,0);DMA_V(1,SLOTB);
  ROT();
  kload8(kf,kp0+sl_cur);
  WAIT_BAR(3);
  s16x4 vlo[VD],vhi[VD]; u32x4 pw0,pw1,pw2,pw3;
  #define PKW(P,B) cvtpk_s(P[B],P[B+1])
  #define PAF(k) __builtin_bit_cast(bf16x8,pw##k)
  #define VFR(i) (bf16x8){vlo[i][0],vlo[i][1],vlo[i][2],vlo[i][3],vhi[i][0],vhi[i][1],vhi[i][2],vhi[i][3]}
  #define PIN(x) asm volatile("":"+v"(x))
  #define MX3(a,b,c) __builtin_fmaxf(__builtin_fmaxf((a),(b)),(c))
  #define GAPA(MF,A0,A1,A2,A3,W0,W1,PW) do{ if(QKON){ MF; } if(PVON){ sacc+=A0; sacc+=A1; sacc+=A2; sacc+=A3; PIN(sacc); W0; W1; PIN(PW); } SBAR(); }while(0)
  #define EX(v) __builtin_amdgcn_exp2f((v)-mhat)
  #define VOFF(j) ((((j)&3)*4096)+(((j)>>2)*1024))
  #define VRDS(j) do{ if(PVON){ vlo[(j)%VD]=vtr(vp_+VOFF(j)); vhi[(j)%VD]=vtr(vp_+VOFF(j)+512); } }while(0)
  #define VRDA(j) do{ if((j)<VD){ VRDS(j); } }while(0)
  #define VRDB(j) do{ if((j)+VD<16){ VRDS((j)+VD); } }while(0)
  #define GAPB(j,X,B,RD) do{ if(PVON){ o[(j)&3]=__builtin_amdgcn_mfma_f32_32x32x16_bf16(PAF_SEL(j),VFR((j)%VD),o[(j)&3],0,0,0); } if(QKON){ X[B]=EX(X[B]); X[B+1]=EX(X[B+1]); PIN(X); } RD; SBAR(); }while(0)
  #define PAF_SEL(j) (((j)>>2)==0?PAF(0):((j)>>2)==1?PAF(1):((j)>>2)==2?PAF(2):PAF(3))
  #define KRD(G,j) do{ if(G){ kload2(kf,kp0+sl_next,j); } }while(0)
  #define KRDE(G,j) do{ if(ATTN_KRD_EARLY){ KRD(G,j); } }while(0)
  #define KRDL(G,j) do{ if(!ATTN_KRD_EARLY){ KRD(G,j); } }while(0)
  #define STEP(C0,C1,P0,P1,t,GK,GV,GL,PRE,SW,QK_,PV_) do{ SBAR(); TS(TS_START); \
    const bool QKON=(QK_) ATTN_LIVE, PVON=(PV_) ATTN_LIVE;     \
    const lds_cptr vp_=vp0+2*sl_prev; const f32x16 zc_=f32x16{}; \
    float sacc=(P0[0]+P0[1]); \
    GAPA(C0=__builtin_amdgcn_mfma_f32_32x32x16_bf16(kf[0],qr[0],zc_,0,0,0), P0[2],P0[3],P0[4],P0[5],     pw0[0]=PKW(P0,0), pw0[1]=PKW(P0,2), pw0); \
    if(ATTN_DMA_EARLY){ if(GK){DMA_K((t)+3,sl_cur);} SBAR(); }     \
    GAPA(C1=__builtin_amdgcn_mfma_f32_32x32x16_bf16(kf[1],qr[0],zc_,0,0,0), P0[6],P0[7],P0[8],P0[9],     pw0[2]=PKW(P0,4), pw0[3]=PKW(P0,6), pw0); \
    if(ATTN_DMA_EARLY){ if(GV){DMA_V0((t)+1,sl_next);} SBAR(); } \
    GAPA(C0=__builtin_amdgcn_mfma_f32_32x32x16_bf16(kf[2],qr[1],C0,0,0,0),   P0[10],P0[11],P0[12],P0[13], pw1[0]=PKW(P0,8), pw1[1]=PKW(P0,10), pw1); \
    if(ATTN_DMA_EARLY){ if(GV){DMA_V1((t)+1,sl_next);} SBAR(); } \
    GAPA(C1=__builtin_amdgcn_mfma_f32_32x32x16_bf16(kf[3],qr[1],C1,0,0,0),   P0[14],P0[15],P1[0],P1[1],   pw1[2]=PKW(P0,12),pw1[3]=PKW(P0,14), pw1); \
    VRDS(0); VRDA(4); SBAR(); GAPA(C0=__builtin_amdgcn_mfma_f32_32x32x16_bf16(kf[4],qr[2],C0,0,0,0),   P1[2],P1[3],P1[4],P1[5],     pw2[0]=PKW(P1,0), pw2[1]=PKW(P1,2), pw2); \
    VRDS(1); VRDA(5); SBAR(); GAPA(C1=__builtin_amdgcn_mfma_f32_32x32x16_bf16(kf[5],qr[2],C1,0,0,0),   P1[6],P1[7],P1[8],P1[9],     pw2[2]=PKW(P1,4), pw2[3]=PKW(P1,6), pw2); \
    VRDS(2); VRDA(6); SBAR(); GAPA(C0=__builtin_amdgcn_mfma_f32_32x32x16_bf16(kf[6],qr[3],C0,0,0,0),   P1[10],P1[11],P1[12],P1[13], pw3[0]=PKW(P1,8), pw3[1]=PKW(P1,10), pw3); \
    VRDS(3); VRDA(7); SBAR(); GAPA(C1=__builtin_amdgcn_mfma_f32_32x32x16_bf16(kf[7],qr[3],C1,0,0,0),   P1[14],P1[15],0.f,0.f,       pw3[2]=PKW(P1,12),pw3[3]=PKW(P1,14), pw3); \
    if(PVON){ l_reg+=sacc; } TS(TS_ENDA); \
    PRE; \
    if(!ATTN_DMA_EARLY && !(ATTN_DMA_SPLIT && wid>=4)){ if(GK){DMA_K((t)+3,sl_cur);} if(GV){DMA_V((t)+1,sl_next);} } TSDMA(); \
    resc=false; \
    if(QKON){ float a=MX3(C0[0],C0[1],C1[0]),b=MX3(C0[2],C0[3],C1[1]); a=MX3(a,C1[2],C1[3]); \
      _Pragma("unroll") for(int r=4;r<16;r+=4){a=MX3(a,C0[r],C0[r+1]);b=MX3(b,C0[r+2],C0[r+3]);a=MX3(a,C1[r],C1[r+1]);b=MX3(b,C1[r+2],C1[r+3]);} \
      float rm=__builtin_fmaxf(a,b); { auto rr=__builtin_amdgcn_permlane32_swap(__float_as_uint(rm),__float_as_uint(rm),false,false); rm=__builtin_fmaxf(__uint_as_float(rr[0]),__uint_as_float(rr[1])); } \
      if(SW){ lsave=l_reg; l_reg=0.f; mhat=rm; }     \
      else{ const float rmr=rm-mhat; \
      if(__builtin_expect(__any(rmr>(float)THRL),0)){ const float dl=__builtin_fmaxf(rmr,0.f); mhat+=dl; \
        const float f=__builtin_amdgcn_exp2f(-dl); l_reg*=f; { int l2_=lane; asm volatile("":"+v"(l2_)); if((l2_>>5)==0)wsf[l2_&31]=f; } resc=true; } } } \
    TS(TS_MAX); SBAR(); \
    GAPB(0, C0,0,  VRDB(0)); \
    GAPB(1, C0,2,  VRDB(1)); \
    GAPB(2, C0,4,  VRDB(2)); \
    GAPB(3, C0,6,  VRDB(3)); \
    GAPB(4, C0,8,  VRDB(4)); \
    GAPB(5, C0,10,  VRDB(5)); \
    GAPB(6, C0,12,  VRDB(6)); \
    GAPB(7, C0,14,  VRDB(7)); \
    if(!ATTN_DMA_EARLY && ATTN_DMA_SPLIT && wid>=4){ if(GK){DMA_K((t)+3,sl_cur);} if(GV){DMA_V((t)+1,sl_next);} SBAR(); }     \
    GAPB(8, C1,0,  VRDB(8);  KRDE(GL,0)); \
    GAPB(9, C1,2,  VRDB(9);  KRDE(GL,1)); \
    GAPB(10, C1,4,  VRDB(10); KRDE(GL,2)); \
    GAPB(11, C1,6,  VRDB(11); KRDE(GL,3)); \
    GAPB(12,C1,8,  KRDL(GL,0)); \
    GAPB(13,C1,10, KRDL(GL,1)); \
    GAPB(14,C1,12, KRDL(GL,2)); \
    GAPB(15,C1,14, KRDL(GL,3)); \
    TS(TS_ENDB); }while(0)
#if ATTN_TIMING
  unsigned tprev=(unsigned)__builtin_amdgcn_s_memtime();
#if ATTN_TSET == 3
  tac0+=tprev-tunit0_;
#endif
  #define TS(a_) do{ const unsigned now_=(unsigned)__builtin_amdgcn_s_memtime(); a_+=now_-tprev; tprev=now_; }while(0)
#else
  #define TS(a_) do{}while(0)
#endif
  unsigned tdum=0u; (void)tdum;
#if ATTN_TSET == 3
  #define TS_START tac2
  #define TS_ENDA tac2
  #define TSDMA() do{}while(0)
  #define TS_MAX tac2
  #define TS_ENDB tac2
  #define TS_WAIT tdum
#elif ATTN_TSET == 2
  #define TS_START tac3
  #define TS_ENDA tdum
  #define TSDMA() TS(tac0)
  #define TS_MAX tac1
  #define TS_ENDB tdum
  #define TS_WAIT tac2
#else
  #define TS_START tac3
  #define TS_ENDA tac0
  #define TSDMA() do{}while(0)
  #define TS_MAX tac1
  #define TS_ENDB tac2
  #define TS_WAIT tdum
#endif
  if(ATTN_PRIO==1 && wid>=4) __builtin_amdgcn_s_setprio(1);
  int t=1; const int wch=wid>>1;
#if ATTN_HALF_PROBE
  const bool live_=!(dbg_half&&wid>=ATTN_HALF_PROBE);
  #define ATTN_LIVE &&live_
#else
  #define ATTN_LIVE
#endif
  #define QKV(t) true
  #define PVV(t) true
  #define QPRE(tt) do{ int l3_=lane; asm volatile("":"+v"(l3_)); _Pragma("unroll") for(int d0=0;d0<4;++d0)qr[d0]=*reinterpret_cast<const bf16x8*>(&Qw[(long)(l3_&31)*DM+512+d0*16+(l3_>>5)*8]); }while(0)
  #define MAP0_FIN() do{ float lt_=lsave; {auto rr=__builtin_amdgcn_permlane32_swap(__float_as_uint(lt_),__float_as_uint(lt_),false,false);lt_=__uint_as_float(rr[0])+__uint_as_float(rr[1]);} \
      { int l2_=lane; asm volatile("":"+v"(l2_)); if((l2_>>5)==0)wsf[32+(l2_&31)]=lt_; } asm volatile("s_waitcnt lgkmcnt(0)":::"memory"); \
      bf16*stg_=(bf16*)(shm+LDS_OST)+wid*4096; \
      _Pragma("unroll") for(int r=0;r<16;++r){ const int orow=crow(r,hi); const float rl_=__builtin_amdgcn_rcpf(wsf[32+orow]); \
        _Pragma("unroll") for(int d0=0;d0<4;++d0){ stg_[orow*128+d0*32+r32]=__float2bfloat16(o[d0][r]*rl_); } } \
      o[0]=f32x16{};o[1]=f32x16{};o[2]=f32x16{};o[3]=f32x16{}; }while(0)
  #undef QKV
  #undef PVV
  #define QKV(t) true
  #define PVV(t) true
  for(;t+5<NT;t+=2){
    STEP(pB0,pB1,pA0,pA1,t,true,true,true,,0,QKV(t),PVV(t));     WAIT_BARX(3); RESC(); ROT();
    STEP(pA0,pA1,pB0,pB1,t+1,true,true,true,,0,QKV(t+1),PVV(t+1));   WAIT_BARX(3); RESC(); ROT();
  }
  #undef QKV
  #undef PVV
  #define QKV(t) (((t)-mbase)<=wch)
  #define PVV(t) (((t)-mbase-1)<=wch)
  for(;t+1<NT;t+=2){
    STEP(pB0,pB1,pA0,pA1,t,true,true,true,,0,QKV(t),PVV(t));     WAIT_BARX(3); RESC(); ROT();
    STEP(pA0,pA1,pB0,pB1,t+1,true,true,true,,0,QKV(t+1),PVV(t+1));   WAIT_BARX(3); RESC(); ROT();
  }
  STEP(pB0,pB1,pA0,pA1,t,true,true,true,QPRE(t),0,QKV(t),PVV(t));  WAIT_BARX(3); RESC(); ROT();
  STEP(pA0,pA1,pB0,pB1,t+1,true,true,true,,1,true,(wch==3));       WAIT_BAR(3); MAP0_FIN(); ROT();
  t+=2;
  mbase=N2-4;
  #undef QKV
  #undef PVV
  #define QKV(t) true
  #define PVV(t) true
  for(;t+5<N2;t+=2){
    STEP(pB0,pB1,pA0,pA1,t,true,true,true,,0,QKV(t),PVV(t));     WAIT_BARX(3); RESC(); ROT();
    STEP(pA0,pA1,pB0,pB1,t+1,true,true,true,,0,QKV(t+1),PVV(t+1));   WAIT_BARX(3); RESC(); ROT();
  }
  #undef QKV
  #undef PVV
  #define QKV(t) (((t)-mbase)<=wch)
  #define PVV(t) (((t)-mbase-1)<=wch)
  #define ENDW(tt) do{ if((tt)+3<N2){WAIT_BAR(3);} else if((tt)+2<N2){WAIT_BAR(2);} else {WAIT_BAR(0);} }while(0)
  for(;t+1<N2;t+=2){
    STEP(pB0,pB1,pA0,pA1,t,(t+3<N2),(t+1<N2),(t+1<N2),,0,QKV(t),PVV(t));       ENDW(t);   RESC(); ROT();
    STEP(pA0,pA1,pB0,pB1,t+1,(t+4<N2),(t+2<N2),(t+2<N2),,0,QKV(t+1),PVV(t+1));     ENDW(t+1); RESC(); ROT();
  }
  STEP(pB0,pB1,pA0,pA1,N2-1,false,false,false,,0,QKV(N2-1),PVV(N2-1)); RESC();
  if(ATTN_PRIO==1) __builtin_amdgcn_s_setprio(0);
  if(wch==3){ float sacc=pB0[0]+pB0[1]; _Pragma("unroll") for(int r=2;r<16;++r)sacc+=pB0[r]; _Pragma("unroll") for(int r=0;r<16;++r)sacc+=pB1[r]; l_reg+=sacc;
    pw0=(u32x4){PKW(pB0,0),PKW(pB0,2),PKW(pB0,4),PKW(pB0,6)};pw1=(u32x4){PKW(pB0,8),PKW(pB0,10),PKW(pB0,12),PKW(pB0,14)};pw2=(u32x4){PKW(pB1,0),PKW(pB1,2),PKW(pB1,4),PKW(pB1,6)};pw3=(u32x4){PKW(pB1,8),PKW(pB1,10),PKW(pB1,12),PKW(pB1,14)};
    SBAR();
    int ln_=lane; asm volatile("":"+v"(ln_));
    const int vb0=(int)(lds0+LDS_V)+((ln_>>4)&1)*32+(ln_&3)*8+(4*(ln_>>5)+((ln_&15)>>2))*64;
    pv(o,vb0+2*sl_cur,PAF(0),PAF(1),PAF(2),PAF(3)); }
  #undef PKW
  #undef PAF
  #undef VFR
  #undef PIN
  #undef MX3
  #undef GAPA
  #undef GAPB
  #undef EX
  #undef VRDS
  #undef VOFF
  #undef PAF_SEL
  #undef VRDA
  #undef VRDB
  #undef TS
  #undef ATTN_LIVE
  #undef QKV
  #undef PVV
  #undef KRD
  #undef KRDE
  #undef KRDL
  #undef STEP
  #undef QPRE
  #undef MAP0_FIN
  #undef ENDW
  {auto rr=__builtin_amdgcn_permlane32_swap(__float_as_uint(l_reg),__float_as_uint(l_reg),false,false);l_reg=__uint_as_float(rr[0])+__uint_as_float(rr[1]);}
  { int l2_=lane; asm volatile("":"+v"(l2_)); if((l2_>>5)==0)wsf[32+(l2_&31)]=l_reg; } asm volatile("s_waitcnt lgkmcnt(0)":::"memory");
  float rli[16];
  #pragma unroll
  for(int r=0;r<16;++r)rli[r]=__builtin_amdgcn_rcpf(wsf[32+crow(r,hi)]);
  { bf16*stg=(bf16*)(shm+LDS_OST)+wid*4096;
    if(false){
      #pragma unroll
      for(int r=0;r<16;++r){const int orow=crow(r,hi);
        #pragma unroll
        for(int d0=0;d0<4;++d0)stg[orow*128+d0*32+r32]=__float2bfloat16(o[d0][r]*rli[r]);}
    } else {
      #pragma unroll
      for(int r=0;r<16;++r){const int orow=crow(r,hi);
        #pragma unroll
        for(int d0=0;d0<4;++d0){const float prev=__bfloat162float(stg[orow*128+d0*32+r32]); stg[orow*128+d0*32+r32]=__float2bfloat16(prev-lam*(o[d0][r]*rli[r]));}}
    }
    asm volatile("s_waitcnt lgkmcnt(0)":::"memory");
    {
      int le_=lane; asm volatile("":"+v"(le_));
      const int ch=le_&7;
      float ga[8],gb[8];
      #pragma unroll
      for(int j=0;j<8;++j){ga[j]=gsub[ch*8+j];gb[j]=gsub[64+ch*8+j];}
      bf16*Yw=YA+(rowbase+q0+wid*QBLK)*DM+head*128;
      #pragma unroll
      for(int i=0;i<4;++i){const int row=i*8+(le_>>3);
        const u32x4 va=*(const u32x4*)(stg+row*128+ch*8),vb=*(const u32x4*)(stg+row*128+64+ch*8);
        float a[8],bb[8];
        #pragma unroll
        for(int j=0;j<4;++j){a[2*j]=__uint_as_float(va[j]<<16);a[2*j+1]=__uint_as_float(va[j]&0xffff0000u);bb[2*j]=__uint_as_float(vb[j]<<16);bb[2*j+1]=__uint_as_float(vb[j]&0xffff0000u);}
        float ss=0.f;
        #pragma unroll
        for(int j=0;j<8;++j)ss+=a[j]*a[j]+bb[j]*bb[j];
        ss+=__builtin_bit_cast(float,__builtin_amdgcn_update_dpp(0,__builtin_bit_cast(int,ss),0xB1,0xf,0xf,false));
        ss+=__builtin_bit_cast(float,__builtin_amdgcn_update_dpp(0,__builtin_bit_cast(int,ss),0x4E,0xf,0xf,false));
        ss+=__builtin_bit_cast(float,__builtin_amdgcn_update_dpp(0,__builtin_bit_cast(int,ss),0x141,0xf,0xf,false));
        const float rn=1.0f/sqrtf(ss*(1.f/128.f)+1e-6f);
        u32x4 oa,ob;
        #pragma unroll
        for(int j=0;j<4;++j){oa[j]=cvtpk_s(a[2*j]*rn*ga[2*j],a[2*j+1]*rn*ga[2*j+1]);ob[j]=cvtpk_s(bb[2*j]*rn*gb[2*j],bb[2*j+1]*rn*gb[2*j+1]);}
        ATTN_STORE16(Yw+(long)row*DM+ch*8,oa);ATTN_STORE16(Yw+(long)row*DM+64+ch*8,ob);}
    } }
  asm volatile("s_waitcnt lgkmcnt(0)\n\ts_barrier":::"memory");
#if ATTN_TIMING && ATTN_TSET == 3
  { asm volatile("s_waitcnt vmcnt(0)":::"memory"); const unsigned now_=(unsigned)__builtin_amdgcn_s_memtime(); tac1+=now_-tprev; }
#endif
  #undef KOFS
  #undef VOFS
  #undef DMA_K
  #undef DMA_V
  #undef DMA_V0
  #undef DMA_V1
  #undef CMASK
  #undef START
  #undef RESC
  #undef ROT
}
constexpr int ATTN_LDS_BYTES=LDS_BYTES;
struct AttnTensors { const bf16* Q; const bf16* K; const bf16* V; bf16* YA; const float* gsub; float lam; int dbg_qb; };
template<int THRL=8> __device__ __forceinline__ unsigned attn_phase(char*lds,const AttnTensors&T,int grid,int block,const int wid){
  unsigned tac0=0u,tac1=0u,tac2=0u,tac3=0u;
  const int vcu=(grid%8==0)?(block%8)*(grid/8)+block/8:block;
  for(int it=vcu;it<256;it+=grid){
    const int b=it>>5,j=it&31,hsel=j>>4,qi=j&15,qj=(qi+8)&15;
    for(int k=0;k<4;++k){
#if ATTN_MAP_OLD
      const int s=it&3,head=(it>>2)&7; const int qb=(T.dbg_qb>=0)?T.dbg_qb:((k==0)?15-s:(k==1)?8+s:(k==2)?7-s:s);
#else
      const int head=2*((k+(ATTN_HEADROT?b:0))&3)+hsel;
      const int qb=(T.dbg_qb>=0)?T.dbg_qb:((k==0)?qi:(k==1)?15-qi:(k==2)?qj:15-qj);
#endif
      attn_unit<THRL>(b,head,qb,T.Q,T.K,T.V,T.YA,lds,T.lam,T.gsub,wid,T.dbg_qb==-2,tac0,tac1,tac2,tac3);
    }
  }
  return (ATTN_TIMING==1)?tac0:(ATTN_TIMING==2)?tac1:(ATTN_TIMING==3)?tac2:(ATTN_TIMING==4)?tac3:(tac0+tac1+tac2+tac3)*0u;
}
#undef SBAR
#undef WAIT_BAR
#undef WAIT_BARX
}
#define GAS __attribute__((address_space(1)))
#define LAS __attribute__((address_space(3)))
typedef unsigned short bf16;
typedef unsigned v4u __attribute__((ext_vector_type(4)));
typedef unsigned v2u __attribute__((ext_vector_type(2)));
typedef float f32x4 __attribute__((ext_vector_type(4)));
typedef float f32x2 __attribute__((ext_vector_type(2)));
typedef short bf16x8 __attribute__((ext_vector_type(8)));
typedef __bf16 bf16x2_t __attribute__((ext_vector_type(2)));

constexpr int NWAVES = 8, NTHR = NWAVES * 64;
constexpr int LDS_MISC = 147456 - 64;
constexpr int T_ = 32768, D_ = 1024, S_ = 4096, NB_ = 8, DIN_ = 7168, NEXP_ = 16384;
constexpr float EPS_ = 1e-6f;
constexpr float C2_ = 0.125f * 1.4426950408889634f;
constexpr float LAM_INIT_ = 0.2f;

constexpr size_t MiB = 1u << 20;
constexpr size_t WS_CTL = 0;
constexpr size_t WS_WIN = 2 * MiB;
constexpr size_t WS_WA = 16 * MiB;
constexpr size_t WS_WB = 18 * MiB;
constexpr size_t WS_WO = 20 * MiB;
constexpr size_t WS_WQS = 22 * MiB;
constexpr size_t WS_SGW = 26 * MiB;
constexpr size_t WS_GSUB = 27 * MiB;
constexpr size_t WS_UT = 28 * MiB;
constexpr size_t WS_VT = 60 * MiB;
constexpr size_t WS_XN = 96 * MiB;
constexpr size_t WS_Q = 160 * MiB;
constexpr size_t WS_K = 224 * MiB;
constexpr size_t WS_V = 288 * MiB;
constexpr size_t WS_SU = 352 * MiB;
constexpr size_t WS_SV = 416 * MiB;
constexpr size_t WS_SC = 160 * MiB;
constexpr size_t WS_END = 480 * MiB;

__device__ __forceinline__ unsigned f2bf(float f) { unsigned u = __builtin_bit_cast(unsigned, f); return (u + 0x7fffu + ((u >> 16) & 1u)) >> 16; }
__device__ __forceinline__ unsigned pk2(float lo, float hi) { f32x2 v = {lo, hi}; return __builtin_bit_cast(unsigned, __builtin_convertvector(v, bf16x2_t)); }
__device__ __forceinline__ float bflo(unsigned u) { return __builtin_bit_cast(float, u << 16); }
__device__ __forceinline__ float bfhi(unsigned u) { return __builtin_bit_cast(float, u & 0xffff0000u); }
__device__ __forceinline__ float bf2f(bf16 h) { return __builtin_bit_cast(float, (unsigned)h << 16); }
#define WDPP_F(x_, ctrl_) __builtin_bit_cast(float, __builtin_amdgcn_update_dpp(0, __builtin_bit_cast(int, (x_)), (ctrl_), 0xf, 0xf, false))
__device__ __forceinline__ float wave_sum(float v) {
    v += WDPP_F(v, 0xB1); v += WDPP_F(v, 0x4E); v += WDPP_F(v, 0x141); v += WDPP_F(v, 0x140);
    { auto r = __builtin_amdgcn_permlane16_swap(__float_as_uint(v), __float_as_uint(v), false, false); v = __uint_as_float(r[0]) + __uint_as_float(r[1]); }
    { auto r = __builtin_amdgcn_permlane32_swap(__float_as_uint(v), __float_as_uint(v), false, false); v = __uint_as_float(r[0]) + __uint_as_float(r[1]); }
    return v;
}
__device__ __forceinline__ float wave_max(float v) {
    v = fmaxf(v, WDPP_F(v, 0xB1)); v = fmaxf(v, WDPP_F(v, 0x4E)); v = fmaxf(v, WDPP_F(v, 0x141)); v = fmaxf(v, WDPP_F(v, 0x140));
    { auto r = __builtin_amdgcn_permlane16_swap(__float_as_uint(v), __float_as_uint(v), false, false); v = fmaxf(__uint_as_float(r[0]), __uint_as_float(r[1])); }
    { auto r = __builtin_amdgcn_permlane32_swap(__float_as_uint(v), __float_as_uint(v), false, false); v = fmaxf(__uint_as_float(r[0]), __uint_as_float(r[1])); }
    return v;
}
#define XB_TMO      128
#define XB_XCNT(j)  (256  + 64 * (j))
#define XB_XSUB(j)  (1280 + 64 * (j))
#define XB_XGEN(j)  (2304 + 64 * (j))
#define XB_TOP      3328
#define XB_TOPGEN   3392
#define XCD_BAR_WORDS 3456
#define XB_SPIN_CAP (1u << 22)

__device__ __forceinline__ unsigned xb_ld(unsigned* p)              { return __hip_atomic_load(p, __ATOMIC_RELAXED, __HIP_MEMORY_SCOPE_AGENT); }
__device__ __forceinline__ unsigned xb_add(unsigned* p, unsigned v) { return __hip_atomic_fetch_add(p, v, __ATOMIC_RELAXED, __HIP_MEMORY_SCOPE_AGENT); }
__device__ __forceinline__ unsigned xb_xcc_id() { return (unsigned)__builtin_amdgcn_s_getreg((3 << 11) | 20) & 0xFu; }
#define XB_SPIN(cond, bar) do { unsigned _sp = 0; while (cond) { __builtin_amdgcn_s_sleep(1); \
    if ((++_sp & 255u) == 0u) { if (xb_ld(&(bar)[XB_TMO])) break; if (_sp > XB_SPIN_CAP) { atomicAdd(&(bar)[XB_TMO], 1u); break; } } } } while (0)

struct XcdBarrier {
    unsigned* bar; unsigned x;
    volatile LAS unsigned* st;
};

__device__ __forceinline__ XcdBarrier xcd_barrier_post(unsigned* bar, volatile LAS unsigned* st, const int tid) {
    XcdBarrier b; b.bar = bar; b.x = xb_xcc_id(); b.st = st;
    if (tid == 0) st[3] = 1u + xb_add(&bar[XB_XCNT(b.x)], 1u);
    return b;
}
__device__ __forceinline__ void xcd_barrier_complete(unsigned* bar, unsigned x, unsigned& nloc, unsigned& nx, unsigned& uni) {
    const unsigned G = gridDim.x * gridDim.y * gridDim.z;
    unsigned sum, cnt, mine, sp = 0u;
    for (;;) {
        sum = 0u; cnt = 0u; mine = 0u; uni = 1u;
#pragma unroll
        for (unsigned j = 0; j < 16; ++j) { const unsigned c = xb_ld(&bar[XB_XCNT(j)]); sum += c; cnt += (c > 0u) ? 1u : 0u; mine = (j == x) ? c : mine;
            if (c != ((j < 8u && (G & 7u) == 0u) ? G / 8u : 0u)) uni = 2u; }
        if (sum == G) break;
        __builtin_amdgcn_s_sleep(1);
        if ((++sp & 255u) == 0u) { if (xb_ld(&bar[XB_TMO])) break; if (sp > XB_SPIN_CAP) { atomicAdd(&bar[XB_TMO], 1u); break; } }
    }
    nloc = mine > 0u ? mine : 1u; nx = cnt > 0u ? cnt : 1u; if (sum != G) uni = 2u;
}

__device__ __forceinline__ void xcd_barrier(const XcdBarrier& b, const int tid) {
    asm volatile("s_waitcnt vmcnt(0)" ::: "memory");
    __syncthreads();
    if (tid == 0) {
        unsigned* bar = b.bar;
        __builtin_amdgcn_s_waitcnt(0);
        unsigned nloc = b.st[0], nx = b.st[1];
        if (nloc == 0u) { unsigned uni; xcd_barrier_complete(bar, b.x, nloc, nx, uni); b.st[0] = nloc; b.st[1] = nx; b.st[2] = uni; }
        const unsigned old = xb_add(&bar[XB_XSUB(b.x)], 1u);
        const unsigned gen = old / nloc;
        if (old + 1u == (gen + 1u) * nloc) {
            __builtin_amdgcn_fence(__ATOMIC_RELEASE, "agent");
            asm volatile("s_waitcnt vmcnt(0)" ::: "memory");
            const unsigned og = xb_add(&bar[XB_TOP], 1u);
            const unsigned tg = og / nx;
            if (og + 1u == (tg + 1u) * nx) xb_add(&bar[XB_TOPGEN], 1u);
            else XB_SPIN(xb_ld(&bar[XB_TOPGEN]) == tg, bar);
            __builtin_amdgcn_fence(__ATOMIC_ACQUIRE, "agent");
            xb_add(&bar[XB_XGEN(b.x)], 1u);
            asm volatile("s_waitcnt vmcnt(0)" ::: "memory");
        } else {
            XB_SPIN(xb_ld(&bar[XB_XGEN(b.x)]) == gen, bar);
            __builtin_amdgcn_fence(__ATOMIC_ACQUIRE, "agent");
            asm volatile("s_waitcnt vmcnt(0)" ::: "memory");
        }
    }
    __syncthreads();
}

__device__ __forceinline__ void xcd_barrier_local(const XcdBarrier& b, const int tid) {
    asm volatile("s_waitcnt vmcnt(0)" ::: "memory");
    __syncthreads();
    if (tid == 0) {
        unsigned* bar = b.bar;
        __builtin_amdgcn_s_waitcnt(0);
        const unsigned nloc = b.st[0];
        const unsigned old = xb_add(&bar[XB_XSUB(b.x)], 1u);
        const unsigned gen = old / nloc;
        if (old + 1u == (gen + 1u) * nloc) xb_add(&bar[XB_XGEN(b.x)], 1u);
        else XB_SPIN(xb_ld(&bar[XB_XGEN(b.x)]) == gen, bar);
        __builtin_amdgcn_fence(__ATOMIC_ACQUIRE, "agent");
        asm volatile("s_waitcnt vmcnt(0)" ::: "memory");
    }
    __syncthreads();
}
__device__ __forceinline__ float gelu1(float v) {
    const float av = fabsf(v), d = av * 0.2316418882f + 1.0f;
    const float t = __builtin_amdgcn_rcpf(d);
    float q = t * 0.5307027145f + (-0.7265760135f); q = q * t + 0.7107068705f; q = q * t + (-0.142248368f); q = q * t + 0.127414796f; q = q * t;
    const float e = __builtin_amdgcn_exp2f((v * v) * (-0.72134752044f));
    const float m = v * (q * e), r = v - m;
    return v < 0.f ? m : r;
}
__device__ __forceinline__ float sigmoid1(float v) { return __builtin_amdgcn_rcpf(1.0f + __builtin_amdgcn_exp2f(-1.4426950408889634f * v)); }
__device__ __forceinline__ void store4bf(bf16* p, f32x4 v) { v2u w; w.x = pk2(v[0], v[1]); w.y = pk2(v[2], v[3]); *(v2u*)p = w; }

struct Args { const float* in[21]; float* out; unsigned char* ws; int ph_lo, ph_hi; };
struct Frame {
    LAS unsigned char* lds;
    int tid, lane, wave, G, bid;
};
#define WSP(A, off) ((bf16*)((A).ws + (off)))

__device__ __forceinline__ void p0_transpose_item(const float* W, int K, int N, bf16* WT, LAS float* scr, int item, int lane) {
    const int nblk = N / 32, kb = item / nblk, nb = item % nblk, k0 = 64 * kb, n0 = 32 * nb;
    f32x4 v[8];
#pragma unroll
    for (int i = 0; i < 8; ++i) v[i] = *(const f32x4*)(W + (size_t)(k0 + 8 * i + (lane >> 3)) * N + n0 + 4 * (lane & 7));
#pragma unroll
    for (int i = 0; i < 8; ++i) { LAS float* d = scr + (8 * i + (lane >> 3)) * 33 + 4 * (lane & 7); d[0] = v[i][0]; d[1] = v[i][1]; d[2] = v[i][2]; d[3] = v[i][3]; }
    asm volatile("s_waitcnt lgkmcnt(0)" ::: "memory");
    const int c = lane & 7;
#pragma unroll
    for (int j = 0; j < 4; ++j) { const int n = (lane >> 3) + 8 * j; const LAS float* s = scr + (8 * c) * 33 + n;
        v4u o; o.x = pk2(s[0 * 33], s[1 * 33]); o.y = pk2(s[2 * 33], s[3 * 33]); o.z = pk2(s[4 * 33], s[5 * 33]); o.w = pk2(s[6 * 33], s[7 * 33]);
        *(v4u*)(WT + (size_t)(n0 + n) * K + k0 + 8 * c) = o; }
    asm volatile("s_waitcnt lgkmcnt(0)" ::: "memory");
}

__device__ __forceinline__ int vcu_of(const Frame& F) { int G = F.G; asm volatile("" : "+s"(G));
    return (G % 8 == 0) ? (F.bid % 8) * (G / 8) + F.bid / 8 : F.bid; }
__device__ __forceinline__ unsigned short* sc_row(const Args& A, int t) {
    return (unsigned short*)(A.ws + WS_Q + ((size_t)(t >> 12) << 23) + ((size_t)((t >> 11) & 1) * (WS_K - WS_Q)) + ((size_t)(t & 2047) << 12)); }
__device__ __forceinline__ v2u* lst_row(const Args& A, int t) {
    return (v2u*)(A.ws + WS_SU + ((size_t)(t >> 12) << 23) + ((size_t)(t & 4095) << 10)); }
__device__ __forceinline__ int peer_grp(const Frame& F, int j) { const int gwv = vcu_of(F) * NWAVES + F.wave; return (F.G == 256) ? ((gwv >> 8) << 10) + (j << 8) + (gwv & 255) : gwv + j * F.G * NWAVES; }
__device__ __forceinline__ int peer_ngrp(const Frame& F) { return (F.G == 256) ? 4 : (T_ / 4 - (vcu_of(F) * NWAVES + F.wave) + F.G * NWAVES - 1) / (F.G * NWAVES); }

__device__ __forceinline__ v4u pk8(f32x4 a, f32x4 b);
__device__ __forceinline__ void p0_prologue(Frame& F, const Args& A, const int part, const bool do_w, const int tlo, const int thi, const int skip = 0) {
    LAS float* scr = (LAS float*)(F.lds + F.wave * 16384);
    const int gw = F.bid * NWAVES + F.wave, NGW = F.G * NWAVES;
    const int gt = F.bid * NTHR + F.tid, NGT = F.G * NTHR;
    constexpr int I_IN = (D_ / 64) * (DIN_ / 32), I_SQ = (D_ / 64) * (D_ / 32);
    constexpr int NITEMS = I_IN + 3 * I_SQ;
    if ((part == 0 && !(skip & 1)) || (part == 1 && do_w && !(skip & 4))) for (int it = gw + (part ? I_IN : 0); it < (part ? NITEMS : I_IN); it += NGW) {
        int r = it;
        if (r < I_IN) { p0_transpose_item(A.in[2], D_, DIN_, WSP(A, WS_WIN), scr, r, F.lane); continue; } r -= I_IN;
        if (r < I_SQ) { p0_transpose_item(A.in[12], D_, D_, WSP(A, WS_WA), scr, r, F.lane); continue; } r -= I_SQ;
        if (r < I_SQ) { p0_transpose_item(A.in[13], D_, D_, WSP(A, WS_WB), scr, r, F.lane); continue; } r -= I_SQ;
        p0_transpose_item(A.in[14], D_, D_, WSP(A, WS_WO), scr, r, F.lane);
    }
    if (part == 1 && do_w && !(skip & 8)) {
        const float* Wq = A.in[16]; const float* sk = A.in[17]; const float* g2 = A.in[15]; bf16* WQS = WSP(A, WS_WQS);
        LAS float* skL = (LAS float*)F.lds;
        LAS float* wqT = (LAS float*)(F.lds + 65536);
        for (int it = F.bid; it < 256; it += F.G) {
            const int sl = it >> 4, db = it & 15, p = sl & 1;
            __syncthreads();
#pragma unroll
            for (int q = 0; q < 8; ++q) { const int idx = F.tid + 512 * q; *(LAS f32x4*)(skL + idx * 4) = *(const f32x4*)(sk + (size_t)p * 16384 + idx * 4); }
#pragma unroll
            for (int q = 0; q < 4; ++q) { const int idx = F.tid + 512 * q, d = idx >> 5, c4 = (idx & 31) * 4;
                const f32x4 w = *(const f32x4*)(Wq + (size_t)(db * 64 + d) * 2048 + sl * 128 + c4);
                wqT[(c4 + 0) * 65 + d] = w[0]; wqT[(c4 + 1) * 65 + d] = w[1]; wqT[(c4 + 2) * 65 + d] = w[2]; wqT[(c4 + 3) * 65 + d] = w[3]; }
            __syncthreads();
            const int d = F.tid & 63, g = F.tid >> 6;
            float acc[16];
#pragma unroll
            for (int i = 0; i < 16; ++i) acc[i] = 0.f;
#pragma unroll 2
            for (int c = 0; c < 128; c += 4) {
                const float w0 = wqT[(c + 0) * 65 + d], w1 = wqT[(c + 1) * 65 + d], w2 = wqT[(c + 2) * 65 + d], w3 = wqT[(c + 3) * 65 + d];
#pragma unroll
                for (int i = 0; i < 16; ++i) { const f32x4 s = *(const LAS f32x4*)(skL + (g * 16 + i) * 128 + c); acc[i] += (w0 * s[0] + w1 * s[1]) + (w2 * s[2] + w3 * s[3]); }
            }
            const float gg = g2[db * 64 + d];
#pragma unroll
            for (int i = 0; i < 16; ++i) WQS[(size_t)(sl * 128 + g * 16 + i) * 1024 + db * 64 + d] = (bf16)f2bf(acc[i] * gg);
        }
        __syncthreads();
    }
    if (part == 0 && !(skip & 1) && gt < 128) ((float*)(A.ws + WS_GSUB))[gt] = A.in[7][gt] * (1.0f - LAM_INIT_);
    if (part == 0 && !(skip & 1)) for (int it = gt; it < 8 * 128 * 128; it += NGT) { const int j = it & 127, i = (it >> 7) & 127; const float w = A.in[10][it]; WSP(A, WS_SGW)[it] = (bf16)f2bf(((i >> 6) >= (j >> 6)) ? w : 0.f); }
    if (part == 1 && !(skip & 16)) for (int st = tlo; st < thi; ++st) { const int r0 = gw + st * 4 * NGW;
        f32x4 v[4][4];
#pragma unroll
        for (int k = 0; k < 4; ++k) { const int r = min(r0 + k * NGW, 2 * NEXP_ - 1), tb = r >= NEXP_, e = tb ? r - NEXP_ : r;
            const float* src = (tb ? A.in[19] : A.in[18]) + (size_t)e * D_ + 16 * F.lane;
#pragma unroll
            for (int i = 0; i < 4; ++i) v[k][i] = *(const f32x4*)(src + 4 * i); }
#pragma unroll
        for (int k = 0; k < 4; ++k) { const int r = min(r0 + k * NGW, 2 * NEXP_ - 1), tb = r >= NEXP_, e = tb ? r - NEXP_ : r;
            float mx = 0.f;
#pragma unroll
            for (int i = 0; i < 4; ++i) mx = fmaxf(mx, fmaxf(fmaxf(fabsf(v[k][i][0]), fabsf(v[k][i][1])), fmaxf(fabsf(v[k][i][2]), fabsf(v[k][i][3]))));
            mx = wave_max(mx);
            const float top = tb ? 240.0f : 127.0f;
            const float sc = mx > 0.f ? top / mx : 1.0f, inv = mx > 0.f ? mx / top : 1.0f;
            v4u o;
            if (tb) {
#pragma unroll
                for (int i = 0; i < 4; ++i) { int p = __builtin_amdgcn_cvt_pk_fp8_f32(v[k][i][0] * sc, v[k][i][1] * sc, 0, false); p = __builtin_amdgcn_cvt_pk_fp8_f32(v[k][i][2] * sc, v[k][i][3] * sc, p, true); o[i] = (unsigned)p; }
            } else {
#pragma unroll
                for (int i = 0; i < 4; ++i) { const int q0 = __float2int_rn(v[k][i][0] * sc), q1 = __float2int_rn(v[k][i][1] * sc), q2 = __float2int_rn(v[k][i][2] * sc), q3 = __float2int_rn(v[k][i][3] * sc);
                    o[i] = (unsigned)(q0 & 0xff) | ((unsigned)(q1 & 0xff) << 8) | ((unsigned)(q2 & 0xff) << 16) | ((unsigned)(q3 & 0xff) << 24); }
            }
            unsigned char* tab = A.ws + (tb ? WS_VT : WS_UT);
            *(v4u*)(tab + (size_t)e * 1024 + 16 * F.lane) = o;
            if (F.lane == 0) ((float*)(tab + 16 * MiB))[e] = inv; }
    }
    if (part == 0 && !(skip & 2)) {
        const float* g1 = A.in[1]; const float* X = A.in[0]; bf16* XN = WSP(A, WS_XN);
        f32x4 gv[4];
#pragma unroll
        for (int j = 0; j < 4; ++j) gv[j] = *(const f32x4*)(g1 + (j >> 1) * 512 + 8 * F.lane + 4 * (j & 1));
        constexpr int XR = P0_XROWS;
        for (int m0 = gw; m0 < T_; m0 += XR * NGW) {
            f32x4 v[XR][4];
#pragma unroll
            for (int k = 0; k < XR; ++k) { const float* xr = X + (size_t)min(P0_XCONSEC ? (m0 - gw) + gw * XR + k : m0 + k * NGW, T_ - 1) * D_ + 8 * F.lane;
#pragma unroll
                for (int jj = 0; jj < 4; ++jj) v[k][jj] = *(const f32x4*)(xr + (jj >> 1) * 512 + 4 * (jj & 1)); }
#pragma unroll
            for (int k = 0; k < XR; ++k) { float s = 0.f;
#pragma unroll
                for (int jj = 0; jj < 4; ++jj) s += (v[k][jj][0] * v[k][jj][0] + v[k][jj][1] * v[k][jj][1]) + (v[k][jj][2] * v[k][jj][2] + v[k][jj][3] * v[k][jj][3]);
                const float rstd = 1.0f / sqrtf(wave_sum(s) * (1.f / D_) + EPS_);
                bf16* o8 = XN + (size_t)min(P0_XCONSEC ? (m0 - gw) + gw * XR + k : m0 + k * NGW, T_ - 1) * D_ + 8 * F.lane;
                *(v4u*)o8 = pk8(v[k][0] * rstd * gv[0], v[k][1] * rstd * gv[1]);
                *(v4u*)(o8 + 512) = pk8(v[k][2] * rstd * gv[2], v[k][3] * rstd * gv[3]); }
        }
    }
}

__device__ __forceinline__ void st16(void* p, v4u v) {
#if ST_SC1
    asm volatile("global_store_dwordx4 %0, %1, off sc1\n\ts_nop 1" :: "v"(p), "v"(v) : "memory");
#else
    *(v4u*)p = v;
#endif
}
__device__ __forceinline__ v4u pk8(f32x4 a, f32x4 b) { v4u w; w.x = pk2(a[0], a[1]); w.y = pk2(a[2], a[3]); w.z = pk2(b[0], b[1]); w.w = pk2(b[2], b[3]); return w; }
__device__ __forceinline__ f32x4 gelu4(f32x4 v) { const pg8::f32x2 a = pg8::gelu_pk((pg8::f32x2){v[0], v[1]}), b = pg8::gelu_pk((pg8::f32x2){v[2], v[3]}); return (f32x4){a.x, a.y, b.x, b.y}; }
__device__ __forceinline__ f32x4 sigmoid4(f32x4 v) {
    const f32x4 t = v * (-1.4426950408889634f);
    f32x4 e = {__builtin_amdgcn_exp2f(t[0]), __builtin_amdgcn_exp2f(t[1]), __builtin_amdgcn_exp2f(t[2]), __builtin_amdgcn_exp2f(t[3])};
    e = e + 1.0f;
    return (f32x4){__builtin_amdgcn_rcpf(e[0]), __builtin_amdgcn_rcpf(e[1]), __builtin_amdgcn_rcpf(e[2]), __builtin_amdgcn_rcpf(e[3])};
}
__device__ __forceinline__ f32x4 bf4lo(v4u w) { return (f32x4){bflo(w.x), bfhi(w.x), bflo(w.y), bfhi(w.y)}; }
__device__ __forceinline__ f32x4 bf4hi(v4u w) { return (f32x4){bflo(w.z), bfhi(w.z), bflo(w.w), bfhi(w.w)}; }
struct EpiIn {
    bf16 *Q, *K, *V, *SU, *SV, *GT;
    __device__ __forceinline__ void operator()(int row, int col, f32x4 a, f32x4 b) const {
        if (col < 1024) { st16(Q + (size_t)row * 1024 + col, pk8(a * C2_, b * C2_)); }
        else if (col < 2048) { st16(K + (size_t)row * 1024 + (col - 1024), pk8(a, b)); }
        else if (col < 3072) { st16(V + (size_t)row * 1024 + (col - 2048), pk8(a, b)); }
        else if (col < 4096) { st16(SU + (size_t)row * 1024 + (col - 3072), pk8(gelu4(a), gelu4(b))); }
        else if (col < 5120) { st16(SV + (size_t)row * 1024 + (col - 4096), pk8(gelu4(a), gelu4(b))); }
        else { st16(GT + (size_t)row * 2048 + (col - 5120), pk8(sigmoid4(a), sigmoid4(b))); }
    }
};
struct EpiBrA {
    const bf16* GT; bf16* TMP;
    __device__ __forceinline__ void operator()(int row, int col, f32x4 a, f32x4 b) const {
        const v4u g = *(const v4u*)(GT + (size_t)row * 2048 + col);
        *(v4u*)(TMP + (size_t)row * 1024 + col) = pk8(a * bf4lo(g), b * bf4hi(g));
    }
};
struct EpiBrB {
    const bf16* GT; const bf16* TMP; bf16* MG;
    __device__ __forceinline__ void operator()(int row, int col, f32x4 a, f32x4 b) const {
        const v4u g = *(const v4u*)(GT + (size_t)row * 2048 + 1024 + col);
        const v4u t = *(const v4u*)(TMP + (size_t)row * 1024 + col);
        *(v4u*)(MG + (size_t)row * 1024 + col) = pk8(bf4lo(t) + a * bf4lo(g), bf4hi(t) + b * bf4hi(g));
    }
};
struct EpiOut {
    const float* X; bf16* HB;
    __device__ __forceinline__ void operator()(int row, int col, f32x4 a, f32x4 b) const {
        const float* xp = X + (size_t)row * 1024 + col;
        const f32x4 h0 = *(const f32x4*)xp + a, h1 = *(const f32x4*)(xp + 4) + b;
        st16(HB + (size_t)row * 1024 + col, pk8(h0, h1));
    }
};
typedef _Float16 h16x2 __attribute__((ext_vector_type(2)));
__device__ __forceinline__ unsigned pkh2(float lo, float hi) { f32x2 v = {lo, hi}; return __builtin_bit_cast(unsigned, __builtin_convertvector(v, h16x2)); }
struct EpiSc {
    const Args* AP;
    __device__ __forceinline__ void operator()(int row, int col, f32x4 a, f32x4 b) const {
        v4u w; w.x = pkh2(a[0], a[1]); w.y = pkh2(a[2], a[3]); w.z = pkh2(b[0], b[1]); w.w = pkh2(b[2], b[3]);
        st16(sc_row(*AP, row) + col, w);
    }
};

template <class T> __device__ __forceinline__ auto qptr_(const T& t, int) -> decltype(t.Q) { return t.Q; }
template <class T> __device__ __forceinline__ bf16* qptr_(const T&, long) { return nullptr; }
template <class T> __device__ __forceinline__ auto gptr_(const T& t, int) -> decltype(t.GT) { return t.GT; }
template <class T> __device__ __forceinline__ bf16* gptr_(const T&, long) { return nullptr; }
template <class Fn> struct EpiWrap {
    static constexpr bool PERM = true, AFTER_DRAIN = false, KSPLIT = false; static constexpr int NSTORE = EPI_SKIP ? 0 : 16;
    Fn f; int skip;
    __device__ __forceinline__ void operator()(const pg8::f32x4 (&acc)[2][2][4][2], const pg8::Unit& u, int wr, int wc, int fr, int fq) const {
        asm volatile("" : "+v"(fr), "+v"(fq));
#if EPI_SKIP == 1
        if (skip) {
#pragma unroll
            for (int ai = 0; ai < 2; ++ai)
#pragma unroll
                for (int m = 0; m < 4; ++m)
#pragma unroll
                    for (int bj = 0; bj < 2; ++bj) asm volatile("" :: "v"(acc[ai][bj][m][0]), "v"(acc[ai][bj][m][1]));
            return; }
#endif
#if EPI_SKIP == 3
        if (skip) {
            const int wid_ = wr * 4 + wc, lane_ = fq * 16 + fr;
            const int ti_ = u.pm * 28 + u.pn; bf16* tb_ = (ti_ < 2560) ? qptr_(f, 0) + (size_t)ti_ * 65536 : gptr_(f, 0) + (size_t)(ti_ - 2560) * 65536;
#pragma unroll
            for (int ai = 0; ai < 2; ++ai)
#pragma unroll
                for (int m = 0; m < 4; ++m)
#pragma unroll
                    for (int bj = 0; bj < 2; ++bj) { const int col_ = u.pn * 256 + bj * 128 + wc * 32 + 8 * fq;
                        const f32x4 a_ = acc[ai][bj][m][0], b_ = acc[ai][bj][m][1];
                        v4u w_;
                        if (col_ < 1024) w_ = pk8(a_ * C2_, b_ * C2_); else if (col_ < 3072) w_ = pk8(a_, b_); else if (col_ < 5120) w_ = pk8(gelu4(a_), gelu4(b_)); else w_ = pk8(sigmoid4(a_), sigmoid4(b_));
                        *(v4u*)(tb_ + ((ai * 4 + m) * 2 + bj) * 4096 + wid_ * 512 + lane_ * 8) = w_; }
            return; }
#endif
#if EPI_SKIP == 2
        if (skip) {
#pragma unroll
            for (int ai = 0; ai < 2; ++ai)
#pragma unroll
                for (int m = 0; m < 4; ++m)
#pragma unroll
                    for (int bj = 0; bj < 2; ++bj) { const int col_ = u.pn * 256 + bj * 128 + wc * 32 + 8 * fq;
                        f((u.pm & 3) * 256 + ai * 128 + wr * 64 + m * 16 + fr, (col_ & ~1023) | (col_ & 255), acc[ai][bj][m][0], acc[ai][bj][m][1]); }
            return; }
#endif
#pragma unroll
        for (int ai = 0; ai < 2; ++ai)
#pragma unroll
            for (int m = 0; m < 4; ++m)
#pragma unroll
                for (int bj = 0; bj < 2; ++bj)
                    f(u.pm * 256 + ai * 128 + wr * 64 + m * 16 + fr, u.pn * 256 + bj * 128 + wc * 32 + 8 * fq, acc[ai][bj][m][0], acc[ai][bj][m][1]);
    }
};

struct EpiMerge {
    static constexpr bool PERM = true, AFTER_DRAIN = false, KSPLIT = true; static constexpr int NSTORE = 16;
    const bf16* GT; bf16* MG;
    __device__ __forceinline__ void mid(pg8::f32x4 (&acc)[2][2][4][2], const pg8::Unit& u, int wr, int wc, int fr, int fq) const {
        asm volatile("" : "+v"(fr), "+v"(fq));
#pragma unroll
        for (int ai = 0; ai < 2; ++ai)
#pragma unroll
            for (int m = 0; m < 4; ++m)
#pragma unroll
                for (int bj = 0; bj < 2; ++bj) {
                    const int row = u.pm * 256 + ai * 128 + wr * 64 + m * 16 + fr, col = u.pn * 256 + bj * 128 + wc * 32 + 8 * fq;
                    const v4u ga = *(const v4u*)(GT + (size_t)row * 2048 + col), gb = *(const v4u*)(GT + (size_t)row * 2048 + 1024 + col);
                    const f32x4 b0 = bf4lo(gb), b1 = bf4hi(gb);
                    const f32x4 r0 = bf4lo(ga) * (f32x4){__builtin_amdgcn_rcpf(fmaxf(b0[0], 1e-20f)), __builtin_amdgcn_rcpf(fmaxf(b0[1], 1e-20f)), __builtin_amdgcn_rcpf(fmaxf(b0[2], 1e-20f)), __builtin_amdgcn_rcpf(fmaxf(b0[3], 1e-20f))};
                    const f32x4 r1 = bf4hi(ga) * (f32x4){__builtin_amdgcn_rcpf(fmaxf(b1[0], 1e-20f)), __builtin_amdgcn_rcpf(fmaxf(b1[1], 1e-20f)), __builtin_amdgcn_rcpf(fmaxf(b1[2], 1e-20f)), __builtin_amdgcn_rcpf(fmaxf(b1[3], 1e-20f))};
                    acc[ai][bj][m][0] = acc[ai][bj][m][0] * r0; acc[ai][bj][m][1] = acc[ai][bj][m][1] * r1;
                }
    }
    __device__ __forceinline__ void operator()(const pg8::f32x4 (&acc)[2][2][4][2], const pg8::Unit& u, int wr, int wc, int fr, int fq) const {
        asm volatile("" : "+v"(fr), "+v"(fq));
        v4u gbv[2][4][2];
#pragma unroll
        for (int ai = 0; ai < 2; ++ai)
#pragma unroll
            for (int m = 0; m < 4; ++m)
#pragma unroll
                for (int bj = 0; bj < 2; ++bj) {
                    const int row = u.pm * 256 + ai * 128 + wr * 64 + m * 16 + fr, col = u.pn * 256 + bj * 128 + wc * 32 + 8 * fq;
                    gbv[ai][m][bj] = *(const v4u*)(GT + (size_t)row * 2048 + 1024 + col); }
        asm volatile("" ::: "memory");
#pragma unroll
        for (int ai = 0; ai < 2; ++ai)
#pragma unroll
            for (int m = 0; m < 4; ++m)
#pragma unroll
                for (int bj = 0; bj < 2; ++bj) {
                    const int row = u.pm * 256 + ai * 128 + wr * 64 + m * 16 + fr, col = u.pn * 256 + bj * 128 + wc * 32 + 8 * fq;
                    const v4u gb = gbv[ai][m][bj];
                    const f32x4 b0 = bf4lo(gb), b1 = bf4hi(gb);
                    const f32x4 c0 = {fmaxf(b0[0], 1e-20f), fmaxf(b0[1], 1e-20f), fmaxf(b0[2], 1e-20f), fmaxf(b0[3], 1e-20f)}, c1 = {fmaxf(b1[0], 1e-20f), fmaxf(b1[1], 1e-20f), fmaxf(b1[2], 1e-20f), fmaxf(b1[3], 1e-20f)};
                    st16(MG + (size_t)row * 1024 + col, pk8(acc[ai][bj][m][0] * c0, acc[ai][bj][m][1] * c1));
                }
    }
};
struct EpiOutB {
    static constexpr bool PERM = true, AFTER_DRAIN = false, KSPLIT = false; static constexpr int NSTORE = 16;
    const float* X; bf16* HB;
    __device__ __forceinline__ void operator()(const pg8::f32x4 (&acc)[2][2][4][2], const pg8::Unit& u, int wr, int wc, int fr, int fq) const {
        asm volatile("" : "+v"(fr), "+v"(fq));
#pragma unroll
        for (int ai = 0; ai < 2; ++ai) {
            f32x4 xv[4][2][2];
#pragma unroll
            for (int m = 0; m < 4; ++m)
#pragma unroll
                for (int bj = 0; bj < 2; ++bj) { const float* xp = X + (size_t)(u.pm * 256 + ai * 128 + wr * 64 + m * 16 + fr) * 1024 + u.pn * 256 + bj * 128 + wc * 32 + 8 * fq;
                    xv[m][bj][0] = *(const f32x4*)xp; xv[m][bj][1] = *(const f32x4*)(xp + 4); }
            asm volatile("" ::: "memory");
#pragma unroll
            for (int m = 0; m < 4; ++m)
#pragma unroll
                for (int bj = 0; bj < 2; ++bj) { const int row = u.pm * 256 + ai * 128 + wr * 64 + m * 16 + fr, col = u.pn * 256 + bj * 128 + wc * 32 + 8 * fq;
                    st16(HB + (size_t)row * 1024 + col, pk8(xv[m][bj][0] + acc[ai][bj][m][0], xv[m][bj][1] + acc[ai][bj][m][1])); }
            asm volatile("" ::: "memory");
        }
    }
};
__device__ __forceinline__ void gemm_out(Frame& F, const bf16* A, const bf16* Bt, const float* X, bf16* HB) {
    pg8::Gemm g{A, Bt, T_, D_, D_, 1, 0, 0}; pg8::StaticOrder S; S.init(T_, D_, F.G, F.bid, PG8_ROT_ALL);
    EpiOutB E{X, HB};
    pg8::gemm_phase<EpiOutB, pg8::StaticOrder, true, true>(F.lds, g, S, E, F.tid);
}
__device__ __forceinline__ void gemm_merge(Frame& F, const bf16* YA, const bf16* WA, long dA, long dB, const bf16* GT, bf16* MG) {
    pg8::Gemm g{YA, WA, T_, D_, D_, 2, dA, dB}; pg8::StaticOrder S; S.init(T_, D_, F.G, F.bid, PG8_ROT_ALL);
    EpiMerge E{GT, MG};
    pg8::gemm_phase<EpiMerge, pg8::StaticOrder, true, true>(F.lds, g, S, E, F.tid);
}

template <class Fn>
__device__ __forceinline__ void gemm_any(Frame& F, const bf16* A, const bf16* Bt, int M, int N, int K, const Fn& f, const int skip = 0) {
    pg8::Gemm g{A, Bt, M, N, K, 1, 0, 0}; pg8::StaticOrder S; S.init(M, N, F.G, F.bid, (PG8_ROT_ALL || N == DIN_ || (PG8_ROT_SC && N == 2048)) ? 1 : 0);
    EpiWrap<Fn> E{f, skip};
    pg8::gemm_phase<EpiWrap<Fn>, pg8::StaticOrder, true, true>(F.lds, g, S, E, F.tid);
}

__device__ __forceinline__ void gmlp_naive(Frame& F, const Args& A) {
    bf16* SU = WSP(A, WS_SU); const bf16* SV = WSP(A, WS_SV);
    LAS float* vn = (LAS float*)F.lds;
    LAS float* Wl = (LAS float*)(F.lds + 65536);
    LAS float* st = (LAS float*)(F.lds + 131072);
    const float* lng = A.in[8]; const float* lnb = A.in[9]; const float* sgw = A.in[10]; const float* sgb = A.in[11];
    for (int u = F.bid; u < T_ / 128; u += F.G) {
        const int r0 = u * 128;
        __syncthreads();
        for (int rr = 0; rr < 16; ++rr) {
            const int j = F.wave * 16 + rr;
            const bf16* row = SV + (size_t)(r0 + j) * 1024;
            const v4u a = *(const v4u*)(row + 8 * F.lane), b = *(const v4u*)(row + 512 + 8 * F.lane);
            float x[16] = {bflo(a.x), bfhi(a.x), bflo(a.y), bfhi(a.y), bflo(a.z), bfhi(a.z), bflo(a.w), bfhi(a.w),
                           bflo(b.x), bfhi(b.x), bflo(b.y), bfhi(b.y), bflo(b.z), bfhi(b.z), bflo(b.w), bfhi(b.w)};
            float s = 0.f;
#pragma unroll
            for (int i = 0; i < 16; ++i) s += x[i];
            const float mean = wave_sum(s) * (1.f / 1024.f);
            float q = 0.f;
#pragma unroll
            for (int i = 0; i < 16; ++i) { const float d = x[i] - mean; q += d * d; }
            const float rstd = 1.0f / sqrtf(wave_sum(q) * (1.f / 1024.f) + EPS_);
            if (F.lane == 0) { st[2 * j] = mean; st[2 * j + 1] = rstd; }
        }
        __syncthreads();
        for (int g = 0; g < 8; ++g) {
            for (int idx = F.tid; idx < 16384; idx += NTHR) {
                const int j = idx >> 7, c = idx & 127;
                const float x = bf2f(SV[(size_t)(r0 + j) * 1024 + g * 128 + c]);
                vn[idx] = (x - st[2 * j]) * st[2 * j + 1] * lng[g * 128 + c] + lnb[g * 128 + c];
                const int i = j;
                const float w = sgw[(size_t)g * 16384 + idx];
                Wl[idx] = ((i >> 6) >= (c >> 6)) ? w : 0.f;
            }
            __syncthreads();
            const int c = F.tid & 127, rg = F.tid >> 7;
            float acc[32];
#pragma unroll
            for (int ii = 0; ii < 32; ++ii) acc[ii] = 0.f;
            for (int j = 0; j < 128; j += 4) {
                const float v0 = vn[(j + 0) * 128 + c], v1 = vn[(j + 1) * 128 + c], v2 = vn[(j + 2) * 128 + c], v3 = vn[(j + 3) * 128 + c];
#pragma unroll
                for (int ii = 0; ii < 32; ++ii) { const f32x4 w = *(const LAS f32x4*)(Wl + (rg * 32 + ii) * 128 + j); acc[ii] += w[0] * v0 + w[1] * v1 + w[2] * v2 + w[3] * v3; }
            }
#pragma unroll
            for (int ii = 0; ii < 32; ++ii) {
                const int i = rg * 32 + ii; bf16* p = SU + (size_t)(r0 + i) * 1024 + g * 128 + c;
                *p = (bf16)f2bf(bf2f(*p) * (acc[ii] + sgb[g * 128 + i]));
            }
            __syncthreads();
        }
    }
}

typedef short v4i16_t __attribute__((ext_vector_type(4)));
__device__ __forceinline__ void gmlp_mfma(Frame& F, const Args& A) {
    bf16* SU = WSP(A, WS_SU); const bf16* SV = WSP(A, WS_SV); const bf16* SGW = WSP(A, WS_SGW);
    const float* lng = A.in[8]; const float* lnb = A.in[9]; const float* sgb = A.in[11];
    LAS float* st = (LAS float*)(F.lds + 65536);
    const int lane = F.lane, w = F.wave, tid = F.tid;
    const int l15 = lane & 15, gq = lane >> 4, q4 = (lane & 15) >> 2, p4 = lane & 3;
    const int fsw = q4 | ((gq & 1) << 2);
    for (int u = vcu_of(F); u < T_ / 128; u += F.G) {
        const int r0 = u * 128;
        __syncthreads();
#pragma unroll 8
        for (int rr = 0; rr < 16; ++rr) {
            const int j = w * 16 + rr;
            const bf16* row = SV + (size_t)(r0 + j) * 1024;
            const v4u a = *(const v4u*)(row + 8 * lane), b = *(const v4u*)(row + 512 + 8 * lane);
            float x[16] = {bflo(a.x), bfhi(a.x), bflo(a.y), bfhi(a.y), bflo(a.z), bfhi(a.z), bflo(a.w), bfhi(a.w),
                           bflo(b.x), bfhi(b.x), bflo(b.y), bfhi(b.y), bflo(b.z), bfhi(b.z), bflo(b.w), bfhi(b.w)};
            float s = 0.f;
#pragma unroll
            for (int i = 0; i < 16; ++i) s += x[i];
            const float mean = wave_sum(s) * (1.f / 1024.f);
            float q = 0.f;
#pragma unroll
            for (int i = 0; i < 16; ++i) { const float d = x[i] - mean; q += d * d; }
            const float rstd = 1.0f / sqrtf(wave_sum(q) * (1.f / 1024.f) + EPS_);
            if (lane == 0) { st[2 * j] = mean; st[2 * j + 1] = rstd; }
        }
        v4u raw[4];
#define GM_LOAD(g_) do { _Pragma("unroll") for (int q_ = 0; q_ < 4; ++q_) { const int p_ = tid + 512 * q_; raw[q_] = *(const v4u*)(SV + (size_t)(r0 + (p_ >> 4)) * 1024 + (g_) * 128 + (p_ & 15) * 8); } } while (0)
#define GM_WRITE(buf_, g_) do { _Pragma("unroll") for (int q_ = 0; q_ < 4; ++q_) { const int p_ = tid + 512 * q_, j_ = p_ >> 4, ch_ = p_ & 15; \
            const float mu_ = st[2 * j_], rs_ = st[2 * j_ + 1]; \
            const f32x4 ga_ = lp_ga, gb_ = lp_gb, ba_ = lp_ba, bb_ = lp_bb;     \
            v4u o_; \
            o_.x = pk2((bflo(raw[q_].x) - mu_) * rs_ * ga_[0] + ba_[0], (bfhi(raw[q_].x) - mu_) * rs_ * ga_[1] + ba_[1]); \
            o_.y = pk2((bflo(raw[q_].y) - mu_) * rs_ * ga_[2] + ba_[2], (bfhi(raw[q_].y) - mu_) * rs_ * ga_[3] + ba_[3]); \
            o_.z = pk2((bflo(raw[q_].z) - mu_) * rs_ * gb_[0] + bb_[0], (bfhi(raw[q_].z) - mu_) * rs_ * gb_[1] + bb_[1]); \
            o_.w = pk2((bflo(raw[q_].w) - mu_) * rs_ * gb_[2] + bb_[2], (bfhi(raw[q_].w) - mu_) * rs_ * gb_[3] + bb_[3]); \
            const int fj_ = (j_ & 3) | (((j_ >> 3) & 1) << 2); \
            *(LAS v4u*)(F.lds + (buf_) * 32768 + j_ * 256 + (((ch_ >> 1) ^ fj_) * 32) + (ch_ & 1) * 16) = o_; } } while (0)
#define GM_LNP(g_) do { const int ch_ = tid & 15; lp_ga = *(const f32x4*)(lng + (g_) * 128 + ch_ * 8); lp_gb = *(const f32x4*)(lng + (g_) * 128 + ch_ * 8 + 4); lp_ba = *(const f32x4*)(lnb + (g_) * 128 + ch_ * 8); lp_bb = *(const f32x4*)(lnb + (g_) * 128 + ch_ * 8 + 4); } while (0)
        f32x4 lp_ga, lp_gb, lp_ba, lp_bb;
        GM_LOAD(0); GM_LNP(0);
        __syncthreads();
        GM_WRITE(0, 0);
        bf16x8 wfn[4]; float biasn;
        { const int i0_ = w * 16 + l15;
#pragma unroll
          for (int ks = 0; ks < 4; ++ks) wfn[ks] = *(const bf16x8*)(SGW + (size_t)i0_ * 128 + ks * 32 + 8 * gq);
          biasn = sgb[i0_]; }
#pragma unroll 1
        for (int g = 0; g < 8; ++g) {
            __syncthreads();
            {
                LAS unsigned char* tb = F.lds + (g & 1) * 32768;
                const int i = w * 16 + l15;
                v4u uu[4];
#pragma unroll
                for (int cp = 0; cp < 4; ++cp) uu[cp] = *(const v4u*)(SU + (size_t)(r0 + i) * 1024 + g * 128 + (2 * cp + (gq & 1)) * 16 + 8 * (gq >> 1));
                if (g + 1 < 8) { GM_LOAD(g + 1); GM_LNP(g + 1); }
                bf16x8 wf[4];
#pragma unroll
                for (int ks = 0; ks < 4; ++ks) wf[ks] = wfn[ks];
                const float bias = biasn;
                if (g + 1 < 8) {
#pragma unroll
                    for (int ks = 0; ks < 4; ++ks) wfn[ks] = *(const bf16x8*)(SGW + (size_t)((g + 1) * 128 + i) * 128 + ks * 32 + 8 * gq);
                    biasn = sgb[(g + 1) * 128 + i]; }
                f32x4 acc[8];
#pragma unroll
                for (int cb = 0; cb < 8; ++cb) acc[cb] = (f32x4){bias, bias, bias, bias};
                const int nks = (w < 4) ? 2 : 4;
#pragma unroll
                for (int ks = 0; ks < 4; ++ks) if (ks < nks) {
#pragma unroll
                    for (int cb = 0; cb < 8; ++cb) {
                        const LAS unsigned char* pa = tb + (ks * 32 + 8 * gq + q4) * 256 + ((cb ^ fsw) * 32) + 8 * p4;
                        const v4i16_t lo = __builtin_amdgcn_ds_read_tr16_b64_v4i16((LAS v4i16_t*)pa);
                        const v4i16_t hi = __builtin_amdgcn_ds_read_tr16_b64_v4i16((LAS v4i16_t*)(pa + 4 * 256));
                        const bf16x8 vf = (bf16x8){lo[0], lo[1], lo[2], lo[3], hi[0], hi[1], hi[2], hi[3]};
                        acc[cb] = __builtin_amdgcn_mfma_f32_16x16x32_bf16(vf, wf[ks], acc[cb], 0, 0, 0);
                    }
                }
#pragma unroll
                for (int cb = 0; cb < 8; cb += 2) {
                    f32x4 xa, xb;
#pragma unroll
                    for (int k = 0; k < 4; ++k) { auto r_ = __builtin_amdgcn_permlane16_swap(__float_as_uint(acc[cb][k]), __float_as_uint(acc[cb + 1][k]), false, false); xa[k] = __uint_as_float(r_[0]); xb[k] = __uint_as_float(r_[1]); }
                    bf16* p = SU + (size_t)(r0 + i) * 1024 + g * 128 + (cb + (gq & 1)) * 16 + 8 * (gq >> 1);
                    *(v4u*)p = pk8(bf4lo(uu[cb >> 1]) * xa, bf4hi(uu[cb >> 1]) * xb);
                }
            }
            if (g + 1 < 8) GM_WRITE((g + 1) & 1, g + 1);
        }
#undef GM_LOAD
#undef GM_LNP
#undef GM_WRITE
    }
}

__device__ __forceinline__ void attn_naive(Frame& F, const Args& A, bf16* O1, bf16* O2) {
    const bf16* Qp = WSP(A, WS_Q); const bf16* Kp = WSP(A, WS_K); const bf16* Vp = WSP(A, WS_V);
    const int gw = F.bid * NWAVES + F.wave, NGW = F.G * NWAVES;
    for (int it = gw; it < NB_ * 16 * S_; it += NGW) {
        const int q = it & (S_ - 1), hm = (it >> 12) & 15, b = it >> 16, head = hm & 7, map = hm >> 3;
        const size_t rowb = (size_t)b * S_;
        float qf[64];
        { const bf16* qp = Qp + (rowb + q) * 1024 + hm * 64;
#pragma unroll
          for (int i = 0; i < 8; ++i) { const v4u w = *(const v4u*)(qp + 8 * i); qf[8 * i + 0] = bflo(w.x); qf[8 * i + 1] = bfhi(w.x); qf[8 * i + 2] = bflo(w.y); qf[8 * i + 3] = bfhi(w.y); qf[8 * i + 4] = bflo(w.z); qf[8 * i + 5] = bfhi(w.z); qf[8 * i + 6] = bflo(w.w); qf[8 * i + 7] = bfhi(w.w); } }
        float m = -INFINITY, l = 0.f, o0 = 0.f, o1 = 0.f;
        const int nt = (q >> 6) + 1;
        for (int tt = 0; tt < nt; ++tt) {
            const bf16* kp = Kp + (rowb + tt * 64 + F.lane) * 1024 + hm * 64;
            float s = 0.f;
#pragma unroll
            for (int i = 0; i < 8; ++i) { const v4u w = *(const v4u*)(kp + 8 * i);
                s += qf[8 * i + 0] * bflo(w.x) + qf[8 * i + 1] * bfhi(w.x) + qf[8 * i + 2] * bflo(w.y) + qf[8 * i + 3] * bfhi(w.y) + qf[8 * i + 4] * bflo(w.z) + qf[8 * i + 5] * bfhi(w.z) + qf[8 * i + 6] * bflo(w.w) + qf[8 * i + 7] * bfhi(w.w); }
            const float mt = wave_max(s), mn = fmaxf(m, mt), al = __builtin_amdgcn_exp2f(m - mn), p = __builtin_amdgcn_exp2f(s - mn);
            l = l * al + wave_sum(p); o0 *= al; o1 *= al; m = mn;
            const bf16* vp = Vp + (rowb + tt * 64) * 1024 + head * 128 + 2 * F.lane;
            for (int j = 0; j < 64; ++j) { const float pj = __shfl(p, j); const unsigned w = *(const unsigned*)(vp + (size_t)j * 1024); o0 += pj * bflo(w); o1 += pj * bfhi(w); }
        }
        const float il = 1.0f / l;
        bf16* op = (map ? O2 : O1) + (rowb + q) * 1024 + head * 128 + 2 * F.lane;
        *(unsigned*)op = pk2(o0 * il, o1 * il);
    }
}

__device__ __forceinline__ void combine_phase(Frame& F, const Args& A, bf16* O1, const bf16* O2) {
    const int gw = F.bid * NWAVES + F.wave, NGW = F.G * NWAVES;
    const float s1 = wave_sum(A.in[3][F.lane] * A.in[4][F.lane]), s2 = wave_sum(A.in[5][F.lane] * A.in[6][F.lane]);
    const float lam = expf(s1) - expf(s2) + LAM_INIT_;
    float sg[16];
#pragma unroll
    for (int i = 0; i < 16; ++i) sg[i] = A.in[7][(16 * F.lane + i) & 127] * (1.0f - LAM_INIT_);
    for (int t = gw; t < T_; t += NGW) {
        bf16* p1 = O1 + (size_t)t * 1024 + 16 * F.lane; const bf16* p2 = O2 + (size_t)t * 1024 + 16 * F.lane;
        const v4u a0 = *(const v4u*)p1, a1 = *(const v4u*)(p1 + 8), b0 = *(const v4u*)p2, b1 = *(const v4u*)(p2 + 8);
        float d[16] = {bflo(a0.x) - lam * bflo(b0.x), bfhi(a0.x) - lam * bfhi(b0.x), bflo(a0.y) - lam * bflo(b0.y), bfhi(a0.y) - lam * bfhi(b0.y),
                       bflo(a0.z) - lam * bflo(b0.z), bfhi(a0.z) - lam * bfhi(b0.z), bflo(a0.w) - lam * bflo(b0.w), bfhi(a0.w) - lam * bfhi(b0.w),
                       bflo(a1.x) - lam * bflo(b1.x), bfhi(a1.x) - lam * bfhi(b1.x), bflo(a1.y) - lam * bflo(b1.y), bfhi(a1.y) - lam * bfhi(b1.y),
                       bflo(a1.z) - lam * bflo(b1.z), bfhi(a1.z) - lam * bfhi(b1.z), bflo(a1.w) - lam * bflo(b1.w), bfhi(a1.w) - lam * bfhi(b1.w)};
        float ss = 0.f;
#pragma unroll
        for (int i = 0; i < 16; ++i) ss += d[i] * d[i];
        ss += __shfl_xor(ss, 1); ss += __shfl_xor(ss, 2); ss += __shfl_xor(ss, 4);
        const float r = 1.0f / sqrtf(ss * (1.f / 128.f) + EPS_);
        v4u o0, o1;
        o0.x = pk2(d[0] * r * sg[0], d[1] * r * sg[1]); o0.y = pk2(d[2] * r * sg[2], d[3] * r * sg[3]); o0.z = pk2(d[4] * r * sg[4], d[5] * r * sg[5]); o0.w = pk2(d[6] * r * sg[6], d[7] * r * sg[7]);
        o1.x = pk2(d[8] * r * sg[8], d[9] * r * sg[9]); o1.y = pk2(d[10] * r * sg[10], d[11] * r * sg[11]); o1.z = pk2(d[12] * r * sg[12], d[13] * r * sg[13]); o1.w = pk2(d[14] * r * sg[14], d[15] * r * sg[15]);
        *(v4u*)p1 = o0; *(v4u*)(p1 + 8) = o1;
    }
}

__device__ const unsigned char CAND_IJ[56] = {
    0x00, 0x01, 0x02, 0x03, 0x04, 0x05, 0x06, 0x07, 0x08, 0x09, 0x0a, 0x0b, 0x0c, 0x0d, 0x0e, 0x0f,
    0x10, 0x11, 0x12, 0x13, 0x14, 0x15, 0x16, 0x17,
    0x20, 0x21, 0x22, 0x23, 0x24,
    0x30, 0x31, 0x32, 0x33,
    0x40, 0x41, 0x42,
    0x50, 0x51, 0x60, 0x61, 0x70, 0x71,
    0x80, 0x90, 0xa0, 0xb0, 0xc0, 0xd0, 0xe0, 0xf0,
    0xff, 0xff, 0xff, 0xff, 0xff, 0xff};
__device__ __forceinline__ unsigned fkey(float f) { const unsigned b = __builtin_bit_cast(unsigned, f); return b ^ ((unsigned)((int)b >> 31) | 0x80000000u); }
__device__ __forceinline__ unsigned fkeyb(unsigned b) { return b ^ ((unsigned)((int)b >> 31) | 0x80000000u); }
__device__ __forceinline__ float hkeyf(unsigned k) { const unsigned b = (k & 0x80000000u) ? (k ^ 0x80000000u) : ~k; return (float)__builtin_bit_cast(_Float16, (unsigned short)(b >> 16)); }
__device__ __forceinline__ float keyf(unsigned k) { const unsigned b = (k & 0x80000000u) ? (k ^ 0x80000000u) : ~k; return __builtin_bit_cast(float, b); }
#define DPP_U(x, ctrl) ((unsigned)__builtin_amdgcn_update_dpp(0, (int)(x), (ctrl), 0xf, 0xf, false))
#define DPP_F(x, ctrl) __builtin_bit_cast(float, __builtin_amdgcn_update_dpp(0, __builtin_bit_cast(int, (float)(x)), (ctrl), 0xf, 0xf, false))
__device__ __forceinline__ unsigned umax_(unsigned a, unsigned b) { return a > b ? a : b; }
__device__ __forceinline__ unsigned umin_(unsigned a, unsigned b) { return a < b ? a : b; }
__device__ __forceinline__ unsigned rowmax16_u(unsigned v) {
    v = umax_(v, DPP_U(v, 0xB1)); v = umax_(v, DPP_U(v, 0x4E)); v = umax_(v, DPP_U(v, 0x141)); v = umax_(v, DPP_U(v, 0x140)); return v; }
__device__ __forceinline__ unsigned grpmax8_u(unsigned v) {
    v = umax_(v, DPP_U(v, 0xB1)); v = umax_(v, DPP_U(v, 0x4E)); v = umax_(v, DPP_U(v, 0x141)); return v; }
__device__ __forceinline__ float grpmax8_f(float v) { v = fmaxf(v, DPP_F(v, 0xB1)); v = fmaxf(v, DPP_F(v, 0x4E)); v = fmaxf(v, DPP_F(v, 0x141)); return v; }
__device__ __forceinline__ float grpsum8_f(float v) { v += DPP_F(v, 0xB1); v += DPP_F(v, 0x4E); v += DPP_F(v, 0x141); return v; }
#define CEX(a, b) do { const unsigned _hi = umax_(a, b), _lo = umin_(a, b); a = _hi; b = _lo; } while (0)

__device__ __forceinline__ float dot2bf(unsigned a, unsigned b, float acc) { return __builtin_amdgcn_fdot2_f32_bf16(__builtin_bit_cast(bf16x2_t, a), __builtin_bit_cast(bf16x2_t, b), acc, false); }

template <int VARIANT>
__device__ __forceinline__ void peer_phase(Frame& F, const Args& A) {
    const unsigned char* U8 = A.ws + WS_UT; const unsigned char* V8 = A.ws + WS_VT;
    const float* SUs = (const float*)(A.ws + WS_UT + 16 * MiB); const float* SVs = (const float*)(A.ws + WS_VT + 16 * MiB);
    const float* SC = (const float*)(A.ws + WS_SC); float* OUT = A.out;
    const int lane = F.lane, gw = F.bid * NWAVES + F.wave, NGW = F.G * NWAVES;
    LAS unsigned* kl = (LAS unsigned*)(F.lds + F.wave * 4096);
    LAS int* exl = (LAS int*)(F.lds + F.wave * 4096 + 1024);
    LAS float* sul = (LAS float*)(F.lds + F.wave * 4096 + 1536);
    LAS float* gvl = (LAS float*)(F.lds + F.wave * 4096 + 2048);
    const float* g2 = A.in[15]; const float* gfin = A.in[20];
    const bf16* HB = WSP(A, WS_XN);
    const int li = lane & 15, rho = lane >> 4;
    const int eidx = (rho & 1) + 2 * ((lane >> 3) & 1) + 4 * (rho >> 1);
    for (int t = gw; t < T_; t += NGW) {
        const bf16* hp = HB + (size_t)t * 1024 + 16 * lane;
        f32x4 hv[4];
        { const v4u h0 = *(const v4u*)hp, h1 = *(const v4u*)(hp + 8); hv[0] = bf4lo(h0); hv[1] = bf4hi(h0); hv[2] = bf4lo(h1); hv[3] = bf4hi(h1); }
        float ss = 0.f;
#pragma unroll
        for (int i = 0; i < 4; ++i) ss += (hv[i][0] * hv[i][0] + hv[i][1] * hv[i][1]) + (hv[i][2] * hv[i][2] + hv[i][3] * hv[i][3]);
        const float rstd2 = 1.0f / sqrtf(wave_sum(ss) * (1.f / 1024.f) + EPS_);
        f32x2 xn[8];
#pragma unroll
        for (int i = 0; i < 4; ++i) { const f32x4 gg = *(const f32x4*)(g2 + 16 * lane + 4 * i); xn[2 * i] = (f32x2){hv[i][0] * rstd2 * gg[0], hv[i][1] * rstd2 * gg[1]}; xn[2 * i + 1] = (f32x2){hv[i][2] * rstd2 * gg[2], hv[i][3] * rstd2 * gg[3]}; }
        if constexpr (VARIANT != 0) {
            const int e0_ = (VARIANT == 1) ? ((t * 131 + lane * 977) & 16383) : lane * 128, e1_ = (VARIANT == 1) ? ((t * 137 + (lane + 64) * 977) & 16383) : (lane + 64) * 128;
            exl[lane] = e0_; exl[lane + 64] = e1_; sul[lane] = SUs[e0_]; sul[lane + 64] = SUs[e1_]; gvl[lane] = SVs[e0_] * (1.f / 16.f); gvl[lane + 64] = SVs[e1_] * (1.f / 16.f);
        } else {
        const float* sp = SC + (size_t)t * 2048;
#pragma unroll 1
        for (int r = 0; r < 4; ++r) {
            const int gi = 4 * r + rho;
            const f32x4 s0 = *(const f32x4*)(sp + gi * 128 + 8 * li), s1 = *(const f32x4*)(sp + gi * 128 + 8 * li + 4);
            unsigned k0 = (fkey(s0[0]) & ~127u) | (unsigned)(127 - (8 * li + 0)), k1 = (fkey(s0[1]) & ~127u) | (unsigned)(127 - (8 * li + 1)),
                     k2 = (fkey(s0[2]) & ~127u) | (unsigned)(127 - (8 * li + 2)), k3 = (fkey(s0[3]) & ~127u) | (unsigned)(127 - (8 * li + 3)),
                     k4 = (fkey(s1[0]) & ~127u) | (unsigned)(127 - (8 * li + 4)), k5 = (fkey(s1[1]) & ~127u) | (unsigned)(127 - (8 * li + 5)),
                     k6 = (fkey(s1[2]) & ~127u) | (unsigned)(127 - (8 * li + 6)), k7 = (fkey(s1[3]) & ~127u) | (unsigned)(127 - (8 * li + 7));
            CEX(k0, k1); CEX(k2, k3); CEX(k4, k5); CEX(k6, k7);
            CEX(k0, k2); CEX(k1, k3); CEX(k4, k6); CEX(k5, k7);
            CEX(k1, k2); CEX(k5, k6); CEX(k0, k4); CEX(k3, k7);
            CEX(k1, k5); CEX(k2, k6);
            CEX(k1, k4); CEX(k3, k6);
            CEX(k2, k4); CEX(k3, k5);
            CEX(k3, k4);
            unsigned rec = 0u;
#pragma unroll
            for (int itx = 0; itx < 16; ++itx) {
                const unsigned mk = rowmax16_u(k0);
                rec = (li == itx) ? mk : rec;
                const bool own = (k0 == mk);
                k0 = own ? k1 : k0; k1 = own ? k2 : k1; k2 = own ? k3 : k2; k3 = own ? k4 : k3; k4 = own ? k5 : k4; k5 = own ? k6 : k5; k6 = own ? k7 : k6; k7 = own ? 0u : k7;
            }
            kl[gi * 16 + li] = rec;
        }
        asm volatile("s_waitcnt lgkmcnt(0)" ::: "memory");
        {
            const int hh = lane >> 3, q8 = lane & 7;
            unsigned c[7];
#pragma unroll
            for (int mth = 0; mth < 7; ++mth) {
                const int cid = q8 + 8 * mth; const unsigned ij = CAND_IJ[cid];
                if (ij == 0xffu) { c[mth] = 0u; }
                else { const unsigned ka = kl[(2 * hh) * 16 + (ij >> 4)], kb = kl[(2 * hh + 1) * 16 + (ij & 15)];
                       const float sum = keyf(ka & ~127u) + keyf(kb & ~127u);
                       c[mth] = (fkey(sum) & ~63u) | (unsigned)(63 - cid); }
            }
            CEX(c[0], c[6]); CEX(c[2], c[3]); CEX(c[4], c[5]);
            CEX(c[0], c[2]); CEX(c[1], c[4]); CEX(c[3], c[6]);
            CEX(c[0], c[1]); CEX(c[2], c[5]); CEX(c[3], c[4]);
            CEX(c[1], c[2]); CEX(c[4], c[6]);
            CEX(c[2], c[3]); CEX(c[4], c[5]);
            CEX(c[1], c[2]); CEX(c[3], c[4]); CEX(c[5], c[6]);
            unsigned rec0 = 0u, rec1 = 0u;
#pragma unroll
            for (int itx = 0; itx < 16; ++itx) {
                const unsigned mk = grpmax8_u(c[0]);
                if (itx < 8) rec0 = (q8 == itx) ? mk : rec0; else rec1 = (q8 == itx - 8) ? mk : rec1;
                const bool own = (c[0] == mk);
                c[0] = own ? c[1] : c[0]; c[1] = own ? c[2] : c[1]; c[2] = own ? c[3] : c[2]; c[3] = own ? c[4] : c[3]; c[4] = own ? c[5] : c[4]; c[5] = own ? c[6] : c[5]; c[6] = own ? 0u : c[6];
            }
            const int cid0 = 63 - (int)(rec0 & 63u), cid1 = 63 - (int)(rec1 & 63u);
            const unsigned ij0 = CAND_IJ[cid0], ij1 = CAND_IJ[cid1];
            const int e0 = (127 - (int)(kl[(2 * hh) * 16 + (ij0 >> 4)] & 127u)) * 128 + (127 - (int)(kl[(2 * hh + 1) * 16 + (ij0 & 15)] & 127u));
            const int e1 = (127 - (int)(kl[(2 * hh) * 16 + (ij1 >> 4)] & 127u)) * 128 + (127 - (int)(kl[(2 * hh + 1) * 16 + (ij1 & 15)] & 127u));
            const float su0 = SUs[e0], su1 = SUs[e1], sv0 = SVs[e0], sv1 = SVs[e1];
            const float v0 = keyf(rec0 & ~63u) * rstd2, v1 = keyf(rec1 & ~63u) * rstd2;
            const float mx = grpmax8_f(fmaxf(v0, v1));
            const float x0 = __expf(v0 - mx), x1 = __expf(v1 - mx);
            const float inv = 1.0f / grpsum8_f(x0 + x1);
            exl[hh * 16 + q8] = e0; exl[hh * 16 + 8 + q8] = e1;
            sul[hh * 16 + q8] = su0; sul[hh * 16 + 8 + q8] = su1;
            gvl[hh * 16 + q8] = x0 * inv * sv0; gvl[hh * 16 + 8 + q8] = x1 * inv * sv1;
        }
        }
        asm volatile("s_waitcnt lgkmcnt(0)" ::: "memory");
        f32x2 y[8];
#pragma unroll
        for (int i = 0; i < 8; ++i) y[i] = (f32x2){0.f, 0.f};
        v4u UA[8], VA[8], UB[8], VB[8];
#define PEER_LOAD(U_, V_, ch) do { \
            const v4u ea_ = *(const LAS v4u*)(exl + (ch) * 8), eb_ = *(const LAS v4u*)(exl + (ch) * 8 + 4); \
            _Pragma("unroll") for (int i_ = 0; i_ < 8; ++i_) { const unsigned e_ = (unsigned)__builtin_amdgcn_readfirstlane((int)(i_ < 4 ? ea_[i_ & 3] : eb_[i_ & 3])); \
                U_[i_] = *(const v4u*)(U8 + (size_t)e_ * 1024 + 16 * lane); V_[i_] = *(const v4u*)(V8 + (size_t)e_ * 1024 + 16 * lane); } } while (0)
#define PEER_COMP(U_, V_, ch) do { \
            float a_[8]; \
            _Pragma("unroll") for (int i_ = 0; i_ < 8; ++i_) { f32x2 s_ = (f32x2){0.f, 0.f}; \
                _Pragma("unroll") for (int w_ = 0; w_ < 4; ++w_) { const f32x2 lo_ = __builtin_amdgcn_cvt_pk_f32_fp8(U_[i_][w_], false), hi_ = __builtin_amdgcn_cvt_pk_f32_fp8(U_[i_][w_], true); \
                    s_ = __builtin_elementwise_fma(lo_, xn[2 * w_], s_); s_ = __builtin_elementwise_fma(hi_, xn[2 * w_ + 1], s_); } \
                a_[i_] = s_.x + s_.y; } \
            float b_[4]; \
            _Pragma("unroll") for (int i_ = 0; i_ < 4; ++i_) { auto r_ = __builtin_amdgcn_permlane32_swap(__float_as_uint(a_[i_]), __float_as_uint(a_[i_ + 4]), false, false); b_[i_] = __uint_as_float(r_[0]) + __uint_as_float(r_[1]); } \
            float c_[2]; \
            _Pragma("unroll") for (int i_ = 0; i_ < 2; ++i_) { auto r_ = __builtin_amdgcn_permlane16_swap(__float_as_uint(b_[2 * i_]), __float_as_uint(b_[2 * i_ + 1]), false, false); c_[i_] = __uint_as_float(r_[0]) + __uint_as_float(r_[1]); } \
            c_[0] += DPP_F(c_[0], 0x128); c_[1] += DPP_F(c_[1], 0x128); \
            float d_ = (lane & 8) ? c_[1] : c_[0]; \
            d_ += DPP_F(d_, 0xB1); d_ += DPP_F(d_, 0x4E); d_ += DPP_F(d_, 0x141); \
            const float w_ = gvl[(ch) * 8 + eidx] * gelu1(d_ * sul[(ch) * 8 + eidx]); \
            _Pragma("unroll") for (int i_ = 0; i_ < 8; ++i_) { \
                const float ws_ = __builtin_bit_cast(float, __builtin_amdgcn_readlane(__builtin_bit_cast(int, w_), ((i_ & 1) + 2 * (i_ >> 2)) * 16 + ((i_ >> 1) & 1) * 8)); \
                const f32x2 w2_ = (f32x2){ws_, ws_}; \
                _Pragma("unroll") for (int q_ = 0; q_ < 4; ++q_) { const f32x2 lo_ = __builtin_amdgcn_cvt_pk_f32_fp8(V_[i_][q_], false), hi_ = __builtin_amdgcn_cvt_pk_f32_fp8(V_[i_][q_], true); \
                    y[2 * q_] = __builtin_elementwise_fma(lo_, w2_, y[2 * q_]); y[2 * q_ + 1] = __builtin_elementwise_fma(hi_, w2_, y[2 * q_ + 1]); } } } while (0)
        PEER_LOAD(UA, VA, 0);
#pragma unroll 1
        for (int ch = 0; ch < 16; ch += 2) {
            PEER_LOAD(UB, VB, ch + 1);
            PEER_COMP(UA, VA, ch);
            if (ch + 2 < 16) PEER_LOAD(UA, VA, ch + 2);
            PEER_COMP(UB, VB, ch + 1);
        }
#undef PEER_LOAD
#undef PEER_COMP
        f32x4 o[4]; float s2 = 0.f;
        const v4u hr0 = *(const volatile v4u*)hp, hr1 = *(const volatile v4u*)(hp + 8);
#pragma unroll
        for (int i = 0; i < 4; ++i) { const f32x4 hr = (i == 0) ? bf4lo(hr0) : (i == 1) ? bf4hi(hr0) : (i == 2) ? bf4lo(hr1) : bf4hi(hr1);
            o[i] = hr + (f32x4){y[2 * i].x, y[2 * i].y, y[2 * i + 1].x, y[2 * i + 1].y}; s2 += (o[i][0] * o[i][0] + o[i][1] * o[i][1]) + (o[i][2] * o[i][2] + o[i][3] * o[i][3]); }
        const float rf = 1.0f / sqrtf(wave_sum(s2) * (1.f / 1024.f) + EPS_);
        float* op = OUT + (size_t)t * 1024 + 16 * lane;
#pragma unroll
        for (int i = 0; i < 4; ++i) *(f32x4*)(op + 4 * i) = o[i] * rf * *(const f32x4*)(gfin + 16 * lane + 4 * i);
    }
}

constexpr int PG = 2;
constexpr int PW_STRIDE = 16384;
template <bool FIXED>
__device__ __forceinline__ void peer_phase2(Frame& F, const Args& A) {
    const unsigned char* U8 = A.ws + WS_UT; const unsigned char* V8 = A.ws + WS_VT;
    const float* SUs = (const float*)(A.ws + WS_UT + 16 * MiB); const float* SVs = (const float*)(A.ws + WS_VT + 16 * MiB);
    const float* SC = (const float*)(A.ws + WS_SC); float* OUT = A.out;
    const int lane = F.lane, gw = F.bid * NWAVES + F.wave, NGW = F.G * NWAVES;
    LAS unsigned char* wl = F.lds + F.wave * PW_STRIDE;
    LAS unsigned* kl = (LAS unsigned*)wl;
    LAS unsigned char* xnl = wl + 1024;
    LAS int* exl = (LAS int*)(wl + 1024 + PG * 2048);
    LAS float* sul = (LAS float*)(wl + 1024 + PG * 2048 + PG * 512);
    LAS float* gvl = (LAS float*)(wl + 1024 + PG * 2048 + 2 * PG * 512);
    LAS int* ofl = (LAS int*)(wl + 1024 + PG * 2048 + 3 * PG * 512);
    const float* g2 = A.in[15]; const float* gfin = A.in[20];
    const bf16* HB = WSP(A, WS_XN);
    const int li = lane & 15, rho = lane >> 4;
    const int eidx = (rho & 1) + 2 * ((lane >> 3) & 1) + 4 * (rho >> 1);
    const int x0 = (int)xb_xcc_id() & 7;
    for (int grp = gw; grp < T_ / PG; grp += NGW) {
#pragma unroll 1
        for (int n = 0; n < PG; ++n) {
            const int t = grp * PG + n;
            const bf16* hp = HB + (size_t)t * 1024 + 16 * lane;
            f32x4 hv[4];
            { const v4u h0 = *(const v4u*)hp, h1 = *(const v4u*)(hp + 8); hv[0] = bf4lo(h0); hv[1] = bf4hi(h0); hv[2] = bf4lo(h1); hv[3] = bf4hi(h1); }
            float ss = 0.f;
#pragma unroll
            for (int i = 0; i < 4; ++i) ss += (hv[i][0] * hv[i][0] + hv[i][1] * hv[i][1]) + (hv[i][2] * hv[i][2] + hv[i][3] * hv[i][3]);
            const float rstd2 = 1.0f / sqrtf(wave_sum(ss) * (1.f / 1024.f) + EPS_);
            {
                v4u xa, xb;
#pragma unroll
                for (int i = 0; i < 4; ++i) { const f32x4 gg = *(const f32x4*)(g2 + 16 * lane + 4 * i);
                    const unsigned p0 = pk2(hv[i][0] * rstd2 * gg[0], hv[i][1] * rstd2 * gg[1]), p1 = pk2(hv[i][2] * rstd2 * gg[2], hv[i][3] * rstd2 * gg[3]);
                    if (i < 2) { xa[2 * i] = p0; xa[2 * i + 1] = p1; } else { xb[2 * (i - 2)] = p0; xb[2 * (i - 2) + 1] = p1; } }
                *(LAS v4u*)(xnl + n * 2048 + 32 * lane) = xa; *(LAS v4u*)(xnl + n * 2048 + 32 * lane + 16) = xb;
            }
            const float* sp = SC + (size_t)t * 2048;
#pragma unroll 1
            for (int r = 0; r < 4; ++r) {
                const int gi = 4 * r + rho;
                const f32x4 s0 = *(const f32x4*)(sp + gi * 128 + 8 * li), s1 = *(const f32x4*)(sp + gi * 128 + 8 * li + 4);
                unsigned k0 = (fkey(s0[0]) & ~127u) | (unsigned)(127 - (8 * li + 0)), k1 = (fkey(s0[1]) & ~127u) | (unsigned)(127 - (8 * li + 1)),
                         k2 = (fkey(s0[2]) & ~127u) | (unsigned)(127 - (8 * li + 2)), k3 = (fkey(s0[3]) & ~127u) | (unsigned)(127 - (8 * li + 3)),
                         k4 = (fkey(s1[0]) & ~127u) | (unsigned)(127 - (8 * li + 4)), k5 = (fkey(s1[1]) & ~127u) | (unsigned)(127 - (8 * li + 5)),
                         k6 = (fkey(s1[2]) & ~127u) | (unsigned)(127 - (8 * li + 6)), k7 = (fkey(s1[3]) & ~127u) | (unsigned)(127 - (8 * li + 7));
                CEX(k0, k1); CEX(k2, k3); CEX(k4, k5); CEX(k6, k7);
                CEX(k0, k2); CEX(k1, k3); CEX(k4, k6); CEX(k5, k7);
                CEX(k1, k2); CEX(k5, k6); CEX(k0, k4); CEX(k3, k7);
                CEX(k1, k5); CEX(k2, k6);
                CEX(k1, k4); CEX(k3, k6);
                CEX(k2, k4); CEX(k3, k5);
                CEX(k3, k4);
                unsigned rec = 0u;
#pragma unroll
                for (int itx = 0; itx < 16; ++itx) {
                    const unsigned mk = rowmax16_u(k0);
                    rec = (li == itx) ? mk : rec;
                    const bool own = (k0 == mk);
                    k0 = own ? k1 : k0; k1 = own ? k2 : k1; k2 = own ? k3 : k2; k3 = own ? k4 : k3; k4 = own ? k5 : k4; k5 = own ? k6 : k5; k6 = own ? k7 : k6; k7 = own ? 0u : k7;
                }
                kl[gi * 16 + li] = rec;
            }
            asm volatile("s_waitcnt lgkmcnt(0)" ::: "memory");
            {
                const int hh = lane >> 3, q8 = lane & 7;
                unsigned c[7];
#pragma unroll
                for (int mth = 0; mth < 7; ++mth) {
                    const int cid = q8 + 8 * mth; const unsigned ij = CAND_IJ[cid];
                    if (ij == 0xffu) { c[mth] = 0u; }
                    else { const unsigned ka = kl[(2 * hh) * 16 + (ij >> 4)], kb = kl[(2 * hh + 1) * 16 + (ij & 15)];
                           const float sum = keyf(ka & ~127u) + keyf(kb & ~127u);
                           c[mth] = (fkey(sum) & ~63u) | (unsigned)(63 - cid); }
                }
                CEX(c[0], c[6]); CEX(c[2], c[3]); CEX(c[4], c[5]);
                CEX(c[0], c[2]); CEX(c[1], c[4]); CEX(c[3], c[6]);
                CEX(c[0], c[1]); CEX(c[2], c[5]); CEX(c[3], c[4]);
                CEX(c[1], c[2]); CEX(c[4], c[6]);
                CEX(c[2], c[3]); CEX(c[4], c[5]);
                CEX(c[1], c[2]); CEX(c[3], c[4]); CEX(c[5], c[6]);
                unsigned rec0 = 0u, rec1 = 0u;
#pragma unroll
                for (int itx = 0; itx < 16; ++itx) {
                    const unsigned mk = grpmax8_u(c[0]);
                    if (itx < 8) rec0 = (q8 == itx) ? mk : rec0; else rec1 = (q8 == itx - 8) ? mk : rec1;
                    const bool own = (c[0] == mk);
                    c[0] = own ? c[1] : c[0]; c[1] = own ? c[2] : c[1]; c[2] = own ? c[3] : c[2]; c[3] = own ? c[4] : c[3]; c[4] = own ? c[5] : c[4]; c[5] = own ? c[6] : c[5]; c[6] = own ? 0u : c[6];
                }
                const int cid0 = 63 - (int)(rec0 & 63u), cid1 = 63 - (int)(rec1 & 63u);
                const unsigned ij0 = CAND_IJ[cid0], ij1 = CAND_IJ[cid1];
                const int e0r = (127 - (int)(kl[(2 * hh) * 16 + (ij0 >> 4)] & 127u)) * 128 + (127 - (int)(kl[(2 * hh + 1) * 16 + (ij0 & 15)] & 127u));
                const int e1r = (127 - (int)(kl[(2 * hh) * 16 + (ij1 >> 4)] & 127u)) * 128 + (127 - (int)(kl[(2 * hh + 1) * 16 + (ij1 & 15)] & 127u));
                const int e0 = FIXED ? lane * 128 + (lane & 63) : e0r, e1 = FIXED ? (lane + 64) * 128 + lane : e1r;
                const float su0 = SUs[e0], su1 = SUs[e1], sv0 = SVs[e0], sv1 = SVs[e1];
                const float v0 = keyf(rec0 & ~63u) * rstd2, v1 = keyf(rec1 & ~63u) * rstd2;
                const float mx = grpmax8_f(fmaxf(v0, v1));
                const float x0e = __expf(v0 - mx), x1e = __expf(v1 - mx);
                const float inv = 1.0f / grpsum8_f(x0e + x1e);
                const int r0 = e0 >> 11, r1 = e1 >> 11; int pos0 = 0, pos1 = 0, start = 0;
#pragma unroll
                for (int r = 0; r < 8; ++r) {
                    const unsigned long long m0 = __ballot(r0 == r), m1 = __ballot(r1 == r);
                    const int c0 = __popcll(m0), c1 = __popcll(m1);
                    const int b0 = (int)__builtin_amdgcn_mbcnt_hi((unsigned)(m0 >> 32), __builtin_amdgcn_mbcnt_lo((unsigned)m0, 0u));
                    const int b1 = (int)__builtin_amdgcn_mbcnt_hi((unsigned)(m1 >> 32), __builtin_amdgcn_mbcnt_lo((unsigned)m1, 0u));
                    pos0 = (r0 == r) ? start + b0 : pos0; pos1 = (r1 == r) ? start + c0 + b1 : pos1;
                    if (lane == r) ofl[n * 16 + r] = start;
                    start += c0 + c1;
                }
                if (lane == 8) ofl[n * 16 + 8] = 128;
                exl[n * 128 + pos0] = e0; exl[n * 128 + pos1] = e1;
                sul[n * 128 + pos0] = su0; sul[n * 128 + pos1] = su1;
                gvl[n * 128 + pos0] = x0e * inv * sv0; gvl[n * 128 + pos1] = x1e * inv * sv1;
            }
            asm volatile("s_waitcnt lgkmcnt(0)" ::: "memory");
        }
        f32x2 y[PG][8];
#pragma unroll
        for (int n = 0; n < PG; ++n)
#pragma unroll
            for (int i = 0; i < 8; ++i) y[n][i] = (f32x2){0.f, 0.f};
        v4u UA[4], VA[4], UB[4], VB[4];
#define P2_LOAD(U_, V_, bi_, cc_) do { \
            _Pragma("unroll") for (int i_ = 0; i_ < 4; ++i_) { const int ix_ = (bi_) + ((i_ < (cc_)) ? i_ : (cc_) - 1); \
                const unsigned e_ = (unsigned)__builtin_amdgcn_readfirstlane(exl[ix_]); \
                U_[i_] = *(const v4u*)(U8 + (size_t)e_ * 1024 + 16 * lane); V_[i_] = *(const v4u*)(V8 + (size_t)e_ * 1024 + 16 * lane); } } while (0)
#define P2_VSIDE(V_, yy) do { _Pragma("unroll") for (int i_ = 0; i_ < 4; ++i_) { \
                const float ws_ = __builtin_bit_cast(float, __builtin_amdgcn_readlane(__builtin_bit_cast(int, w_), i_ * 16)); \
                const f32x2 w2_ = (f32x2){ws_, ws_}; \
                _Pragma("unroll") for (int q_ = 0; q_ < 4; ++q_) { const f32x2 lo_ = __builtin_amdgcn_cvt_pk_f32_fp8(V_[i_][q_], false), hi_ = __builtin_amdgcn_cvt_pk_f32_fp8(V_[i_][q_], true); \
                    yy[2 * q_] = __builtin_elementwise_fma(lo_, w2_, yy[2 * q_]); yy[2 * q_ + 1] = __builtin_elementwise_fma(hi_, w2_, yy[2 * q_ + 1]); } } } while (0)
#define P2_COMP(U_, V_, n_, bi_, cc_) do { \
            f32x2 xn[8]; \
            { const v4u xa_ = *(const LAS v4u*)(xnl + (n_) * 2048 + 32 * lane), xb_ = *(const LAS v4u*)(xnl + (n_) * 2048 + 32 * lane + 16); \
              _Pragma("unroll") for (int i_ = 0; i_ < 4; ++i_) { xn[i_] = (f32x2){bflo(xa_[i_]), bfhi(xa_[i_])}; xn[4 + i_] = (f32x2){bflo(xb_[i_]), bfhi(xb_[i_])}; } } \
            float a_[4]; \
            _Pragma("unroll") for (int i_ = 0; i_ < 4; ++i_) { f32x2 s_ = (f32x2){0.f, 0.f}; \
                _Pragma("unroll") for (int w4_ = 0; w4_ < 4; ++w4_) { const f32x2 lo_ = __builtin_amdgcn_cvt_pk_f32_fp8(U_[i_][w4_], false), hi_ = __builtin_amdgcn_cvt_pk_f32_fp8(U_[i_][w4_], true); \
                    s_ = __builtin_elementwise_fma(lo_, xn[2 * w4_], s_); s_ = __builtin_elementwise_fma(hi_, xn[2 * w4_ + 1], s_); } \
                a_[i_] = s_.x + s_.y; } \
              \
            float b_[2]; \
            _Pragma("unroll") for (int i_ = 0; i_ < 2; ++i_) { auto r_ = __builtin_amdgcn_permlane32_swap(__float_as_uint(a_[i_]), __float_as_uint(a_[i_ + 2]), false, false); b_[i_] = __uint_as_float(r_[0]) + __uint_as_float(r_[1]); } \
            float d_; { auto r_ = __builtin_amdgcn_permlane16_swap(__float_as_uint(b_[0]), __float_as_uint(b_[1]), false, false); d_ = __uint_as_float(r_[0]) + __uint_as_float(r_[1]); } \
            d_ += DPP_F(d_, 0xB1); d_ += DPP_F(d_, 0x4E); d_ += DPP_F(d_, 0x141); d_ += DPP_F(d_, 0x140); \
            const int lx_ = (bi_) + ((rho < (cc_)) ? rho : (cc_) - 1); \
            const float wv_ = gvl[lx_] * gelu1(d_ * sul[lx_]); \
            const float w_ = (rho < (cc_)) ? wv_ : 0.f; \
            if ((n_) == 0) P2_VSIDE(V_, y[0]); else if ((n_) == 1) P2_VSIDE(V_, y[1]); ; } while (0)
        int k = 0, n = -1, c = 0, cnt = 0, base = 0;
#define P2_NEXT(ok_) do { c += 4; ok_ = true; \
            if (c >= cnt) { for (;;) { ++n; if (n == PG) { n = 0; ++k; } if (k == 8) { ok_ = false; break; } \
                    const int r_ = (x0 + k) & 7; const int s0_ = __builtin_amdgcn_readfirstlane(ofl[n * 16 + r_]), s1_ = __builtin_amdgcn_readfirstlane(ofl[n * 16 + r_ + 1]); \
                    cnt = s1_ - s0_; if (cnt > 0) { base = n * 128 + s0_; c = 0; break; } } } } while (0)
        bool okA, okB;
        P2_NEXT(okA);
        int nA = n, biA = base + c, ccA = (cnt - c < 4) ? cnt - c : 4, nB = 0, biB = 0, ccB = 1;
        P2_LOAD(UA, VA, biA, ccA);
#pragma unroll 1
        for (;;) {
            P2_NEXT(okB);
            if (okB) { nB = n; biB = base + c; ccB = (cnt - c < 4) ? cnt - c : 4; P2_LOAD(UB, VB, biB, ccB); }
            P2_COMP(UA, VA, nA, biA, ccA);
            if (!okB) break;
            P2_NEXT(okA);
            if (okA) { nA = n; biA = base + c; ccA = (cnt - c < 4) ? cnt - c : 4; P2_LOAD(UA, VA, biA, ccA); }
            P2_COMP(UB, VB, nB, biB, ccB);
            if (!okA) break;
        }
#undef P2_LOAD
#undef P2_COMP
#undef P2_VSIDE
#undef P2_NEXT
#pragma unroll
        for (int nn = 0; nn < PG; ++nn) {
            const int t = grp * PG + nn;
            const bf16* hp = HB + (size_t)t * 1024 + 16 * lane;
            const v4u hr0 = *(const v4u*)hp, hr1 = *(const v4u*)(hp + 8);
            f32x4 o[4]; float s2 = 0.f;
#pragma unroll
            for (int i = 0; i < 4; ++i) { const f32x4 hr = (i == 0) ? bf4lo(hr0) : (i == 1) ? bf4hi(hr0) : (i == 2) ? bf4lo(hr1) : bf4hi(hr1);
                o[i] = hr + (f32x4){y[nn][2 * i].x, y[nn][2 * i].y, y[nn][2 * i + 1].x, y[nn][2 * i + 1].y}; s2 += (o[i][0] * o[i][0] + o[i][1] * o[i][1]) + (o[i][2] * o[i][2] + o[i][3] * o[i][3]); }
            const float rf = 1.0f / sqrtf(wave_sum(s2) * (1.f / 1024.f) + EPS_);
            float* op = OUT + (size_t)t * 1024 + 16 * lane;
#pragma unroll
            for (int i = 0; i < 4; ++i) *(f32x4*)(op + 4 * i) = o[i] * rf * *(const f32x4*)(gfin + 16 * lane + 4 * i);
            asm volatile("" ::: "memory");
        }
    }
}

__device__ __forceinline__ void peer_phase3(Frame& F, const Args& A) {
    const unsigned char* U8 = A.ws + WS_UT; const unsigned char* V8 = A.ws + WS_VT;
    const float* SUs = (const float*)(A.ws + WS_UT + 16 * MiB); const float* SVs = (const float*)(A.ws + WS_VT + 16 * MiB);
    const float* SC = (const float*)(A.ws + WS_SC); float* OUT = A.out;
    const int lane = F.lane, gw = F.bid * NWAVES + F.wave, NGW = F.G * NWAVES;
    LAS unsigned char* wl = F.lds + F.wave * 8192;
    LAS unsigned* kl = (LAS unsigned*)wl;
    LAS unsigned char* xnl = wl + 1024;
    LAS int* exl = (LAS int*)(wl + 1024 + 4096);
    LAS float* sul = (LAS float*)(wl + 1024 + 4096 + 1024);
    LAS float* gvl = (LAS float*)(wl + 1024 + 4096 + 2048);
    const float* g2 = A.in[15]; const float* gfin = A.in[20];
    const bf16* HB = WSP(A, WS_XN);
#define OPQ(v_) ({ unsigned o_ = (unsigned)(v_); asm volatile("" : "+v"(o_)); o_; })
    const int li = lane & 15, rho = lane >> 4;
    const int eidx = (rho & 1) + 2 * ((lane >> 3) & 1) + 4 * (rho >> 1);
    const int x0 = ((int)xb_xcc_id() & 7) * (PEER_NR / 8);
    for (int grp = gw; grp < T_ / 2; grp += NGW) {
#if PEER_XSYNC
        {
            __syncthreads();
            if (F.wave == 0 && lane == 0) { unsigned* xsync = (unsigned*)(A.ws + WS_CTL + 32768) + 64 * (xb_xcc_id() & 15);
                const unsigned nloc = ((volatile LAS unsigned*)(F.lds + LDS_MISC))[0], want = nloc * (unsigned)((grp - gw) / NGW + 1);
                __hip_atomic_fetch_add(xsync, 1u, __ATOMIC_RELAXED, __HIP_MEMORY_SCOPE_AGENT); unsigned sp = 0;
                while (__hip_atomic_load(xsync, __ATOMIC_RELAXED, __HIP_MEMORY_SCOPE_AGENT) < want && ++sp < 20000u) __builtin_amdgcn_s_sleep(2); }
            __syncthreads(); }
#endif
#pragma unroll 1
        for (int n = 0; n < 2; ++n) {
            const int t = grp * 2 + n;
            const bf16* hp = (const bf16*)((const char*)(HB + (size_t)t * 1024) + OPQ(32 * lane));
            f32x4 hv[4];
            { const v4u h0 = *(const v4u*)hp, h1 = *(const v4u*)(hp + 8); hv[0] = bf4lo(h0); hv[1] = bf4hi(h0); hv[2] = bf4lo(h1); hv[3] = bf4hi(h1); }
            float ss = 0.f;
#pragma unroll
            for (int i = 0; i < 4; ++i) ss += (hv[i][0] * hv[i][0] + hv[i][1] * hv[i][1]) + (hv[i][2] * hv[i][2] + hv[i][3] * hv[i][3]);
            const float rstd2 = 1.0f / sqrtf(wave_sum(ss) * (1.f / 1024.f) + EPS_);
            {
                v4u xa, xb;
#pragma unroll
                for (int i = 0; i < 4; ++i) { const f32x4 gg = *(const f32x4*)((const char*)g2 + OPQ(64 * lane) + 16 * i);
                    const unsigned p0 = pk2(hv[i][0] * rstd2 * gg[0], hv[i][1] * rstd2 * gg[1]), p1 = pk2(hv[i][2] * rstd2 * gg[2], hv[i][3] * rstd2 * gg[3]);
                    if (i < 2) { xa[2 * i] = p0; xa[2 * i + 1] = p1; } else { xb[2 * (i - 2)] = p0; xb[2 * (i - 2) + 1] = p1; } }
                *(LAS v4u*)(xnl + n * 2048 + 32 * lane) = xa; *(LAS v4u*)(xnl + n * 2048 + 32 * lane + 16) = xb;
            }
            const float* sp = SC + (size_t)t * 2048;
#pragma unroll 1
            for (int r = 0; r < 4; ++r) {
                const int gi = 4 * r + rho;
                const float* spg = (const float*)((const char*)sp + OPQ((gi * 128 + 8 * li) * 4));
                const f32x4 s0 = *(const f32x4*)spg, s1 = *(const f32x4*)(spg + 4);
                unsigned k0 = (fkey(s0[0]) & ~127u) | (unsigned)(127 - (8 * li + 0)), k1 = (fkey(s0[1]) & ~127u) | (unsigned)(127 - (8 * li + 1)),
                         k2 = (fkey(s0[2]) & ~127u) | (unsigned)(127 - (8 * li + 2)), k3 = (fkey(s0[3]) & ~127u) | (unsigned)(127 - (8 * li + 3)),
                         k4 = (fkey(s1[0]) & ~127u) | (unsigned)(127 - (8 * li + 4)), k5 = (fkey(s1[1]) & ~127u) | (unsigned)(127 - (8 * li + 5)),
                         k6 = (fkey(s1[2]) & ~127u) | (unsigned)(127 - (8 * li + 6)), k7 = (fkey(s1[3]) & ~127u) | (unsigned)(127 - (8 * li + 7));
                CEX(k0, k1); CEX(k2, k3); CEX(k4, k5); CEX(k6, k7);
                CEX(k0, k2); CEX(k1, k3); CEX(k4, k6); CEX(k5, k7);
                CEX(k1, k2); CEX(k5, k6); CEX(k0, k4); CEX(k3, k7);
                CEX(k1, k5); CEX(k2, k6);
                CEX(k1, k4); CEX(k3, k6);
                CEX(k2, k4); CEX(k3, k5);
                CEX(k3, k4);
                unsigned rec = 0u;
#pragma unroll
                for (int itx = 0; itx < 16; ++itx) {
                    const unsigned mk = rowmax16_u(k0);
                    rec = (li == itx) ? mk : rec;
                    const bool own = (k0 == mk);
                    k0 = own ? k1 : k0; k1 = own ? k2 : k1; k2 = own ? k3 : k2; k3 = own ? k4 : k3; k4 = own ? k5 : k4; k5 = own ? k6 : k5; k6 = own ? k7 : k6; k7 = own ? 0u : k7;
                }
                kl[gi * 16 + li] = rec;
            }
            asm volatile("s_waitcnt lgkmcnt(0)" ::: "memory");
            {
                const int hh = lane >> 3, q8 = lane & 7;
                unsigned c[7];
#pragma unroll
                for (int mth = 0; mth < 7; ++mth) {
                    const int cid = q8 + 8 * mth; const unsigned ij = CAND_IJ[cid];
                    if (ij == 0xffu) { c[mth] = 0u; }
                    else { const unsigned ka = kl[(2 * hh) * 16 + (ij >> 4)], kb = kl[(2 * hh + 1) * 16 + (ij & 15)];
                           const float sum = keyf(ka & ~127u) + keyf(kb & ~127u);
                           c[mth] = (fkey(sum) & ~63u) | (unsigned)(63 - cid); }
                }
                CEX(c[0], c[6]); CEX(c[2], c[3]); CEX(c[4], c[5]);
                CEX(c[0], c[2]); CEX(c[1], c[4]); CEX(c[3], c[6]);
                CEX(c[0], c[1]); CEX(c[2], c[5]); CEX(c[3], c[4]);
                CEX(c[1], c[2]); CEX(c[4], c[6]);
                CEX(c[2], c[3]); CEX(c[4], c[5]);
                CEX(c[1], c[2]); CEX(c[3], c[4]); CEX(c[5], c[6]);
                unsigned rec0 = 0u, rec1 = 0u;
#pragma unroll
                for (int itx = 0; itx < 16; ++itx) {
                    const unsigned mk = grpmax8_u(c[0]);
                    if (itx < 8) rec0 = (q8 == itx) ? mk : rec0; else rec1 = (q8 == itx - 8) ? mk : rec1;
                    const bool own = (c[0] == mk);
                    c[0] = own ? c[1] : c[0]; c[1] = own ? c[2] : c[1]; c[2] = own ? c[3] : c[2]; c[3] = own ? c[4] : c[3]; c[4] = own ? c[5] : c[4]; c[5] = own ? c[6] : c[5]; c[6] = own ? 0u : c[6];
                }
                const int cid0 = 63 - (int)(rec0 & 63u), cid1 = 63 - (int)(rec1 & 63u);
                const unsigned ij0 = CAND_IJ[cid0], ij1 = CAND_IJ[cid1];
                const int e0r = (127 - (int)(kl[(2 * hh) * 16 + (ij0 >> 4)] & 127u)) * 128 + (127 - (int)(kl[(2 * hh + 1) * 16 + (ij0 & 15)] & 127u));
                const int e1r = (127 - (int)(kl[(2 * hh) * 16 + (ij1 >> 4)] & 127u)) * 128 + (127 - (int)(kl[(2 * hh + 1) * 16 + (ij1 & 15)] & 127u));
                const int e0 = e0r, e1 = e1r;
                const float su0 = SUs[e0], su1 = SUs[e1], sv0 = SVs[e0], sv1 = SVs[e1];
                const float v0 = keyf(rec0 & ~63u) * rstd2, v1 = keyf(rec1 & ~63u) * rstd2;
                const float mx = grpmax8_f(fmaxf(v0, v1));
                const float x0e = __expf(v0 - mx), x1e = __expf(v1 - mx);
                const float inv = 1.0f / grpsum8_f(x0e + x1e);
                const int r0 = ((e0 / (16384 / PEER_NR)) - x0) & (PEER_NR - 1), r1 = ((e1 / (16384 / PEER_NR)) - x0) & (PEER_NR - 1); int pos0 = 0, pos1 = 0, start = 0;
#pragma unroll
                for (int r = 0; r < PEER_NR; ++r) {
                    const unsigned long long m0 = __ballot(r0 == r), m1 = __ballot(r1 == r);
                    const int c0 = __popcll(m0), c1 = __popcll(m1);
                    const int b0 = (int)__builtin_amdgcn_mbcnt_hi((unsigned)(m0 >> 32), __builtin_amdgcn_mbcnt_lo((unsigned)m0, 0u));
                    const int b1 = (int)__builtin_amdgcn_mbcnt_hi((unsigned)(m1 >> 32), __builtin_amdgcn_mbcnt_lo((unsigned)m1, 0u));
                    pos0 = (r0 == r) ? start + b0 : pos0; pos1 = (r1 == r) ? start + c0 + b1 : pos1;
                    start += c0 + c1;
                }
                exl[n * 128 + pos0] = e0; exl[n * 128 + pos1] = e1;
                sul[n * 128 + pos0] = su0; sul[n * 128 + pos1] = su1;
                gvl[n * 128 + pos0] = x0e * inv * sv0; gvl[n * 128 + pos1] = x1e * inv * sv1;
            }
            asm volatile("s_waitcnt lgkmcnt(0)" ::: "memory");
        }
        unsigned xn0[8], xn1[8];
        { const v4u a0 = *(const LAS v4u*)(xnl + 32 * lane), a1 = *(const LAS v4u*)(xnl + 32 * lane + 16), b0 = *(const LAS v4u*)(xnl + 2048 + 32 * lane), b1 = *(const LAS v4u*)(xnl + 2048 + 32 * lane + 16);
#pragma unroll
          for (int i = 0; i < 4; ++i) { xn0[i] = a0[i]; xn0[4 + i] = a1[i]; xn1[i] = b0[i]; xn1[4 + i] = b1[i]; } }
        f32x2 y0[8], y1[8];
#pragma unroll
        for (int i = 0; i < 8; ++i) { y0[i] = (f32x2){0.f, 0.f}; y1[i] = (f32x2){0.f, 0.f}; }
        v4u UA[8], VA[8], UB[8], VB[8];
#define P3_LOAD(U_, V_, li0_) do { \
            const v4u ea_ = *(const LAS v4u*)(exl + (li0_)), eb_ = *(const LAS v4u*)(exl + (li0_) + 4); \
            _Pragma("unroll") for (int i_ = 0; i_ < 8; ++i_) { const unsigned e_ = (unsigned)__builtin_amdgcn_readfirstlane((int)(i_ < 4 ? ea_[i_ & 3] : eb_[i_ & 3])); \
                const unsigned l16_ = OPQ(16 * lane); \
                U_[i_] = *(const v4u*)(U8 + (size_t)e_ * 1024 + l16_); V_[i_] = *(const v4u*)(V8 + (size_t)e_ * 1024 + l16_); } } while (0)
#define P3_COMP(U_, V_, li0_, xn_, y_) do { \
            float a_[8]; \
            _Pragma("unroll") for (int i_ = 0; i_ < 8; ++i_) { float s_ = 0.f; \
                _Pragma("unroll") for (int w4_ = 0; w4_ < 4; ++w4_) { \
                    s_ = __builtin_amdgcn_fdot2_f32_bf16(__builtin_amdgcn_cvt_scalef32_pk_bf16_fp8(U_[i_][w4_], 1.0f, false), __builtin_bit_cast(bf16x2_t, xn_[2 * w4_]), s_, false); \
                    s_ = __builtin_amdgcn_fdot2_f32_bf16(__builtin_amdgcn_cvt_scalef32_pk_bf16_fp8(U_[i_][w4_], 1.0f, true), __builtin_bit_cast(bf16x2_t, xn_[2 * w4_ + 1]), s_, false); } \
                a_[i_] = s_; } \
            float b_[4]; \
            _Pragma("unroll") for (int i_ = 0; i_ < 4; ++i_) { auto r_ = __builtin_amdgcn_permlane32_swap(__float_as_uint(a_[i_]), __float_as_uint(a_[i_ + 4]), false, false); b_[i_] = __uint_as_float(r_[0]) + __uint_as_float(r_[1]); } \
            float c_[2]; \
            _Pragma("unroll") for (int i_ = 0; i_ < 2; ++i_) { auto r_ = __builtin_amdgcn_permlane16_swap(__float_as_uint(b_[2 * i_]), __float_as_uint(b_[2 * i_ + 1]), false, false); c_[i_] = __uint_as_float(r_[0]) + __uint_as_float(r_[1]); } \
            c_[0] += DPP_F(c_[0], 0x128); c_[1] += DPP_F(c_[1], 0x128); \
            float d_ = (lane & 8) ? c_[1] : c_[0]; \
            d_ += DPP_F(d_, 0xB1); d_ += DPP_F(d_, 0x4E); d_ += DPP_F(d_, 0x141); \
            const float w_ = gvl[(li0_) + eidx] * gelu1(d_ * sul[(li0_) + eidx]); \
            if (DBG_LIST && (lane & 7) == 0) { ((v2u*)(A.ws + WS_SV))[(size_t)(grp * 2) * 128 + (li0_) + eidx] = (v2u){(unsigned)exl[(li0_) + eidx], __float_as_uint(DBG_LIST == 3 ? 0.f : w_)}; } \
            _Pragma("unroll") for (int i_ = 0; i_ < 8; ++i_) { \
                const float ws_ = __builtin_bit_cast(float, __builtin_amdgcn_readlane(__builtin_bit_cast(int, w_), ((i_ & 1) + 2 * (i_ >> 2)) * 16 + ((i_ >> 1) & 1) * 8)); \
                const f32x2 w2_ = (f32x2){ws_, ws_}; \
                _Pragma("unroll") for (int q_ = 0; q_ < 4; ++q_) { const f32x2 lo_ = __builtin_amdgcn_cvt_pk_f32_fp8(V_[i_][q_], false), hi_ = __builtin_amdgcn_cvt_pk_f32_fp8(V_[i_][q_], true); \
                    y_[2 * q_] = __builtin_elementwise_fma(lo_, w2_, y_[2 * q_]); y_[2 * q_ + 1] = __builtin_elementwise_fma(hi_, w2_, y_[2 * q_ + 1]); } } } while (0)
        P3_LOAD(UA, VA, 0);
#pragma unroll 1
        for (int ch = 0; ch < 16; ++ch) {
            P3_LOAD(UB, VB, 128 + ch * 8);
            P3_COMP(UA, VA, ch * 8, xn0, y0);
            if (ch + 1 < 16) P3_LOAD(UA, VA, (ch + 1) * 8);
            P3_COMP(UB, VB, 128 + ch * 8, xn1, y1);
        }
#undef P3_LOAD
#undef P3_COMP
#pragma unroll
        for (int nn = 0; nn < 2; ++nn) {
            const int t = grp * 2 + nn;
            const bf16* hp = (const bf16*)((const char*)(HB + (size_t)t * 1024) + OPQ(32 * lane));
            const v4u hr0 = *(const v4u*)hp, hr1 = *(const v4u*)(hp + 8);
            f32x4 o[4]; float s2 = 0.f;
#pragma unroll
            for (int i = 0; i < 4; ++i) { const f32x4 hr = (i == 0) ? bf4lo(hr0) : (i == 1) ? bf4hi(hr0) : (i == 2) ? bf4lo(hr1) : bf4hi(hr1);
                const f32x2 ya = nn ? y1[2 * i] : y0[2 * i], yb = nn ? y1[2 * i + 1] : y0[2 * i + 1];
                o[i] = hr + (f32x4){ya.x, ya.y, yb.x, yb.y}; s2 += (o[i][0] * o[i][0] + o[i][1] * o[i][1]) + (o[i][2] * o[i][2] + o[i][3] * o[i][3]); }
            const float rf = 1.0f / sqrtf(wave_sum(s2) * (1.f / 1024.f) + EPS_);
            float* op = (float*)((char*)(OUT + (size_t)t * 1024) + OPQ(64 * lane));
            const float* gp = (const float*)((const char*)gfin + OPQ(64 * lane));
#pragma unroll
            for (int i = 0; i < 4; ++i) *(f32x4*)(op + 4 * i) = o[i] * rf * *(const f32x4*)(gp + 4 * i);
            asm volatile("" ::: "memory");
        }
    }
}

__device__ __forceinline__ void peer_u_phase(Frame& F, const Args& A) {
    const unsigned char* U8 = A.ws + WS_UT; const unsigned char* V8 = A.ws + WS_VT;
    const float* SUs = (const float*)(A.ws + WS_UT + 16 * MiB); const float* SVs = (const float*)(A.ws + WS_VT + 16 * MiB);
    const float* SC = (const float*)(A.ws + WS_SC); float* OUT = A.out;
    const int lane = F.lane, gw = F.bid * NWAVES + F.wave, NGW = F.G * NWAVES;
    LAS unsigned char* wl = F.lds + F.wave * 16384;
    LAS unsigned* kl = (LAS unsigned*)wl;
    LAS unsigned char* xnl = wl + 1024;
    LAS int* exl = (LAS int*)(wl + 1024 + 8192);
    LAS float* sul = (LAS float*)(wl + 1024 + 8192 + 2048);
    LAS float* gvl = (LAS float*)(wl + 1024 + 8192 + 4096);
    const float* g2 = A.in[15]; const float* gfin = A.in[20];
    const bf16* HB = WSP(A, WS_XN);
#define OPQ(v_) ({ unsigned o_ = (unsigned)(v_); asm volatile("" : "+v"(o_)); o_; })
    const int li = lane & 15, rho = lane >> 4;
    const int eidx = (rho & 1) + 2 * ((lane >> 3) & 1) + 4 * (rho >> 1);
    const int x0 = ((int)xb_xcc_id() & 7) * (PEER_NR / 8);
    const int ngrp = peer_ngrp(F);
    if (PEER_U_DELAY > 0 && F.wave >= 4) {
        const unsigned long long t0_ = __builtin_amdgcn_s_memrealtime(); while (__builtin_amdgcn_s_memrealtime() - t0_ < (unsigned long long)(PEER_U_DELAY * 100)) __builtin_amdgcn_s_sleep(8); }
    for (int gj = 0; gj < ngrp; ++gj) { const int grp = peer_grp(F, gj);
#pragma unroll 1
        for (int n = 0; n < 4; ++n) {
            const int t = grp * 4 + n;
            const bf16* hp = (const bf16*)((const char*)(HB + (size_t)t * 1024) + OPQ(32 * lane));
            f32x4 hv[4];
            { const v4u h0 = *(const v4u*)hp, h1 = *(const v4u*)(hp + 8); hv[0] = bf4lo(h0); hv[1] = bf4hi(h0); hv[2] = bf4lo(h1); hv[3] = bf4hi(h1); }
            float ss = 0.f;
#pragma unroll
            for (int i = 0; i < 4; ++i) ss += (hv[i][0] * hv[i][0] + hv[i][1] * hv[i][1]) + (hv[i][2] * hv[i][2] + hv[i][3] * hv[i][3]);
            const float rstd2 = 1.0f / sqrtf(wave_sum(ss) * (1.f / 1024.f) + EPS_);
            float sxn;
            {
                f32x4 xf[4]; float am = 0.f;
#pragma unroll
                for (int i = 0; i < 4; ++i) { const f32x4 gg = *(const f32x4*)((const char*)g2 + OPQ(64 * lane) + 16 * i); xf[i] = hv[i] * rstd2 * gg;
                    am = fmaxf(am, fmaxf(fmaxf(fabsf(xf[i][0]), fabsf(xf[i][1])), fmaxf(fabsf(xf[i][2]), fabsf(xf[i][3])))); }
                am = wave_max(am);
                const float qs = am > 0.f ? 127.0f / am : 1.0f; sxn = am > 0.f ? am * (1.0f / 127.0f) : 1.0f;
                v4u xq;
#pragma unroll
                for (int i = 0; i < 4; ++i) { const int q0 = __float2int_rn(xf[i][0] * qs), q1 = __float2int_rn(xf[i][1] * qs), q2 = __float2int_rn(xf[i][2] * qs), q3 = __float2int_rn(xf[i][3] * qs);
                    xq[i] = (unsigned)(q0 & 0xff) | ((unsigned)(q1 & 0xff) << 8) | ((unsigned)(q2 & 0xff) << 16) | ((unsigned)(q3 & 0xff) << 24); }
                *(LAS v4u*)(xnl + n * 2048 + 16 * lane) = xq;
            }
            const unsigned short* sp = sc_row(A, t);
#define L1_KEYS(k_, w_) \
                unsigned k_##0 = (fkeyb(w_[0] << 16) & 0xffff0000u) | (unsigned)(127 - (8 * li + 0)), k_##1 = (fkeyb(w_[0] & 0xffff0000u) & 0xffff0000u) | (unsigned)(127 - (8 * li + 1)), \
                         k_##2 = (fkeyb(w_[1] << 16) & 0xffff0000u) | (unsigned)(127 - (8 * li + 2)), k_##3 = (fkeyb(w_[1] & 0xffff0000u) & 0xffff0000u) | (unsigned)(127 - (8 * li + 3)), \
                         k_##4 = (fkeyb(w_[2] << 16) & 0xffff0000u) | (unsigned)(127 - (8 * li + 4)), k_##5 = (fkeyb(w_[2] & 0xffff0000u) & 0xffff0000u) | (unsigned)(127 - (8 * li + 5)), \
                         k_##6 = (fkeyb(w_[3] << 16) & 0xffff0000u) | (unsigned)(127 - (8 * li + 6)), k_##7 = (fkeyb(w_[3] & 0xffff0000u) & 0xffff0000u) | (unsigned)(127 - (8 * li + 7)); \
                CEX(k_##0, k_##1); CEX(k_##2, k_##3); CEX(k_##4, k_##5); CEX(k_##6, k_##7); \
                CEX(k_##0, k_##2); CEX(k_##1, k_##3); CEX(k_##4, k_##6); CEX(k_##5, k_##7); \
                CEX(k_##1, k_##2); CEX(k_##5, k_##6); CEX(k_##0, k_##4); CEX(k_##3, k_##7); \
                CEX(k_##1, k_##5); CEX(k_##2, k_##6); \
                CEX(k_##1, k_##4); CEX(k_##3, k_##6); \
                CEX(k_##2, k_##4); CEX(k_##3, k_##5); \
                CEX(k_##3, k_##4);
#define L1_STEP(k_, rec_, itx_) { const unsigned mk_ = rowmax16_u(k_##0); rec_ = (li == (itx_)) ? mk_ : rec_; const bool own_ = (k_##0 == mk_); \
                    k_##0 = own_ ? k_##1 : k_##0; k_##1 = own_ ? k_##2 : k_##1; k_##2 = own_ ? k_##3 : k_##2; k_##3 = own_ ? k_##4 : k_##3; k_##4 = own_ ? k_##5 : k_##4; k_##5 = own_ ? k_##6 : k_##5; k_##6 = own_ ? k_##7 : k_##6; k_##7 = own_ ? 0u : k_##7; }
            {
                const unsigned short* spa = (const unsigned short*)((const char*)sp + OPQ(((0 + rho) * 128 + 8 * li) * 2));
                const v4u sa = *(const v4u*)spa, sb = *(const v4u*)(spa + 512), sc = *(const v4u*)(spa + 1024), sd = *(const v4u*)(spa + 1536);
                L1_KEYS(ka, sa) L1_KEYS(kb, sb) L1_KEYS(kc, sc) L1_KEYS(kd, sd)
                unsigned reca = 0u, recb = 0u, recc = 0u, recd = 0u;
#pragma unroll
                for (int itx = 0; itx < 16; ++itx) { L1_STEP(ka, reca, itx) L1_STEP(kb, recb, itx) L1_STEP(kc, recc, itx) L1_STEP(kd, recd, itx) }
                LAS unsigned* kln = (LAS unsigned*)(xnl + n * 2048 + 1024);
                kln[(0 + rho) * 16 + li] = reca; kln[(4 + rho) * 16 + li] = recb; kln[(8 + rho) * 16 + li] = recc; kln[(12 + rho) * 16 + li] = recd;
                if (lane == 0) { ((LAS float*)wl)[2 * n] = rstd2; ((LAS float*)wl)[2 * n + 1] = sxn; }
            }
#undef L1_KEYS
#undef L1_STEP
        }
        asm volatile("s_waitcnt lgkmcnt(0)" ::: "memory");
        {
            const int hh = lane >> 3, q8 = lane & 7;
            unsigned c[4][7], rec0[4], rec1[4];
#pragma unroll
            for (int n = 0; n < 4; ++n) {
                const LAS unsigned* kln = (const LAS unsigned*)(xnl + n * 2048 + 1024);
#pragma unroll
                for (int mth = 0; mth < 7; ++mth) {
                    const int cid = q8 + 8 * mth; const unsigned ij = CAND_IJ[cid];
                    if (ij == 0xffu) { c[n][mth] = 0u; }
                    else { const unsigned ka = kln[(2 * hh) * 16 + (ij >> 4)], kb = kln[(2 * hh + 1) * 16 + (ij & 15)];
                           const float sum = hkeyf(ka) + hkeyf(kb);
                           c[n][mth] = (fkey(sum) & ~63u) | (unsigned)(63 - cid); }
                }
                CEX(c[n][0], c[n][6]); CEX(c[n][2], c[n][3]); CEX(c[n][4], c[n][5]);
                CEX(c[n][0], c[n][2]); CEX(c[n][1], c[n][4]); CEX(c[n][3], c[n][6]);
                CEX(c[n][0], c[n][1]); CEX(c[n][2], c[n][5]); CEX(c[n][3], c[n][4]);
                CEX(c[n][1], c[n][2]); CEX(c[n][4], c[n][6]);
                CEX(c[n][2], c[n][3]); CEX(c[n][4], c[n][5]);
                CEX(c[n][1], c[n][2]); CEX(c[n][3], c[n][4]); CEX(c[n][5], c[n][6]);
                rec0[n] = 0u; rec1[n] = 0u;
            }
#pragma unroll
            for (int itx = 0; itx < 16; ++itx) {
#pragma unroll
                for (int n = 0; n < 4; ++n) {
                    const unsigned mk = grpmax8_u(c[n][0]);
                    if (itx < 8) rec0[n] = (q8 == itx) ? mk : rec0[n]; else rec1[n] = (q8 == itx - 8) ? mk : rec1[n];
                    const bool own = (c[n][0] == mk);
                    c[n][0] = own ? c[n][1] : c[n][0]; c[n][1] = own ? c[n][2] : c[n][1]; c[n][2] = own ? c[n][3] : c[n][2]; c[n][3] = own ? c[n][4] : c[n][3]; c[n][4] = own ? c[n][5] : c[n][4]; c[n][5] = own ? c[n][6] : c[n][5]; c[n][6] = own ? 0u : c[n][6];
                }
            }
#pragma unroll
            for (int n = 0; n < 4; ++n) {
                const LAS unsigned* kln = (const LAS unsigned*)(xnl + n * 2048 + 1024);
                const float rstd2 = ((const LAS float*)wl)[2 * n], sxn = ((const LAS float*)wl)[2 * n + 1];
                const int cid0 = 63 - (int)(rec0[n] & 63u), cid1 = 63 - (int)(rec1[n] & 63u);
                const unsigned ij0 = CAND_IJ[cid0], ij1 = CAND_IJ[cid1];
                const int e0 = (127 - (int)(kln[(2 * hh) * 16 + (ij0 >> 4)] & 127u)) * 128 + (127 - (int)(kln[(2 * hh + 1) * 16 + (ij0 & 15)] & 127u));
                const int e1 = (127 - (int)(kln[(2 * hh) * 16 + (ij1 >> 4)] & 127u)) * 128 + (127 - (int)(kln[(2 * hh + 1) * 16 + (ij1 & 15)] & 127u));
                const float su0 = SUs[e0], su1 = SUs[e1], sv0 = SVs[e0], sv1 = SVs[e1];
                const float v0 = keyf(rec0[n] & ~63u) * rstd2, v1 = keyf(rec1[n] & ~63u) * rstd2;
                const float mx = grpmax8_f(fmaxf(v0, v1));
                const float x0e = __expf(v0 - mx), x1e = __expf(v1 - mx);
                const float inv = 1.0f / grpsum8_f(x0e + x1e);
                const int r0 = ((e0 / (16384 / PEER_NR)) - x0) & (PEER_NR - 1), r1 = ((e1 / (16384 / PEER_NR)) - x0) & (PEER_NR - 1); int pos0 = 0, pos1 = 0, start = 0;
#pragma unroll
                for (int r = 0; r < PEER_NR; ++r) {
                    const unsigned long long m0 = __ballot(r0 == r), m1 = __ballot(r1 == r);
                    const int c0 = __popcll(m0), c1 = __popcll(m1);
                    const int b0 = (int)__builtin_amdgcn_mbcnt_hi((unsigned)(m0 >> 32), __builtin_amdgcn_mbcnt_lo((unsigned)m0, 0u));
                    const int b1 = (int)__builtin_amdgcn_mbcnt_hi((unsigned)(m1 >> 32), __builtin_amdgcn_mbcnt_lo((unsigned)m1, 0u));
                    pos0 = (r0 == r) ? start + b0 : pos0; pos1 = (r1 == r) ? start + c0 + b1 : pos1;
                    start += c0 + c1;
                }
                exl[n * 128 + pos0] = e0; exl[n * 128 + pos1] = e1;
                sul[n * 128 + pos0] = su0 * sxn; sul[n * 128 + pos1] = su1 * sxn;
                gvl[n * 128 + pos0] = x0e * inv * sv0; gvl[n * 128 + pos1] = x1e * inv * sv1;
            }
        }
        asm volatile("s_waitcnt lgkmcnt(0)" ::: "memory");
        const v4u xn0 = *(const LAS v4u*)(xnl + 16 * lane), xn1 = *(const LAS v4u*)(xnl + 2048 + 16 * lane), xn2 = *(const LAS v4u*)(xnl + 4096 + 16 * lane), xn3 = *(const LAS v4u*)(xnl + 6144 + 16 * lane);
        v4u U0[8], U1[8], U2[8], U3[8];
#define PU_LOAD(U_, li0_) do { \
            const v4u ea_ = *(const LAS v4u*)(exl + (li0_)), eb_ = *(const LAS v4u*)(exl + (li0_) + 4); \
            _Pragma("unroll") for (int i_ = 0; i_ < 8; ++i_) { const unsigned e_ = (unsigned)__builtin_amdgcn_readfirstlane((int)(i_ < 4 ? ea_[i_ & 3] : eb_[i_ & 3])); \
                U_[i_] = *(const v4u*)(U8 + (size_t)e_ * 1024 + OPQ(16 * lane)); } } while (0)
#define PU_COMP(U_, li0_, xn_) do { \
            int a_[8]; \
            _Pragma("unroll") for (int i_ = 0; i_ < 8; ++i_) { int s_ = 0; \
                _Pragma("unroll") for (int w4_ = 0; w4_ < 4; ++w4_) s_ = __builtin_amdgcn_sdot4((int)U_[i_][w4_], (int)xn_[w4_], s_, false); \
                a_[i_] = s_; } \
            int b_[4]; \
            _Pragma("unroll") for (int i_ = 0; i_ < 4; ++i_) { auto r_ = __builtin_amdgcn_permlane32_swap((unsigned)a_[i_], (unsigned)a_[i_ + 4], false, false); b_[i_] = (int)r_[0] + (int)r_[1]; } \
            int c_[2]; \
            _Pragma("unroll") for (int i_ = 0; i_ < 2; ++i_) { auto r_ = __builtin_amdgcn_permlane16_swap((unsigned)b_[2 * i_], (unsigned)b_[2 * i_ + 1], false, false); c_[i_] = (int)r_[0] + (int)r_[1]; } \
            c_[0] += (int)DPP_U(c_[0], 0x128); c_[1] += (int)DPP_U(c_[1], 0x128); \
            int di_ = (lane & 8) ? c_[1] : c_[0]; \
            di_ += (int)DPP_U(di_, 0xB1); di_ += (int)DPP_U(di_, 0x4E); di_ += (int)DPP_U(di_, 0x141); \
            const float d_ = (float)di_; \
            const float w_ = gvl[(li0_) + eidx] * gelu1(d_ * sul[(li0_) + eidx]); \
            if ((lane & 7) == 0) gvl[(li0_) + eidx] = w_; } while (0)
        PU_LOAD(U0, 0); PU_LOAD(U1, 128); PU_LOAD(U2, 256); PU_LOAD(U3, 384);
#pragma unroll 1
        for (int ch = 0; ch < 15; ++ch) {
            PU_COMP(U0, ch * 8, xn0);       PU_LOAD(U0, (ch + 1) * 8);
            PU_COMP(U1, 128 + ch * 8, xn1); PU_LOAD(U1, 128 + (ch + 1) * 8);
            PU_COMP(U2, 256 + ch * 8, xn2); PU_LOAD(U2, 256 + (ch + 1) * 8);
            PU_COMP(U3, 384 + ch * 8, xn3); PU_LOAD(U3, 384 + (ch + 1) * 8);
        }
        PU_COMP(U0, 120, xn0); PU_COMP(U1, 248, xn1); PU_COMP(U2, 376, xn2); PU_COMP(U3, 504, xn3);
#undef PU_LOAD
#undef PU_COMP
        asm volatile("s_waitcnt lgkmcnt(0)" ::: "memory");
#pragma unroll
        for (int n = 0; n < 4; ++n) { v2u* lp = lst_row(A, grp * 4 + n);
            ((v4u*)lp)[lane] = (v4u){(unsigned)exl[n * 128 + 2 * lane], __float_as_uint(gvl[n * 128 + 2 * lane]), (unsigned)exl[n * 128 + 2 * lane + 1], __float_as_uint(gvl[n * 128 + 2 * lane + 1])}; }
        asm volatile("s_waitcnt lgkmcnt(0)" ::: "memory");
    }
}

__device__ __forceinline__ void peer_v_phase(Frame& F, const Args& A) {
    const unsigned char* V8 = A.ws + WS_VT; float* OUT = A.out;
    const int lane = F.lane, gw = F.bid * NWAVES + F.wave, NGW = F.G * NWAVES;
    LAS unsigned char* wl = F.lds + F.wave * 4096;
    LAS int* exl = (LAS int*)wl;
    LAS float* wgl = (LAS float*)(wl + 2048);
    const float* gfin = A.in[20];
    const bf16* HB = WSP(A, WS_XN);
    static_assert(PVT == 4, "the v pass walks the u pass's groups of four tokens");
    const int ngrp = peer_ngrp(F);
    for (int gj = 0; gj < ngrp; ++gj) { const int grp = peer_grp(F, gj);
#pragma unroll
        for (int n = 0; n < PVT; ++n) { const v4u rr = ((const v4u*)lst_row(A, grp * PVT + n))[lane];
            exl[n * 128 + 2 * lane] = (int)rr.x; wgl[n * 128 + 2 * lane] = __uint_as_float(rr.y); exl[n * 128 + 2 * lane + 1] = (int)rr.z; wgl[n * 128 + 2 * lane + 1] = __uint_as_float(rr.w); }
        asm volatile("s_waitcnt lgkmcnt(0)" ::: "memory");
        f32x2 y0[8], y1[8], y2[8], y3[8];
#pragma unroll
        for (int i = 0; i < 8; ++i) { y0[i] = (f32x2){0.f, 0.f}; y1[i] = (f32x2){0.f, 0.f}; y2[i] = (f32x2){0.f, 0.f}; y3[i] = (f32x2){0.f, 0.f}; }
        v4u V0[4], V1[4], V2[4], V3[4];
#define PV_LOAD(V_, li0_) do { \
            const v4u ea_ = *(const LAS v4u*)(exl + (li0_)); \
            _Pragma("unroll") for (int i_ = 0; i_ < 4; ++i_) { const unsigned e_ = (unsigned)__builtin_amdgcn_readfirstlane((int)ea_[i_]); \
                V_[i_] = *(const v4u*)(V8 + (size_t)e_ * 1024 + OPQ(16 * lane)); } } while (0)
#define PV_COMP(V_, li0_, y_) do { \
            const v4u wa_ = *(const LAS v4u*)(wgl + (li0_));     \
            _Pragma("unroll") for (int i_ = 0; i_ < 4; ++i_) { \
                const float ws_ = __uint_as_float((unsigned)__builtin_amdgcn_readfirstlane((int)wa_[i_])); \
                const f32x2 w2_ = (f32x2){ws_, ws_}; \
                _Pragma("unroll") for (int q_ = 0; q_ < 4; ++q_) { const f32x2 lo_ = __builtin_amdgcn_cvt_pk_f32_fp8(V_[i_][q_], false), hi_ = __builtin_amdgcn_cvt_pk_f32_fp8(V_[i_][q_], true); \
                    y_[2 * q_] = __builtin_elementwise_fma(lo_, w2_, y_[2 * q_]); y_[2 * q_ + 1] = __builtin_elementwise_fma(hi_, w2_, y_[2 * q_ + 1]); } } } while (0)
#if DBG_VSIMPLE == 2
#pragma unroll 1
        for (int j = 0; j < 128; ++j) {
            { const v2u r = lst_row(A, grp * PVT + 0)[j]; const unsigned e_ = (unsigned)__builtin_amdgcn_readfirstlane((int)r.x); const float ws_ = __uint_as_float((unsigned)__builtin_amdgcn_readfirstlane((int)r.y));
              const v4u vv = *(const v4u*)(V8 + (size_t)e_ * 1024 + 16 * lane); const f32x2 w2_ = (f32x2){ws_, ws_};
#pragma unroll
              for (int q_ = 0; q_ < 4; ++q_) { const f32x2 lo_ = __builtin_amdgcn_cvt_pk_f32_fp8(vv[q_], false), hi_ = __builtin_amdgcn_cvt_pk_f32_fp8(vv[q_], true); y0[2 * q_] = __builtin_elementwise_fma(lo_, w2_, y0[2 * q_]); y0[2 * q_ + 1] = __builtin_elementwise_fma(hi_, w2_, y0[2 * q_ + 1]); } }
            { const v2u r = lst_row(A, grp * PVT + 1)[j]; const unsigned e_ = (unsigned)__builtin_amdgcn_readfirstlane((int)r.x); const float ws_ = __uint_as_float((unsigned)__builtin_amdgcn_readfirstlane((int)r.y));
              const v4u vv = *(const v4u*)(V8 + (size_t)e_ * 1024 + 16 * lane); const f32x2 w2_ = (f32x2){ws_, ws_};
#pragma unroll
              for (int q_ = 0; q_ < 4; ++q_) { const f32x2 lo_ = __builtin_amdgcn_cvt_pk_f32_fp8(vv[q_], false), hi_ = __builtin_amdgcn_cvt_pk_f32_fp8(vv[q_], true); y1[2 * q_] = __builtin_elementwise_fma(lo_, w2_, y1[2 * q_]); y1[2 * q_ + 1] = __builtin_elementwise_fma(hi_, w2_, y1[2 * q_ + 1]); } }
        }
#elif DBG_VSIMPLE
#pragma unroll 1
        for (int ch = 0; ch < 32; ++ch) {
            PV_LOAD(V0, ch * 4); PV_COMP(V0, ch * 4, y0);
            PV_LOAD(V1, 128 + ch * 4); PV_COMP(V1, 128 + ch * 4, y1);
            if (PVT == 4) { PV_LOAD(V2, 256 + ch * 4); PV_COMP(V2, 256 + ch * 4, y2);
            PV_LOAD(V3, 384 + ch * 4); PV_COMP(V3, 384 + ch * 4, y3); }
        }
#else
        PV_LOAD(V0, 0); PV_LOAD(V1, 128); PV_LOAD(V2, 256); PV_LOAD(V3, 384);
#pragma unroll 1
        for (int ch = 0; ch < 31; ++ch) {
            PV_COMP(V0, ch * 4, y0);       PV_LOAD(V0, (ch + 1) * 4);
            PV_COMP(V1, 128 + ch * 4, y1); PV_LOAD(V1, 128 + (ch + 1) * 4);
            PV_COMP(V2, 256 + ch * 4, y2); PV_LOAD(V2, 256 + (ch + 1) * 4);
            PV_COMP(V3, 384 + ch * 4, y3); PV_LOAD(V3, 384 + (ch + 1) * 4);
        }
        PV_COMP(V0, 124, y0); PV_COMP(V1, 252, y1); PV_COMP(V2, 380, y2); PV_COMP(V3, 508, y3);
#endif
#undef PV_LOAD
#undef PV_COMP
#pragma unroll
        for (int nn = 0; nn < PVT; ++nn) {
            const int t = grp * PVT + nn;
            const bf16* hp = (const bf16*)((const char*)(HB + (size_t)t * 1024) + OPQ(32 * lane));
            const v4u hr0 = *(const v4u*)hp, hr1 = *(const v4u*)(hp + 8);
            f32x4 o[4]; float s2 = 0.f;
#pragma unroll
            for (int i = 0; i < 4; ++i) { const f32x4 hr = (i == 0) ? bf4lo(hr0) : (i == 1) ? bf4hi(hr0) : (i == 2) ? bf4lo(hr1) : bf4hi(hr1);
                const f32x2 ya = (nn == 0) ? y0[2 * i] : (nn == 1) ? y1[2 * i] : (nn == 2) ? y2[2 * i] : y3[2 * i], yb = (nn == 0) ? y0[2 * i + 1] : (nn == 1) ? y1[2 * i + 1] : (nn == 2) ? y2[2 * i + 1] : y3[2 * i + 1];
                o[i] = hr + (f32x4){ya.x, ya.y, yb.x, yb.y}; s2 += (o[i][0] * o[i][0] + o[i][1] * o[i][1]) + (o[i][2] * o[i][2] + o[i][3] * o[i][3]); }
            const float rf = 1.0f / sqrtf(wave_sum(s2) * (1.f / 1024.f) + EPS_);
            float* op = (float*)((char*)(OUT + (size_t)t * 1024) + OPQ(64 * lane));
            const float* gp = (const float*)((const char*)gfin + OPQ(64 * lane));
            if ((DBG_VSEL >> nn) & 1) {
#pragma unroll
            for (int i = 0; i < 4; ++i) *(f32x4*)(op + 4 * i) = o[i] * rf * *(const f32x4*)(gp + 4 * i); }
            asm volatile("" ::: "memory");
        }
    }
}

constexpr int LDS_BYTES = 147456;
constexpr int N_PHASES = (USE_PEER2 == 3) ? 8 : 7;
__global__ void __launch_bounds__(NTHR, 2) fwd_kernel(Args args) {
    extern __shared__ __attribute__((aligned(16))) unsigned char lds_raw[];
    Frame F;
    F.lds = (LAS unsigned char*)lds_raw;
    F.wave = __builtin_amdgcn_readfirstlane((int)threadIdx.x >> 6);
#define RETID() do { int l_; asm volatile("v_mbcnt_lo_u32_b32 %0, -1, 0\n\tv_mbcnt_hi_u32_b32 %0, -1, %0" : "=v"(l_)); F.lane = l_; F.tid = F.wave * 64 + l_; F.bid = __builtin_amdgcn_readfirstlane(F.bid); asm volatile("" : "+s"(F.G)); } while (0)
    F.G = gridDim.x; F.bid = blockIdx.x;
    RETID();
    const Args& A = args;
#define IN(k) (lo <= (k) && (k) < hi)
    for (int u = F.tid; u < 16; u += NTHR) ((LAS unsigned*)(F.lds + LDS_MISC))[u] = 0u;
    __syncthreads();
#if ONE_LAUNCH
    XcdBarrier bar = xcd_barrier_post((unsigned*)(A.ws + WS_CTL), (volatile LAS unsigned*)(F.lds + LDS_MISC), F.tid);
    if (args.ph_lo < 0) cg::this_grid().sync();
#define XL_() (XLOCAL && ONE_LAUNCH && __builtin_amdgcn_readfirstlane((int)((volatile LAS unsigned*)(F.lds + LDS_MISC))[2]) == 1)
#define SEAM(k) do { RETID(); if (IN(k) && IN((k) + 1)) { if ((k) > 0 && XL_()) xcd_barrier_local(bar, F.tid); else xcd_barrier(bar, F.tid); \
        if ((k) == 0 && XLOCAL) { const unsigned uni_ = ((volatile LAS unsigned*)(F.lds + LDS_MISC))[2], rk_ = ((volatile LAS unsigned*)(F.lds + LDS_MISC))[3]; \
            if (__builtin_amdgcn_readfirstlane((int)uni_) == 1) { F.bid = __builtin_amdgcn_readfirstlane((int)(rk_ - 1u) * 8 + (int)bar.x); } } } RETID(); } while (0)
#else
#define SEAM(k) do { RETID(); } while (0)
#endif
#if PROBE_K >= 0
    int lo = 0, hi = PROBE_K + 1;
#elif ONE_LAUNCH
    constexpr int lo = 0, hi = N_PHASES;
#else
    const int lo = args.ph_lo, hi = args.ph_hi;
#endif
#define PHASE_PROGRAM() do { \
    if (IN(0)) { const int sk_ = first_ ? P0_SKIP : 0; \
                   \
                 if (P0_XFIRST) { p0_prologue(F, A, 0, false, 0, 0, sk_ | 1); p0_prologue(F, A, 0, false, 0, 0, sk_ | 2); } else { p0_prologue(F, A, 0, false, 0, 0, sk_); } \
                 __syncthreads(); RETID(); p0_prologue(F, A, 1, true, 0, (2 * NEXP_ + 4 * F.G * NWAVES - 1) / (4 * F.G * NWAVES), sk_); } SEAM(0); \
    if (IN(1)) { EpiIn E{WSP(A, WS_Q), WSP(A, WS_K), WSP(A, WS_V), WSP(A, WS_SU), WSP(A, WS_SV), (bf16*)A.out}; gemm_any(F, WSP(A, WS_XN), WSP(A, WS_WIN), T_, DIN_, D_, E, (EPI_SKIP && first_) ? 1 : 0); } SEAM(1); \
    if (IN(2)) {   \
                 const bool gfirst_ = !(P2_SPLIT && XL_() && (F.bid & 4)); \
                 _Pragma("nounroll") for (int part_ = 0; part_ < 2; ++part_) { \
                 if ((part_ == 0) == gfirst_) { gmlp_mfma(F, A); } else { \
                 const float s1_ = wave_sum(A.in[3][F.lane] * A.in[4][F.lane]), s2_ = wave_sum(A.in[5][F.lane] * A.in[6][F.lane]); \
                 const float lam_ = __builtin_bit_cast(float, __builtin_amdgcn_readfirstlane(__builtin_bit_cast(int, expf(s1_) - expf(s2_) + LAM_INIT_))); \
                 const attn128::AttnTensors AT{(const attn128::bf16*)WSP(A, WS_Q), (const attn128::bf16*)WSP(A, WS_K), (const attn128::bf16*)WSP(A, WS_V), (attn128::bf16*)WSP(A, WS_XN), (const float*)(A.ws + WS_GSUB), lam_, (first_ && DBG_ATTN_QB != -1) ? DBG_ATTN_QB : -1}; \
                 const unsigned tcy_ = attn128::attn_phase<8>((char*)lds_raw, AT, F.G, F.bid, F.wave); \
                 if (ATTN_TIMING && first_) { const unsigned long long t0_ = __builtin_amdgcn_s_memtime(); while (__builtin_amdgcn_s_memtime() - t0_ < 4ull * tcy_) __builtin_amdgcn_s_sleep(2); } } \
                 __syncthreads(); RETID(); } } SEAM(2); \
    if (IN(3)) { gemm_merge(F, WSP(A, WS_XN), WSP(A, WS_WA), (long)(WS_SU - WS_XN), (long)(WS_WB - WS_WA), (const bf16*)A.out, WSP(A, WS_Q)); } SEAM(3); \
    if (IN(4)) { gemm_out(F, WSP(A, WS_Q), WSP(A, WS_WO), A.in[0], WSP(A, WS_XN)); } SEAM(4); \
    if (IN(5)) { EpiSc E{&A}; gemm_any(F, WSP(A, WS_XN), WSP(A, WS_WQS), T_, 2048, D_, E); } SEAM(5); \
    if (USE_PEER2 == 3) { if (IN(6)) { if (DBG_LIST) peer_phase3(F, A); else peer_u_phase(F, A); } SEAM(6); if (IN(7)) { if (DBG_LIST != 2) peer_v_phase(F, A); } } else \
    if (IN(6)) { if (PEER_VARIANT != 0 && first_) peer_phase<PEER_VARIANT>(F, A); else if (USE_PEER2 == 2) peer_phase3(F, A); else if (USE_PEER2 == 1) { if (PEER2_FIXED && first_) peer_phase2<true>(F, A); else peer_phase2<false>(F, A); } else peer_phase<0>(F, A); } \
    } while (0)
    bool first_ = (PROBE_K >= 0);
    PHASE_PROGRAM();
#if PROBE_K >= 0
    RETID(); xcd_barrier(bar, F.tid); RETID();
    hi = N_PHASES; first_ = false;
    PHASE_PROGRAM();
#endif
#undef IN
#undef SEAM
}

extern "C" void kernel_launch(void* const* d_in, const int* in_sizes, int n_in, void* d_out, int out_size, void* d_ws, size_t ws_size, hipStream_t stream) {
    static int grid = 0;
    if (grid == 0) {
        if (n_in != 21 || in_sizes[0] != T_ * D_ || out_size != T_ * D_ || ws_size < WS_END) { fprintf(stderr, "kernel_launch: unexpected problem: n_in %d in0 %d out %d ws %zu (need %zu)\n", n_in, n_in > 0 ? in_sizes[0] : -1, out_size, ws_size, (size_t)WS_END); grid = -1; return; }
        int dev = 0, cus = 0, per_cu = 0;
        if (hipGetDevice(&dev) != hipSuccess || hipDeviceGetAttribute(&cus, hipDeviceAttributeMultiprocessorCount, dev) != hipSuccess) { grid = -1; return; }
        if (hipFuncSetAttribute((const void*)fwd_kernel, hipFuncAttributeMaxDynamicSharedMemorySize, LDS_BYTES) != hipSuccess) { fprintf(stderr, "kernel_launch: hipFuncSetAttribute failed\n"); grid = -1; return; }
        if (hipOccupancyMaxActiveBlocksPerMultiprocessor(&per_cu, (const void*)fwd_kernel, NTHR, LDS_BYTES) != hipSuccess || per_cu < 1) { fprintf(stderr, "kernel_launch: occupancy query says %d\n", per_cu); per_cu = 1; }
        (void)hipGetLastError();
        grid = cus;
    }
    if (grid < 0) return;
    if (hipMemsetAsync((char*)d_ws + WS_CTL, 0, 65536, stream) != hipSuccess) { fprintf(stderr, "kernel_launch: memset failed\n"); return; }
    Args a{};
    for (int i = 0; i < 21; ++i) a.in[i] = (const float*)d_in[i];
    a.out = (float*)d_out; a.ws = (unsigned char*)d_ws;
#if ONE_LAUNCH
    a.ph_lo = 0; a.ph_hi = N_PHASES;
    void* kargs[] = {&a};
#if PLAIN_LAUNCH
    (void)kargs; hipLaunchKernelGGL(fwd_kernel, dim3(grid), dim3(NTHR), LDS_BYTES, stream, a); hipError_t e = hipPeekAtLastError();
#else
    hipError_t e = hipLaunchCooperativeKernel((const void*)fwd_kernel, dim3(grid), dim3(NTHR), kargs, LDS_BYTES, stream);
#endif
    if (e != hipSuccess) fprintf(stderr, "cooperative launch failed: %s (grid %d)\n", hipGetErrorString(e), grid);
#else
    for (int p = 0; p < N_PHASES; ++p) {
        a.ph_lo = p; a.ph_hi = p + 1;
        hipLaunchKernelGGL(fwd_kernel, dim3(grid), dim3(NTHR), LDS_BYTES, stream, a);
    }
#endif
}
```
